# Optimizing an MI355X kernel written in HIP

```python
import jax, jax.numpy as jnp
from jax import lax
import numpy as np

D_MODEL = 2048
BATCH = 4
SEQ = 8192
DEPTH = 2

CHUNK = 64
Q_BLOCK = 128
PLE_DIM = 256
HEAD_DIM = 128
N_HEADS_FOX = D_MODEL // HEAD_DIM
EXPAND = 128
N_HEADS_HG = D_MODEL // EXPAND
HG_V_DIM = D_MODEL // N_HEADS_HG
EPS = 1e-6
NEG = -1e30

kernel_name = "fox_hgrn2_interleaved_sandwich_ple"


def rms_norm(x, g):
    xf = x.astype(jnp.float32)
    y = xf * lax.rsqrt(jnp.mean(xf * xf, axis=-1, keepdims=True) + EPS)
    return (y * g.astype(jnp.float32)).astype(x.dtype)


def fox_mixer(xn, w_in, b_f, g_q, g_k, w_out):
    B, S, D = xn.shape
    H, Dh = N_HEADS_FOX, HEAD_DIM
    proj = xn @ w_in
    q, k, v, z, f_logit = jnp.split(proj, [D, 2 * D, 3 * D, 4 * D], axis=-1)
    q = rms_norm(q.reshape(B, S, H, Dh), g_q).transpose(0, 2, 1, 3)
    k = rms_norm(k.reshape(B, S, H, Dh), g_k).transpose(0, 2, 1, 3)
    v = v.reshape(B, S, H, Dh).transpose(0, 2, 1, 3)
    log_f = jax.nn.log_sigmoid((f_logit + b_f).astype(jnp.float32))
    c = jnp.cumsum(log_f, axis=1).transpose(0, 2, 1)
    nb = S // Q_BLOCK
    q_blocks = q.reshape(B, H, nb, Q_BLOCK, Dh).transpose(2, 0, 1, 3, 4)
    c_blocks = c.reshape(B, H, nb, Q_BLOCK).transpose(2, 0, 1, 3)
    kpos = jnp.arange(S)
    scale = 1.0 / np.sqrt(Dh).astype(np.float32)

    def attend(args):
        qb, cqb, bid = args
        qpos = bid * Q_BLOCK + jnp.arange(Q_BLOCK)
        s = jnp.einsum('bhqd,bhkd->bhqk', qb, k).astype(jnp.float32) * scale
        s = s + (cqb[..., :, None] - c[:, :, None, :])
        mask = kpos[None, :] <= qpos[:, None]
        s = jnp.where(mask, s, NEG)
        prob = jax.nn.softmax(s, axis=-1)
        return jnp.einsum('bhqk,bhkd->bhqd', prob.astype(v.dtype), v).astype(v.dtype)

    o = lax.map(attend, (q_blocks, c_blocks, jnp.arange(nb)))
    o = o.transpose(1, 0, 3, 2, 4).reshape(B, S, D)
    return (o * jax.nn.silu(z)) @ w_out


def hgrn2_mixer(xn, w_in, lb, g_o, w_out):
    B, S, D = xn.shape
    H, dk, dv = N_HEADS_HG, EXPAND, HG_V_DIM
    nc = S // CHUNK
    proj = xn @ w_in
    q, f_logit, i_in, z = jnp.split(proj, 4, axis=-1)
    q = jax.nn.silu(q.astype(jnp.float32))
    forget = lb + (1.0 - lb) * jax.nn.sigmoid(f_logit.astype(jnp.float32))
    k = 1.0 - forget
    g = jnp.log(forget)

    def to_chunks(t, hd):
        return t.reshape(B, nc, CHUNK, H, hd).transpose(1, 0, 3, 2, 4)

    qc, kc, gc = to_chunks(q, dk), to_chunks(k, dk), to_chunks(g, dk)
    vc = to_chunks(i_in.astype(jnp.float32), dv)
    causal = jnp.tril(jnp.ones((CHUNK, CHUNK), dtype=bool))

    def step(state, inp):
        qq, kk, vv, gg = inp
        b = jnp.cumsum(gg, axis=2)
        inter = jnp.einsum('bhtd,bhdv->bhtv', qq * jnp.exp(b), state)
        diff = b[:, :, :, None, :] - b[:, :, None, :, :]
        decay = jnp.exp(jnp.where(causal[:, :, None], diff, -jnp.inf))
        att = jnp.einsum('bhtd,bhsd,bhtsd->bhts', qq, kk, decay)
        intra = jnp.einsum('bhts,bhsv->bhtv', att, vv)
        b_last = b[:, :, -1:, :]
        new_state = jnp.exp(b_last[:, :, 0, :])[..., None] * state + jnp.einsum(
            'bhsd,bhsv->bhdv', kk * jnp.exp(b_last - b), vv)
        return new_state, inter + intra

    s0 = jnp.zeros((B, H, dk, dv), jnp.float32)
    _, o = lax.scan(step, s0, (qc, kc, vc, gc))
    o = o.transpose(1, 0, 3, 2, 4).reshape(B, S, H, dv)
    o = rms_norm(o, g_o).reshape(B, S, D).astype(xn.dtype)
    return (o * jax.nn.silu(z)) @ w_out


def setup_inputs(seed: int = 0) -> dict:
    key = jax.random.key(seed)
    ks = jax.random.split(key, 16)
    D, H = D_MODEL, N_HEADS_FOX
    n_fox = (DEPTH + 1) // 2
    n_hg = DEPTH // 2
    nrm = lambda k, shape, fan: jax.random.normal(k, shape, jnp.float32) * fan ** -0.5
    gain = lambda k, shape: 1.0 + 0.05 * jax.random.normal(k, shape, jnp.float32)
    return {
        "x": jax.random.normal(ks[0], (BATCH, SEQ, D), jnp.float32),
        "p": jax.random.normal(ks[1], (DEPTH, BATCH, SEQ, PLE_DIM), jnp.float32),
        "w_in_fox": nrm(ks[2], (n_fox, D, 4 * D + H), D),
        "b_f_fox": jax.random.uniform(ks[3], (n_fox, H), jnp.float32, 1.0, 4.0),
        "g_q_fox": gain(ks[4], (n_fox, HEAD_DIM)),
        "g_k_fox": gain(ks[5], (n_fox, HEAD_DIM)),
        "w_out_fox": nrm(ks[6], (n_fox, D, D), D),
        "w_in_hg": nrm(ks[7], (n_hg, D, 4 * D), D),
        "lb_logits": 0.1 * jax.random.normal(ks[8], (DEPTH, D), jnp.float32),
        "g_o_hg": gain(ks[9], (n_hg, HG_V_DIM)),
        "w_out_hg": nrm(ks[10], (n_hg, D, D), D),
        "pre_norm": gain(ks[11], (DEPTH, D)),
        "post_norm": gain(ks[12], (DEPTH, D)),
        "w_pe": nrm(ks[13], (DEPTH, PLE_DIM, D), PLE_DIM),
        "w_pg": nrm(ks[14], (DEPTH, D, D), D),
    }


def reference(x, p, w_in_fox, b_f_fox, g_q_fox, g_k_fox, w_out_fox, w_in_hg,
              lb_logits, g_o_hg, w_out_hg, pre_norm, post_norm, w_pe, w_pg):
    gam = jax.nn.softmax(lb_logits.astype(jnp.float32), axis=0)
    lower_bounds = jnp.cumsum(gam, axis=0) - gam[0:1]
    h = x
    for i in range(DEPTH):
        xn = rms_norm(h, pre_norm[i])
        if i % 2 == 0:
            j = i // 2
            y = fox_mixer(xn, w_in_fox[j], b_f_fox[j], g_q_fox[j], g_k_fox[j], w_out_fox[j])
        else:
            j = i // 2
            y = hgrn2_mixer(xn, w_in_hg[j], lower_bounds[i], g_o_hg[j], w_out_hg[j])
        h = h + rms_norm(y, post_norm[i])
        pe = p[i].astype(h.dtype) @ w_pe[i]
        h = h + pe * jax.nn.sigmoid(h @ w_pg[i])
    return h
```

```cpp
#include <hip/hip_runtime.h>
#include <hip/hip_bf16.h>
#include <hip/hip_cooperative_groups.h>
#include <cstdio>
#include <cstdint>
namespace cg = cooperative_groups;

typedef __bf16 bf16x2_t __attribute__((ext_vector_type(2)));
typedef float f32x2_t __attribute__((ext_vector_type(2)));
__device__ __forceinline__ unsigned cvtpk_s(float lo, float hi) { f32x2_t v = {lo, hi}; bf16x2_t b = __builtin_convertvector(v, bf16x2_t); return __builtin_bit_cast(unsigned, b); }
__device__ __forceinline__ float bf_lo(unsigned w) { return __uint_as_float(w << 16); }
__device__ __forceinline__ float bf_hi(unsigned w) { return __uint_as_float(w & 0xffff0000u); }
__device__ __forceinline__ float sigmoidf_(float x) { return __builtin_amdgcn_rcpf(1.0f + __expf(-x)); }
__device__ __forceinline__ float siluf_(float x) { return x * __builtin_amdgcn_rcpf(1.0f + __expf(-x)); }

__device__ __forceinline__ int fresh_tid(int wave_s) { int l; asm volatile("v_mbcnt_lo_u32_b32 %0, -1, 0\n\tv_mbcnt_hi_u32_b32 %0, -1, %0" : "=v"(l)); return wave_s * 64 + l; }

namespace pg8 {
#define PG8_LAS __attribute__((address_space(3)))
typedef unsigned short bf16_t;
typedef short bf16x8 __attribute__((ext_vector_type(8)));
typedef float f32x4 __attribute__((ext_vector_type(4)));
typedef unsigned u32x4 __attribute__((ext_vector_type(4)));
constexpr int BM = 256, BK = 64, HALF = 128, HTB = HALF * BK * 2  , STAGE_BYTES = 8 * HTB, NXCD = 8, WGM = 8;

__host__ __device__ __forceinline__ int lds_byte(int r, int c) { const int st = (r >> 4) * 2 + (c >> 5), rr = r & 15, cc = c & 31, ob = rr * 64 + cc * 2; return st * 1024 + (ob ^ (((ob >> 9) & 1) << 5)); }
__host__ __device__ __forceinline__ void stage_rc(int b, int& R, int& C) { const int st = b / 1024, sb = b % 1024, swz = sb ^ (((sb >> 9) & 1) << 5); R = (st >> 1) * 16 + swz / 64; C = (st & 1) * 32 + (swz % 64) / 2; }
__host__ __device__ __forceinline__ int perm32(int rho) { const int n = rho >> 4, i = rho & 15; return 8 * (i >> 2) + 4 * n + (i & 3); }

struct Unit { int pm, pn; };
struct Gemm { const bf16_t* A; const bf16_t* Bt; int M, N, K; };

struct StaticOrder {
    int nM, nN, nwg, G, c;
    __host__ __device__ void init(int M, int N, int G_, int c_) { nM = M / BM; nN = N / BM; nwg = nM * nN; G = G_; c = c_; }
    __host__ __device__ bool next(int i, Unit& u) const {
        const long L = (long)i * G + c; if (L >= nwg) return false;
        int wgid = (int)L; { const int q = nwg / NXCD, r = nwg % NXCD, xcd = wgid % NXCD, off = wgid / NXCD; wgid = (xcd < r ? xcd * (q + 1) : r * (q + 1) + (xcd - r) * q) + off; }
        const int nig = WGM * nN, gid = wgid / nig, fm = gid * WGM, gsz = (nM - fm) < WGM ? (nM - fm) : WGM;
        u.pm = fm + ((wgid % nig) % gsz); u.pn = (wgid % nig) / gsz; return true;
    }
    __device__ __forceinline__ void a_ready(const Unit&) const {}
    __device__ __forceinline__ void done(const Unit&) const {}
};


__device__ __forceinline__ u32x4 pack8bf(const f32x4 a, const f32x4 b) { u32x4 w; w.x = cvtpk_s(a[0], a[1]); w.y = cvtpk_s(a[2], a[3]); w.z = cvtpk_s(b[0], b[1]); w.w = cvtpk_s(b[2], b[3]); return w; }
__device__ __forceinline__ f32x4 silu4(const f32x4 v) { return (f32x4){siluf_(v[0]), siluf_(v[1]), siluf_(v[2]), siluf_(v[3])}; }
__device__ __forceinline__ float logsigmoidf_(float x) { return fminf(x, 0.f) - __logf(1.0f + __expf(-fabsf(x))); }

struct EpiFoxIn {
    static constexpr bool PERM = true, AFTER_DRAIN = false;
    bf16_t *Q, *SZ; size_t qkv_stride; float* logf; const float* b_f; const float* gains; PG8_LAS float* xs;
    __device__ __forceinline__ void operator()(const f32x4 (&acc)[2][2][4][2], const Unit& u, int wr, int wc, int fr, int fq) const {
        const int sec = u.pn >> 3, row0 = u.pm * BM + wr * 64 + fr;
        if (sec < 2) {
            bf16_t* base = Q + (size_t)sec * qkv_stride;
#pragma unroll
            for (int ai = 0; ai < 2; ++ai)
#pragma unroll
                for (int m = 0; m < 4; ++m)
#pragma unroll
                    for (int bj = 0; bj < 2; ++bj) { const f32x4 a = acc[ai][bj][m][0], b = acc[ai][bj][m][1];
                        float s = (a[0] * a[0] + a[1] * a[1]) + (a[2] * a[2] + a[3] * a[3]) + (b[0] * b[0] + b[1] * b[1]) + (b[2] * b[2] + b[3] * b[3]);
                        s += __shfl_xor(s, 16); s += __shfl_xor(s, 32);
                        if (fq == 0) xs[(ai * HALF + wr * 64 + m * 16 + fr) * 8 + bj * 4 + wc] = s; }
            asm volatile("s_waitcnt lgkmcnt(0)" ::: "memory"); __builtin_amdgcn_s_barrier(); asm volatile("" ::: "memory");
            int go_ = wc * 32 + 8 * fq; asm volatile("" : "+v"(go_));
            const float* gp = gains + sec * 128 + go_; const f32x4 g0 = *(const f32x4*)gp, g1 = *(const f32x4*)(gp + 4);
#pragma unroll
            for (int ai = 0; ai < 2; ++ai)
#pragma unroll
                for (int m = 0; m < 4; ++m) { const int row = row0 + ai * HALF + m * 16, b = row >> 13, s = row & 8191;
#pragma unroll
                    for (int bj = 0; bj < 2; ++bj) { const int h = (u.pn & 7) * 2 + bj;
                        const f32x4 pp = *(const PG8_LAS f32x4*)(xs + (ai * HALF + wr * 64 + m * 16 + fr) * 8 + bj * 4);
                        const float r = rsqrtf(((pp[0] + pp[1]) + (pp[2] + pp[3])) * (1.f / 128.f) + 1e-6f);
                        *(u32x4*)(base + ((size_t)(b * 16 + h) * 8192 + s) * 128 + wc * 32 + 8 * fq) = pack8bf(acc[ai][bj][m][0] * r * g0, acc[ai][bj][m][1] * r * g1); }
                    asm volatile("" ::: "memory"); }
        } else if (sec == 2) {
            bf16_t* base = Q + (size_t)sec * qkv_stride;
#pragma unroll
            for (int ai = 0; ai < 2; ++ai)
#pragma unroll
                for (int m = 0; m < 4; ++m) { const int row = row0 + ai * HALF + m * 16, b = row >> 13, s = row & 8191;
#pragma unroll
                    for (int bj = 0; bj < 2; ++bj) { const int h = (u.pn & 7) * 2 + bj;
                        *(u32x4*)(base + ((size_t)(b * 16 + h) * 8192 + s) * 128 + wc * 32 + 8 * fq) = pack8bf(acc[ai][bj][m][0], acc[ai][bj][m][1]); }
                    asm volatile("" ::: "memory"); }
        } else if (sec == 3) {
#pragma unroll
            for (int ai = 0; ai < 2; ++ai)
#pragma unroll
                for (int m = 0; m < 4; ++m) { const int row = row0 + ai * HALF + m * 16;
#pragma unroll
                    for (int bj = 0; bj < 2; ++bj)
                        *(u32x4*)(SZ + (size_t)row * 2048 + (u.pn & 7) * 256 + bj * HALF + wc * 32 + 8 * fq) = pack8bf(silu4(acc[ai][bj][m][0]), silu4(acc[ai][bj][m][1]));
                    asm volatile("" ::: "memory"); }
        } else {
            if (wc == 0 && fq < 2) {
#pragma unroll
                for (int ai = 0; ai < 2; ++ai)
#pragma unroll
                    for (int m = 0; m < 4; ++m) { const int row = row0 + ai * HALF + m * 16, b = row >> 13, s = row & 8191;
#pragma unroll
                        for (int n = 0; n < 2; ++n)
#pragma unroll
                            for (int j = 0; j < 4; ++j) { const int h = 8 * fq + 4 * n + j;
                                logf[(size_t)(b * 16 + h) * 8192 + s] = logsigmoidf_(acc[ai][0][m][n][j] + b_f[h]); }
                        asm volatile("" ::: "memory"); }
            }
        }
    }
};
struct EpiOutSS {
    static constexpr bool PERM = true, AFTER_DRAIN = false;
    bf16_t* Y; float* ss;
    __device__ __forceinline__ void operator()(const f32x4 (&acc)[2][2][4][2], const Unit& u, int wr, int wc, int fr, int fq) const {
        const int row0 = u.pm * BM + wr * 64 + fr, col0 = u.pn * BM + wc * 32 + 8 * fq;
#pragma unroll
        for (int ai = 0; ai < 2; ++ai)
#pragma unroll
            for (int m = 0; m < 4; ++m) { const int row = row0 + ai * HALF + m * 16; float s = 0.f;
#pragma unroll
                for (int bj = 0; bj < 2; ++bj) { const f32x4 a = acc[ai][bj][m][0], b = acc[ai][bj][m][1];
                    s += (a[0] * a[0] + a[1] * a[1]) + (a[2] * a[2] + a[3] * a[3]) + (b[0] * b[0] + b[1] * b[1]) + (b[2] * b[2] + b[3] * b[3]);
                    *(u32x4*)(Y + (size_t)row * 2048 + col0 + bj * HALF) = pack8bf(a, b); }
                s += __shfl_xor(s, 16); s += __shfl_xor(s, 32);
                if (fq == 0) ss[(size_t)row * 32 + u.pn * 4 + wc] = s; asm volatile("" ::: "memory"); }
    }
};
struct EpiPlain {
    static constexpr bool PERM = true, AFTER_DRAIN = false;
    bf16_t* Y;
    __device__ __forceinline__ void operator()(const f32x4 (&acc)[2][2][4][2], const Unit& u, int wr, int wc, int fr, int fq) const {
        const int row0 = u.pm * BM + wr * 64 + fr, col0 = u.pn * BM + wc * 32 + 8 * fq;
#pragma unroll
        for (int ai = 0; ai < 2; ++ai)
#pragma unroll
            for (int m = 0; m < 4; ++m) { const int row = row0 + ai * HALF + m * 16;
#pragma unroll
                for (int bj = 0; bj < 2; ++bj) *(u32x4*)(Y + (size_t)row * 2048 + col0 + bj * HALF) = pack8bf(acc[ai][bj][m][0], acc[ai][bj][m][1]); }
    }
};
struct EpiPG {
    static constexpr bool PERM = true, AFTER_DRAIN = false;
    const float* R; float* H; const bf16_t* Y; const float* rstdY; const float* gpost; const bf16_t* PE; bf16_t* HB; float* ss;
    __device__ __forceinline__ void operator()(const f32x4 (&acc)[2][2][4][2], const Unit& u, int wr, int wc, int fr, int fq) const {
        const int row0 = u.pm * BM + wr * 64 + fr, col0 = u.pn * BM + wc * 32 + 8 * fq;
        float rs[2][4]; f32x4 g[2][2];
#pragma unroll
        for (int ai = 0; ai < 2; ++ai)
#pragma unroll
            for (int m = 0; m < 4; ++m) rs[ai][m] = rstdY[row0 + ai * HALF + m * 16];
#pragma unroll
        for (int bj = 0; bj < 2; ++bj) { g[bj][0] = *(const f32x4*)(gpost + col0 + bj * HALF); g[bj][1] = *(const f32x4*)(gpost + col0 + bj * HALF + 4); }
#pragma unroll
        for (int ai = 0; ai < 2; ++ai)
#pragma unroll
            for (int m = 0; m < 4; ++m) { const int row = row0 + ai * HALF + m * 16; const float r = rs[ai][m]; float s = 0.f;
#pragma unroll
                for (int bj = 0; bj < 2; ++bj) { const size_t idx = (size_t)row * 2048 + col0 + bj * HALF;
                    const f32x4 r0 = *(const f32x4*)(R + idx), r1 = *(const f32x4*)(R + idx + 4); const u32x4 yv = *(const u32x4*)(Y + idx), pe = *(const u32x4*)(PE + idx);
                    const f32x4 y0 = {bf_lo(yv.x), bf_hi(yv.x), bf_lo(yv.y), bf_hi(yv.y)}, y1 = {bf_lo(yv.z), bf_hi(yv.z), bf_lo(yv.w), bf_hi(yv.w)};
                    const f32x4 h0 = r0 + y0 * r * g[bj][0], h1 = r1 + y1 * r * g[bj][1];
                    const f32x4 a = acc[ai][bj][m][0], b = acc[ai][bj][m][1];
                    f32x4 o0, o1;
                    o0[0] = h0[0] + bf_lo(pe.x) * sigmoidf_(a[0]); o0[1] = h0[1] + bf_hi(pe.x) * sigmoidf_(a[1]); o0[2] = h0[2] + bf_lo(pe.y) * sigmoidf_(a[2]); o0[3] = h0[3] + bf_hi(pe.y) * sigmoidf_(a[3]);
                    o1[0] = h1[0] + bf_lo(pe.z) * sigmoidf_(b[0]); o1[1] = h1[1] + bf_hi(pe.z) * sigmoidf_(b[1]); o1[2] = h1[2] + bf_lo(pe.w) * sigmoidf_(b[2]); o1[3] = h1[3] + bf_hi(pe.w) * sigmoidf_(b[3]);
                    *(f32x4*)(H + idx) = o0; *(f32x4*)(H + idx + 4) = o1;
                    if (HB) { *(u32x4*)(HB + idx) = pack8bf(o0, o1);
                        s += (o0[0] * o0[0] + o0[1] * o0[1]) + (o0[2] * o0[2] + o0[3] * o0[3]) + (o1[0] * o1[0] + o1[1] * o1[1]) + (o1[2] * o1[2] + o1[3] * o1[3]); } }
                if (HB) { s += __shfl_xor(s, 16); s += __shfl_xor(s, 32); if (fq == 0) ss[(size_t)row * 32 + u.pn * 4 + wc] = s; }
                asm volatile("" ::: "memory"); }
    }
};
struct EpiHgIn {
    static constexpr bool PERM = true, AFTER_DRAIN = false;
    bf16_t *SQ; size_t buf_stride; float* G; const float* rstd; const float* lbl;
    __device__ __forceinline__ void operator()(const f32x4 (&acc)[2][2][4][2], const Unit& u, int wr, int wc, int fr, int fq) const {
        const int sec = u.pn >> 3, row0 = u.pm * BM + wr * 64 + fr, col0 = (u.pn & 7) * BM + wc * 32 + 8 * fq;
        float rs[2][4];
#pragma unroll
        for (int ai = 0; ai < 2; ++ai)
#pragma unroll
            for (int m = 0; m < 4; ++m) rs[ai][m] = rstd[row0 + ai * HALF + m * 16];
        if (sec == 1) {
            float lb[2][8];
#pragma unroll
            for (int bj = 0; bj < 2; ++bj)
#pragma unroll
                for (int j = 0; j < 8; ++j) { const int c = col0 + bj * HALF + j; lb[bj][j] = 1.0f / (1.0f + __expf(lbl[c] - lbl[2048 + c])); }
#pragma unroll
            for (int ai = 0; ai < 2; ++ai)
#pragma unroll
                for (int m = 0; m < 4; ++m) { const int row = row0 + ai * HALF + m * 16; const float r = rs[ai][m];
#pragma unroll
                    for (int bj = 0; bj < 2; ++bj) { f32x4 o0, o1;
#pragma unroll
                        for (int j = 0; j < 4; ++j) { o0[j] = lb[bj][j] + (1.f - lb[bj][j]) * sigmoidf_(acc[ai][bj][m][0][j] * r); o1[j] = lb[bj][4 + j] + (1.f - lb[bj][4 + j]) * sigmoidf_(acc[ai][bj][m][1][j] * r); }
                        float* gp = G + (size_t)row * 2048 + col0 + bj * HALF; *(f32x4*)gp = o0; *(f32x4*)(gp + 4) = o1; }
                    asm volatile("" ::: "memory"); }
        } else {
            bf16_t* base = SQ + (size_t)(sec ? sec + 1 : 0) * buf_stride;
#pragma unroll
            for (int ai = 0; ai < 2; ++ai)
#pragma unroll
                for (int m = 0; m < 4; ++m) { const int row = row0 + ai * HALF + m * 16; const float r = rs[ai][m];
#pragma unroll
                    for (int bj = 0; bj < 2; ++bj) { f32x4 a = acc[ai][bj][m][0] * r, b = acc[ai][bj][m][1] * r;
                        if (sec != 2) { a = silu4(a); b = silu4(b); }
                        *(u32x4*)(base + (size_t)row * 2048 + col0 + bj * HALF) = pack8bf(a, b); }
                    asm volatile("" ::: "memory"); }
        }
    }
};

template <class Epi, class Sched, bool ALIGN_EPI = false, bool SP2 = false>
__device__ __forceinline__ void gemm_phase(PG8_LAS unsigned char* lds, const Gemm g, const Sched& S, const Epi& E, int wave_s) {
    const int tid = fresh_tid(wave_s), wid = __builtin_amdgcn_readfirstlane(tid >> 6), lane = tid & 63, wr = wid >> 2, wc = wid & 3, fr = lane & 15, fq = lane >> 4;
    const int K = g.K, nt = K / BK;
    unsigned voffA[2], voffB[2];
#pragma unroll
    for (int i = 0; i < 2; ++i) { int R, C; stage_rc(tid * 16 + i * 8192, R, C); const int Rb = Epi::PERM ? ((R & ~31) + perm32(R & 31)) : R;
        voffA[i] = (unsigned)(R * K + C) * 2u; voffB[i] = (unsigned)(Rb * K + C) * 2u; }
    const size_t kstep = (size_t)(BK * 2);
    const size_t hstep = (size_t)HALF * K * 2;
    const size_t tstep = 2 * hstep;
    const unsigned ldsw = (unsigned)wid * 1024u;
    const int aoff = lds_byte(wr * 64 + fr, fq * 8), boff = lds_byte(wc * 32 + fr, fq * 8);
#define PG8_SA(b, h) (((b) * 2 + (h)) * HTB)
#define PG8_SB(b, h) ((4 + (b) * 2 + (h)) * HTB)
#define PG8_STAGE(bufoff, gbase, voff) do { _Pragma("unroll") for (int _i = 0; _i < 2; ++_i) \
        __builtin_amdgcn_global_load_lds((const unsigned*)((const char*)(gbase) + (voff)[_i]), (PG8_LAS unsigned*)(lds + (bufoff) + ldsw + _i * 8192), 16, 0, 0); } while (0)
#define PG8_LDA(dst, b, h) do { _Pragma("unroll") for (int m = 0; m < 4; ++m) _Pragma("unroll") for (int k = 0; k < 2; ++k) dst[m][k] = *(const PG8_LAS bf16x8*)(lds + PG8_SA(b, h) + aoff + m * 2048 + k * 1024); } while (0)
#define PG8_LDB(dst, b, h) do { _Pragma("unroll") for (int n = 0; n < 2; ++n) _Pragma("unroll") for (int k = 0; k < 2; ++k) dst[n][k] = *(const PG8_LAS bf16x8*)(lds + PG8_SB(b, h) + boff + n * 2048 + k * 1024); } while (0)
#define PG8_MMA(ai, bj, At, Bt) do { __builtin_amdgcn_s_setprio(1); _Pragma("unroll") for (int m = 0; m < 4; ++m) _Pragma("unroll") for (int n = 0; n < 2; ++n) _Pragma("unroll") for (int k = 0; k < 2; ++k) \
        acc[ai][bj][m][n] = __builtin_amdgcn_mfma_f32_16x16x32_bf16(Bt[n][k], At[m][k], acc[ai][bj][m][n], 0, 0, 0); __builtin_amdgcn_s_setprio(0); } while (0)
#define PG8_WAIT_V(n) asm volatile("s_waitcnt vmcnt(" #n ")" ::: "memory")
#define PG8_WAIT_L(n) asm volatile("s_waitcnt lgkmcnt(" #n ")" ::: "memory")
#define PG8_BAR __builtin_amdgcn_s_barrier()
#define PG8_SCHED __builtin_amdgcn_sched_barrier(0)
    Unit cur, nxt; int ui = 0;
    if (!S.next(0, cur)) return;
    f32x4 acc[2][2][4][2];
#pragma unroll
    for (int a = 0; a < 2; ++a)
#pragma unroll
        for (int b = 0; b < 2; ++b)
#pragma unroll
            for (int m = 0; m < 4; ++m)
#pragma unroll
                for (int n = 0; n < 2; ++n) acc[a][b][m][n] = (f32x4){0.f, 0.f, 0.f, 0.f};
    bf16x8 At[4][2], B0[2][2], B1[2][2];
    const char* cA = (const char*)g.A + (size_t)cur.pm * tstep; const char* cB = (const char*)g.Bt + (size_t)cur.pn * tstep;
    S.a_ready(cur);
    if constexpr (SP2) {
        PG8_STAGE(PG8_SB(0, 0), cB, voffB); PG8_STAGE(PG8_SB(0, 1), cB + hstep, voffB); PG8_STAGE(PG8_SA(0, 0), cA, voffA); PG8_STAGE(PG8_SA(0, 1), cA + hstep, voffA);
        if (wr == 1) PG8_BAR;
        PG8_WAIT_V(2); PG8_BAR;
        PG8_STAGE(PG8_SB(1, 0), cB + kstep, voffB); PG8_STAGE(PG8_SA(1, 0), cA + kstep, voffA); PG8_STAGE(PG8_SB(1, 1), cB + hstep + kstep, voffB);
        PG8_WAIT_V(6); PG8_BAR;
    } else {
        PG8_STAGE(PG8_SB(0, 0), cB, voffB); PG8_STAGE(PG8_SA(0, 0), cA, voffA); PG8_STAGE(PG8_SB(0, 1), cB + hstep, voffB); PG8_STAGE(PG8_SA(0, 1), cA + hstep, voffA);
        if (wr == 1) PG8_BAR;
        PG8_WAIT_V(4); PG8_BAR;
        PG8_STAGE(PG8_SB(1, 0), cB + kstep, voffB); PG8_STAGE(PG8_SA(1, 0), cA + kstep, voffA); PG8_STAGE(PG8_SB(1, 1), cB + hstep + kstep, voffB);
        PG8_WAIT_V(6); PG8_BAR;
    }
    for (;;) {
        const bool has_next = S.next(ui + 1, nxt);
        const char* nA = has_next ? (const char*)g.A + (size_t)nxt.pm * tstep : cA; const char* nB = has_next ? (const char*)g.Bt + (size_t)nxt.pn * tstep : cB;
        for (int t = 0; t < nt; t += 2) {
            const bool last = (t == nt - 2);
            const char* a1 = cA + (size_t)(t + 1) * kstep;
            const char* a2 = last ? nA : cA + (size_t)(t + 2) * kstep; const char* b2 = last ? nB : cB + (size_t)(t + 2) * kstep;
            const char* a3 = a2 + kstep; const char* b3 = b2 + kstep;
            if (last && has_next) S.a_ready(nxt);
            if constexpr (SP2) {
            PG8_LDB(B0, 0, 0); PG8_LDB(B1, 0, 1); PG8_SCHED; PG8_LDA(At, 0, 0); PG8_STAGE(PG8_SA(1, 1), a1 + hstep, voffA);
            PG8_WAIT_V(8); PG8_WAIT_L(0); PG8_BAR; PG8_MMA(0, 0, At, B0); PG8_MMA(0, 1, At, B1); PG8_BAR; PG8_SCHED;
            PG8_LDA(At, 0, 1); PG8_STAGE(PG8_SB(0, 0), b2, voffB); PG8_STAGE(PG8_SB(0, 1), b2 + hstep, voffB); PG8_STAGE(PG8_SA(0, 0), a2, voffA);
            PG8_WAIT_V(8); PG8_WAIT_L(0); PG8_BAR; PG8_MMA(1, 0, At, B0); PG8_MMA(1, 1, At, B1); PG8_BAR; PG8_SCHED;
            PG8_LDB(B0, 1, 0); PG8_LDB(B1, 1, 1); PG8_SCHED; PG8_LDA(At, 1, 0); PG8_STAGE(PG8_SA(0, 1), a2 + hstep, voffA);
            PG8_WAIT_V(8); PG8_WAIT_L(0); PG8_BAR; PG8_MMA(0, 0, At, B0); PG8_MMA(0, 1, At, B1); PG8_BAR; PG8_SCHED;
            PG8_LDA(At, 1, 1); PG8_STAGE(PG8_SB(1, 0), b3, voffB); PG8_STAGE(PG8_SB(1, 1), b3 + hstep, voffB); PG8_STAGE(PG8_SA(1, 0), a3, voffA);
            PG8_WAIT_V(8); PG8_WAIT_L(0); PG8_BAR; PG8_MMA(1, 0, At, B0); PG8_MMA(1, 1, At, B1); PG8_BAR; PG8_SCHED;
            } else {
            PG8_LDB(B0, 0, 0); PG8_SCHED; PG8_LDA(At, 0, 0); PG8_STAGE(PG8_SA(1, 1), a1 + hstep, voffA);
            PG8_WAIT_L(8); PG8_BAR; PG8_WAIT_L(0); PG8_MMA(0, 0, At, B0); PG8_BAR; PG8_SCHED;
            PG8_LDB(B1, 0, 1); PG8_STAGE(PG8_SB(0, 0), b2, voffB);
            PG8_BAR; PG8_WAIT_L(0); PG8_MMA(0, 1, At, B1); PG8_BAR;
            PG8_LDA(At, 0, 1); PG8_STAGE(PG8_SA(0, 0), a2, voffA);
            PG8_BAR; PG8_WAIT_L(0); PG8_MMA(1, 0, At, B0); PG8_BAR; PG8_SCHED;
            PG8_STAGE(PG8_SB(0, 1), b2 + hstep, voffB);
            PG8_WAIT_V(6); PG8_BAR; PG8_MMA(1, 1, At, B1); PG8_BAR;
            PG8_LDB(B0, 1, 0); PG8_SCHED; PG8_LDA(At, 1, 0); PG8_STAGE(PG8_SA(0, 1), a2 + hstep, voffA);
            PG8_WAIT_L(8); PG8_BAR; PG8_WAIT_L(0); PG8_MMA(0, 0, At, B0); PG8_BAR; PG8_SCHED;
            PG8_LDB(B1, 1, 1); PG8_STAGE(PG8_SB(1, 0), b3, voffB);
            PG8_BAR; PG8_WAIT_L(0); PG8_MMA(0, 1, At, B1); PG8_BAR;
            PG8_LDA(At, 1, 1); PG8_STAGE(PG8_SA(1, 0), a3, voffA);
            PG8_BAR; PG8_WAIT_L(0); PG8_MMA(1, 0, At, B0); PG8_BAR; PG8_SCHED;
            PG8_STAGE(PG8_SB(1, 1), b3 + hstep, voffB);
            PG8_WAIT_V(6); PG8_BAR; PG8_MMA(1, 1, At, B1); PG8_BAR;
            }
        }
        if constexpr (ALIGN_EPI) { if (wr == 0) PG8_BAR; }
        if constexpr (!Epi::AFTER_DRAIN) { E(acc, cur, wr, wc, fr, fq); S.done(cur); }
        if (!has_next) break;
#pragma unroll
        for (int a = 0; a < 2; ++a)
#pragma unroll
            for (int b = 0; b < 2; ++b)
#pragma unroll
                for (int m = 0; m < 4; ++m)
#pragma unroll
                    for (int n = 0; n < 2; ++n) acc[a][b][m][n] = (f32x4){0.f, 0.f, 0.f, 0.f};
        cur = nxt; cA = nA; cB = nB; ++ui;
        if constexpr (ALIGN_EPI) { if (wr == 1) PG8_BAR; }
    }
    PG8_WAIT_V(0);
    if constexpr (!ALIGN_EPI) { if (wr == 0) PG8_BAR; }
    PG8_BAR;
    if constexpr (Epi::AFTER_DRAIN) { E.fused(acc, cur, wr, wc, fr, fq, lds, wid, lane); S.done(cur); }
#undef PG8_SA
#undef PG8_SB
#undef PG8_STAGE
#undef PG8_LDA
#undef PG8_LDB
#undef PG8_MMA
#undef PG8_WAIT_V
#undef PG8_WAIT_L
#undef PG8_BAR
#undef PG8_SCHED
}
}
namespace att {
enum { ORDER_NATURAL = 0, ORDER_REVERSED = 1, ORDER_PAIRED = 2, ORDER_XCD = 4 };
constexpr int D = 128, OSTR = 2048, BIAS_OFF = 69632;
constexpr float THR = 8.f;
constexpr bool WSKIP = false;
constexpr float SCALE = 0.08838834764831845f;
constexpr int NW = 8, QBLK = 32, KVBLK = 64, QB = NW * QBLK;
constexpr int SHM_V = KVBLK * D * 2, SHM_K = KVBLK * D * 2;
constexpr int LDS_BYTES = 2 * SHM_V + 2 * SHM_K + NW * 64 * 4;

using bf16 = __hip_bfloat16;
typedef short bf16x8 __attribute__((ext_vector_type(8)));
typedef short s16x4 __attribute__((ext_vector_type(4)));
typedef float f32x16 __attribute__((ext_vector_type(16)));
typedef float f32x4 __attribute__((ext_vector_type(4)));
typedef unsigned u32x4 __attribute__((ext_vector_type(4)));
template <class A, class Bt> struct same_t { static constexpr bool v = false; };
template <class A> struct same_t<A, A> { static constexpr bool v = true; };

#define KSWZ(row, colB) ((row) * 256 + ((colB) ^ (((row) & 7) << 4)))
#define SBAR() __builtin_amdgcn_sched_barrier(0)
__device__ __forceinline__ int v_st(int k, int c) { const int kk = (k & ~0xC) | ((k & 4) << 1) | ((k & 8) >> 1); return ((kk >> 3) * 4 + (c >> 5)) * 512 + ((kk & 7) * 32 + (c & 31)) * 2; }
__device__ __forceinline__ int v_rd_base(int lane) { return ((lane & 3) << 3) | (((lane >> 2) & 3) << 6) | (((lane >> 4) & 1) << 5) | (((lane >> 5) & 1) << 8); }
constexpr int v_rd_off(int d0, int ks, int half) { return d0 * 512 + ks * 4096 + half * 2048; }
__device__ __forceinline__ int crow(int r, int hi) { return (r & 3) + 8 * (r >> 2) + 4 * hi; }
__device__ __forceinline__ unsigned cvtpk(float lo, float hi) {
    unsigned r; asm volatile("v_cvt_pk_bf16_f32 %0, %1, %2" : "=v"(r) : "v"(lo), "v"(hi)); return r;
}
__device__ __forceinline__ bf16x8 pack8(f32x4 a, f32x4 b) {
    u32x4 w = {cvtpk(a[0], a[1]), cvtpk(a[2], a[3]), cvtpk(b[0], b[1]), cvtpk(b[2], b[3])};
    return *reinterpret_cast<bf16x8*>(&w);
}
template <class T> __device__ __forceinline__ bf16x8 load8(const T* p) {
    if constexpr (same_t<T, float>::v) { return pack8(*(const f32x4*)p, *(const f32x4*)(p + 4)); }
    else { return *reinterpret_cast<const bf16x8*>(p); }
}
__device__ __forceinline__ void mask_tile(f32x16& p0, f32x16& p1, int dq, unsigned W) {
    const float NEG = -__builtin_inff();
#pragma unroll
    for (int r = 0; r < 16; ++r) {
        const int c = (r & 3) + 8 * (r >> 2);
        if ((unsigned)(dq - c) >= W) p0[r] = NEG;
        if ((unsigned)(dq - c - 32) >= W) p1[r] = NEG;
    }
}
__device__ __forceinline__ void partialSM(f32x16& p0, f32x16& p1, float& m_reg, float& mn, float& alpha) {
    float pmax = p0[0]; for (int r = 1; r < 16; ++r) pmax = fmaxf(pmax, p0[r]); for (int r = 0; r < 16; ++r) pmax = fmaxf(pmax, p1[r]);
    { auto rr = __builtin_amdgcn_permlane32_swap(__float_as_uint(pmax), __float_as_uint(pmax), false, false);
      pmax = fmaxf(__uint_as_float(rr[0]), __uint_as_float(rr[1])); }
    constexpr float C2 = 1.4426950408889634f * SCALE;
    if (__builtin_expect(__all((pmax - m_reg) * SCALE <= THR), 1)) { mn = m_reg; alpha = 1.f; }
    else { mn = fmaxf(m_reg, pmax); alpha = __builtin_amdgcn_exp2f((m_reg - mn) * C2); m_reg = mn; }
    const float mnL = -mn * C2;
    for (int r = 0; r < 16; ++r) p0[r] = fmaf(p0[r], C2, mnL); for (int r = 0; r < 16; ++r) p1[r] = fmaf(p1[r], C2, mnL);
    for (int r = 0; r < 16; ++r) p0[r] = __builtin_amdgcn_exp2f(p0[r]);
}
__device__ __forceinline__ void finishSM(f32x16& p0, f32x16& p1, float alpha, float& l_reg, bf16x8& pa0, bf16x8& pa1, bf16x8& pa2, bf16x8& pa3) {
    for (int r = 0; r < 16; ++r) p1[r] = __builtin_amdgcn_exp2f(p1[r]);
    float ps = 0; for (int r = 0; r < 16; ++r) ps += p0[r]; for (int r = 0; r < 16; ++r) ps += p1[r];
    { auto rr = __builtin_amdgcn_permlane32_swap(__float_as_uint(ps), __float_as_uint(ps), false, false);
      ps = __uint_as_float(rr[0]) + __uint_as_float(rr[1]); }
    l_reg = l_reg * alpha + ps;
#define PK4(P, B_, OUT) do { unsigned a0 = cvtpk(P[B_+0], P[B_+1]), a1 = cvtpk(P[B_+2], P[B_+3]);                          \
        unsigned b0 = cvtpk(P[B_+4], P[B_+5]), b1 = cvtpk(P[B_+6], P[B_+7]);                                             \
        auto r0 = __builtin_amdgcn_permlane32_swap(a0, b0, false, false); auto r1 = __builtin_amdgcn_permlane32_swap(a1, b1, false, false); \
        u32x4 w = {r0[0], r1[0], r0[1], r1[1]}; OUT = *reinterpret_cast<bf16x8*>(&w); } while (0)
    PK4(p0, 0, pa0); PK4(p0, 8, pa1); PK4(p1, 0, pa2); PK4(p1, 8, pa3);
#undef PK4
}
template <int KB, bool SK>
__device__ __forceinline__ void qkt(f32x16& p0, f32x16& p1, const char* K_lds, int r32, int hi, const bf16x8* qr, bool act, const char* bl) {
    if (SK && !act) { const float NEG = -__builtin_inff();
#pragma unroll
        for (int r = 0; r < 16; ++r) { p0[r] = NEG; p1[r] = NEG; } return; }
    { const f32x4 c0 = *(const f32x4*)(bl), c1 = *(const f32x4*)(bl + 32), c2 = *(const f32x4*)(bl + 64), c3 = *(const f32x4*)(bl + 96);
      const f32x4 e0 = *(const f32x4*)(bl + 128), e1 = *(const f32x4*)(bl + 160), e2 = *(const f32x4*)(bl + 192), e3 = *(const f32x4*)(bl + 224);
      p0 = (f32x16){c0[0], c0[1], c0[2], c0[3], c1[0], c1[1], c1[2], c1[3], c2[0], c2[1], c2[2], c2[3], c3[0], c3[1], c3[2], c3[3]};
      p1 = (f32x16){e0[0], e0[1], e0[2], e0[3], e1[0], e1[1], e1[2], e1[3], e2[0], e2[1], e2[2], e2[3], e3[0], e3[1], e3[2], e3[3]}; }
    const char* kb[4];
#pragma unroll
    for (int dd = 0; dd < 4; ++dd) kb[dd] = K_lds + KB * SHM_K + KSWZ(r32, (dd * 16 + hi * 8) * 2);
#pragma unroll
    for (int d0 = 0; d0 < 8; ++d0) { const char* a = kb[d0 & 3] + (d0 >> 2) * 128;
        bf16x8 b0 = *reinterpret_cast<const bf16x8*>(a);
        bf16x8 b1 = *reinterpret_cast<const bf16x8*>(a + 32 * 256);
        p0 = __builtin_amdgcn_mfma_f32_32x32x16_bf16(b0, qr[d0], p0, 0, 0, 0);
        p1 = __builtin_amdgcn_mfma_f32_32x32x16_bf16(b1, qr[d0], p1, 0, 0, 0); }
}
template <int VB, bool SK>
__device__ __forceinline__ void pv_tile(f32x16* o, int vb0, bf16x8 pa0, bf16x8 pa1, bf16x8 pa2, bf16x8 pa3, bool act) {
    if (SK && !act) return;
#define TRRD(dst, off) asm volatile("ds_read_b64_tr_b16 %0, %1 offset:%2" : "=&v"(dst) : "v"(vb0), "i"(off) : "memory")
#define PV_D0(d0) do { s16x4 l0, l1, l2, l3, h0, h1, h2, h3; constexpr int b_ = VB * SHM_V + v_rd_off(d0, 0, 0);     \
        TRRD(l0, b_); TRRD(h0, b_ + 2048); TRRD(l1, b_ + 4096); TRRD(h1, b_ + 6144); TRRD(l2, b_ + 8192); TRRD(h2, b_ + 10240); TRRD(l3, b_ + 12288); TRRD(h3, b_ + 14336); \
        asm volatile("s_waitcnt lgkmcnt(0)" ::: "memory"); SBAR();                 \
        o[d0] = __builtin_amdgcn_mfma_f32_32x32x16_bf16(pa0, (bf16x8){l0[0], l0[1], l0[2], l0[3], h0[0], h0[1], h0[2], h0[3]}, o[d0], 0, 0, 0);   \
        o[d0] = __builtin_amdgcn_mfma_f32_32x32x16_bf16(pa1, (bf16x8){l1[0], l1[1], l1[2], l1[3], h1[0], h1[1], h1[2], h1[3]}, o[d0], 0, 0, 0);   \
        o[d0] = __builtin_amdgcn_mfma_f32_32x32x16_bf16(pa2, (bf16x8){l2[0], l2[1], l2[2], l2[3], h2[0], h2[1], h2[2], h2[3]}, o[d0], 0, 0, 0);   \
        o[d0] = __builtin_amdgcn_mfma_f32_32x32x16_bf16(pa3, (bf16x8){l3[0], l3[1], l3[2], l3[3], h3[0], h3[1], h3[2], h3[3]}, o[d0], 0, 0, 0); } while (0)
    PV_D0(0); PV_D0(1); PV_D0(2); PV_D0(3);
#undef PV_D0
#undef TRRD
}

template <class TIn, class TOut> struct BlockRef { const TIn* Q; const TIn* K; const TIn* V; TOut* O; const TOut* Z; const float* C; int P0; };
template <class TIn> struct Seam {
    bf16x8 qr[8];
    bf16x8 st_v0, st_v1, st_k0, st_k1; f32x4 sf0, sf1, sf2, sf3;
    f32x4 tq[16];
};
__device__ __forceinline__ int swa_jlo(int P0, int W) { const int lowk = P0 - W + 1; return lowk > 0 ? lowk / KVBLK : 0; }
#define ROW(p, k0, rr) ((p) + (size_t)((k0) + (rr)) * D + sc)
#define VMW() asm volatile("s_waitcnt vmcnt(0)" ::: "memory")
#define VMWN(n) asm volatile("s_waitcnt vmcnt(%0)" :: "i"(n) : "memory")
#define SLOAD_H(Kp, Vp, k0) do { S.st_v0 = load8<TIn>(ROW(Vp, k0, sr)); S.st_v1 = load8<TIn>(ROW(Vp, k0, 32 + sr));              \
                         S.st_k0 = load8<TIn>(ROW(Kp, k0, sr)); S.st_k1 = load8<TIn>(ROW(Kp, k0, 32 + sr)); } while (0)
#define SWRITE_HK(bf) do { *(bf16x8*)(K_lds + (bf) * SHM_K + kws) = S.st_k0; *(bf16x8*)(K_lds + (bf) * SHM_K + kws + 32 * 256) = S.st_k1; } while (0)
#define SWRITE_HV(bf) do { *(bf16x8*)(V_lds + (bf) * SHM_V + vst0) = S.st_v0; *(bf16x8*)(V_lds + (bf) * SHM_V + vst1) = S.st_v1; } while (0)
#define SWRITE_H(bf) do { SWRITE_HV(bf); SWRITE_HK(bf); } while (0)
#define SLOAD_F(p, k0) do { S.sf0 = *(const f32x4*)ROW(p, k0, sr); S.sf1 = *(const f32x4*)(ROW(p, k0, sr) + 4);                \
                            S.sf2 = *(const f32x4*)ROW(p, k0, 32 + sr); S.sf3 = *(const f32x4*)(ROW(p, k0, 32 + sr) + 4); } while (0)
#define SWRITE_KF(bf) do { *(bf16x8*)(K_lds + (bf) * SHM_K + kws) = pack8(S.sf0, S.sf1); *(bf16x8*)(K_lds + (bf) * SHM_K + kws + 32 * 256) = pack8(S.sf2, S.sf3); } while (0)
#define SWRITE_VF(bf) do { *(bf16x8*)(V_lds + (bf) * SHM_V + vst0) = pack8(S.sf0, S.sf1); *(bf16x8*)(V_lds + (bf) * SHM_V + vst1) = pack8(S.sf2, S.sf3); } while (0)
template <class TIn, class TOut>
__device__ __forceinline__ void causal_swa_prime(const BlockRef<TIn, TOut>& cur, int W, char* lds, Seam<TIn>& S, int wave_s) {
    constexpr bool F32 = same_t<TIn, float>::v;
    const int tid = fresh_tid(wave_s), wid = __builtin_amdgcn_readfirstlane(tid >> 6), lane = tid & 63, r32 = lane & 31, hi = lane >> 5;
    const int sr = tid >> 4, sc = (tid & 15) * 8, kws = KSWZ(sr, sc * 2); char* K_lds = lds + 2 * SHM_V;
    const int kb0 = cur.P0 + QB - KVBLK;
    for (int d0 = 0; d0 < 8; ++d0) S.qr[d0] = load8<TIn>(cur.Q + (size_t)(wid * QBLK + r32) * D + d0 * 16 + hi * 8);
    if constexpr (F32) { SLOAD_F((const float*)cur.K, kb0); VMW(); SWRITE_KF(0); SBAR(); SLOAD_F((const float*)cur.V, kb0); }
    else { SLOAD_H(cur.K, cur.V, kb0); VMW(); SWRITE_HK(0); }
    __syncthreads();
}
template <class TIn, class TOut>
__device__ __forceinline__ void causal_swa_block(const BlockRef<TIn, TOut>& cur, const BlockRef<TIn, TOut>& nxt, int skv, int W, char* lds, Seam<TIn>& S, float TH, float TH2, int wave_s) {
    constexpr bool F32 = same_t<TIn, float>::v;
    const int tid = fresh_tid(wave_s), wid = __builtin_amdgcn_readfirstlane(tid >> 6), lane = tid & 63, r32 = lane & 31, hi = lane >> 5;
    int j_lo;
    int tq_ = tid; asm volatile("" : "+v"(tq_));
    { const int ntb = cur.P0 / KVBLK; const float ref = cur.C[cur.P0]; const int t0 = tq_ & 63, t1 = (tq_ & 63) + 64;
      const float v0 = t0 < ntb ? cur.C[t0 * KVBLK + KVBLK - 1] : ref, v1 = t1 < ntb ? cur.C[t1 * KVBLK + KVBLK - 1] : ref;
      j_lo = __builtin_amdgcn_readfirstlane((int)(__popcll(__ballot(ref - v0 > TH)) + __popcll(__ballot(ref - v1 > TH)))); }
    int j_hi = (cur.P0 + QB - 1) / KVBLK + 1; if (j_hi > skv / KVBLK) j_hi = skv / KVBLK;
    int NT = j_hi - j_lo;
    const int kbn = nxt.P0 + QB - KVBLK;
    const int qlo = cur.P0 + wid * QBLK, qm = qlo + r32 - 4 * hi;
    char* V_lds = lds; char* K_lds = lds + 2 * SHM_V;
    float* ws = (float*)(lds + 2 * SHM_V + 2 * SHM_K) + wid * 64; float* li_l = ws, * al_l = ws + 32;
    float m_reg = -1e30f, l_reg = 0; f32x16 o[4] = {};
    const int sr = tid >> 4, sc = (tid & 15) * 8, vst0 = v_st(sr, sc), vst1 = v_st(32 + sr, sc), kws = KSWZ(sr, sc * 2);
    const int vb0 = (int)(uintptr_t)V_lds + v_rd_base(lane);
    const TIn* Kh = cur.K; const TIn* Vh = cur.V;
    const char* bias0 = lds + BIAS_OFF + 16 * hi;
    { const int n4 = (cur.P0 + QB) >> 2; f32x4* bdst = (f32x4*)(lds + BIAS_OFF); const f32x4* bsrc = (const f32x4*)cur.C;
      for (int i = j_lo * (KVBLK / 4) + tq_; i < n4; i += 64 * NW) bdst[i] = bsrc[i];
      __syncthreads(); }
#define BIASP(t) (bias0 + KBASE(t) * 4)
#define RESC(a) do { if (__any((a) < 1.f)) { if (hi == 0) al_l[r32] = (a); asm volatile("s_waitcnt lgkmcnt(0)" ::: "memory");              \
                     for (int d_ = 0; d_ < 4; ++d_) for (int r = 0; r < 16; ++r) o[d_][r] *= al_l[crow(r, hi)]; } } while (0)
#define KBASE(t) ((j_hi - 1 - (t)) * KVBLK)
#define ACT(t) (KBASE(t) <= qlo + QBLK - 1 && KBASE(t) + KVBLK - 1 >= qlo - W + 1)
#define MASKT(P0_, P1_, t) do { const int kb_ = KBASE(t); if ((!SK || ACT(t)) && (kb_ + KVBLK - 1 > qlo || kb_ <= qlo + QBLK - 1 - W)) mask_tile(P0_, P1_, qm - kb_, (unsigned)W); } while (0)
    constexpr int NQL = F32 ? 16 : 8;
    constexpr bool SK = WSKIP && !F32;
#define SEAM_K0() do { VMWN(NQL); if constexpr (F32) { SWRITE_KF(0); SBAR(); SLOAD_F((const float*)nxt.V, kbn); } else { SWRITE_HK(0); } SBAR(); } while (0)
    f32x16 pA0, pA1, pB0, pB1; float mnA, mnB, alA, alB; bf16x8 pa0, pa1, pa2, pa3;
    if constexpr (F32) { VMW(); SWRITE_VF(0); SBAR(); } else { SWRITE_HV(0); SBAR(); }
    if (NT > 1) { if constexpr (F32) SLOAD_F((const float*)Kh, KBASE(1)); else SLOAD_H(Kh, Vh, KBASE(1)); }
    SBAR(); qkt<0, SK>(pA0, pA1, K_lds, r32, hi, S.qr, ACT(0), BIASP(0));
    if constexpr (F32) { if (NT > 1) { VMW(); SWRITE_KF(1); SBAR(); SLOAD_F((const float*)Vh, KBASE(1)); } }
    MASKT(pA0, pA1, 0); partialSM(pA0, pA1, m_reg, mnA, alA);
    if (NT > 1) { VMW(); if constexpr (F32) { SWRITE_VF(1); SBAR(); if (NT > 2) SLOAD_F((const float*)Kh, KBASE(2)); } else SWRITE_H(1); }
    __syncthreads();
#define HALF_STEP(PX0, PX1, mnX, alX, PY0, PY1, alY, t, KB, VB, SB) do {                                                      \
        SBAR(); qkt<KB, SK>(PX0, PX1, K_lds, r32, hi, S.qr, ACT(t), BIASP(t));                                             \
        finishSM(PY0, PY1, alY, l_reg, pa0, pa1, pa2, pa3); SBAR();                                                           \
        if ((t) + 1 < NT) { if constexpr (F32) { VMW(); SWRITE_KF(SB); SBAR(); SLOAD_F((const float*)Vh, KBASE((t) + 1)); }  \
                            else { SLOAD_H(Kh, Vh, KBASE((t) + 1)); } SBAR(); }                                               \
        pv_tile<VB, SK>(o, vb0, pa0, pa1, pa2, pa3, ACT((t) - 1)); MASKT(PX0, PX1, (t)); partialSM(PX0, PX1, m_reg, mnX, alX);                                        \
        __syncthreads();                                                                                                      \
        if ((t) + 1 < NT) { VMW(); if constexpr (F32) { SWRITE_VF(SB); SBAR(); if ((t) + 2 < NT) SLOAD_F((const float*)Kh, KBASE((t) + 2)); } \
                            else { SWRITE_H(SB); } }                                                                          \
        RESC(alX); __syncthreads(); } while (0)
    for (int t = 1; t + 1 < NT; t += 2) {
        HALF_STEP(pB0, pB1, mnB, alB, pA0, pA1, alA, t, 1, 0, 0);
        HALF_STEP(pA0, pA1, mnA, alA, pB0, pB1, alB, t + 1, 0, 1, 1);
        if (t == 3) {
            float mm = m_reg;
#pragma unroll
            for (int o_ = 1; o_ < 64; o_ <<= 1) mm = fminf(mm, __shfl_xor(mm, o_));
            float* mmw = (float*)(lds + BIAS_OFF - 1024);
            if (lane == 0) mmw[wid] = mm;
            __syncthreads();
            float bm = fminf(fminf(fminf(mmw[0], mmw[1]), fminf(mmw[2], mmw[3])), fminf(fminf(mmw[4], mmw[5]), fminf(mmw[6], mmw[7]))) - TH2;
            const int ntb = cur.P0 / KVBLK, t0 = j_lo + lane, t1 = j_lo + lane + 64;
            const float b0_ = t0 < ntb ? *(const float*)(lds + BIAS_OFF + (t0 * KVBLK + KVBLK - 1) * 4) : bm, b1_ = t1 < ntb ? *(const float*)(lds + BIAS_OFF + (t1 * KVBLK + KVBLK - 1) * 4) : bm;
            const int skip = __builtin_amdgcn_readfirstlane((int)(__popcll(__ballot(b0_ < bm)) + __popcll(__ballot(b1_ < bm))));
            int nt2 = NT - skip; if (nt2 < 5) nt2 = 5;
            if (nt2 < NT) NT = nt2;
        }
    }
    const bool even = (NT & 1) == 0;
    if (even) { SBAR(); qkt<1, SK>(pB0, pB1, K_lds, r32, hi, S.qr, ACT(NT - 1), BIASP(NT - 1)); SBAR(); }
#define QROW(e) (nxt.Q + (size_t)(wid * QBLK + r32) * D + ((e) >> 1) * 16 + hi * 8 + ((e) & 1) * 4)
    if constexpr (F32) { SLOAD_F((const float*)nxt.K, kbn); SBAR();
#pragma unroll
        for (int e = 0; e < 8; ++e) S.tq[e] = *(const f32x4*)QROW(e); }
    else { SLOAD_H(nxt.K, nxt.V, kbn); SBAR();
#pragma unroll
        for (int d0 = 0; d0 < 8; ++d0) S.qr[d0] = load8<TIn>(nxt.Q + (size_t)(wid * QBLK + r32) * D + d0 * 16 + hi * 8); }
    SBAR();
    finishSM(pA0, pA1, alA, l_reg, pa0, pa1, pa2, pa3); SBAR();
    if constexpr (F32) {
#pragma unroll
        for (int e = 8; e < 16; ++e) S.tq[e] = *(const f32x4*)QROW(e); SBAR(); }
#undef QROW
    pv_tile<0, SK>(o, vb0, pa0, pa1, pa2, pa3, ACT(even ? NT - 2 : NT - 1));
    if (even) { MASKT(pB0, pB1, NT - 1); partialSM(pB0, pB1, m_reg, mnB, alB); __syncthreads(); RESC(alB);
        finishSM(pB0, pB1, alB, l_reg, pa0, pa1, pa2, pa3); SBAR(); pv_tile<1, SK>(o, vb0, pa0, pa1, pa2, pa3, ACT(NT - 1)); }
    SBAR(); SEAM_K0();
    if (hi == 0) li_l[r32] = l_reg; asm volatile("s_waitcnt lgkmcnt(0)" ::: "memory");
    float rli[16];
#pragma unroll
    for (int r = 0; r < 16; ++r) rli[r] = __builtin_amdgcn_rcpf(li_l[crow(r, hi)]);
    int eo = (wid * QBLK + 4 * hi) * OSTR + r32; asm volatile("" : "+v"(eo));
    TOut* Ow = cur.O + eo; const TOut* Zw = cur.Z + eo;
#pragma unroll
    for (int r = 0; r < 16; ++r) { const int orow = ((r & 3) + 8 * (r >> 2)) * OSTR;
#pragma unroll
        for (int d0 = 0; d0 < 4; ++d0) { const float v = o[d0][r] * rli[r] * __bfloat162float(Zw[orow + d0 * 32]);
            if constexpr (same_t<TOut, float>::v) { Ow[orow + d0 * 32] = v; }
            else { const float vn = __shfl_xor(v, 1);
                   if ((r32 & 1) == 0) *(unsigned*)(Ow + orow + d0 * 32) = cvtpk(v, vn); } } }
    if constexpr (F32) {
#pragma unroll
        for (int d0 = 0; d0 < 8; ++d0) S.qr[d0] = pack8(S.tq[2 * d0], S.tq[2 * d0 + 1]); }
    __syncthreads();
#undef RESC
#undef BIASP
#undef KBASE
#undef ACT
#undef MASKT
#undef SEAM_K0
#undef HALF_STEP
}
#undef ROW
#undef VMW
#undef VMWN
#undef SLOAD_H
#undef SWRITE_HK
#undef SWRITE_HV
#undef SWRITE_H
#undef SLOAD_F
#undef SWRITE_KF
#undef SWRITE_VF

__host__ __device__ inline int swa_nramp(int nqb, int W, int qoff) { const int t = W - 1 - qoff; const int n = t < 0 ? 0 : t / QB + 1; return n > nqb ? nqb : n; }
__host__ __device__ inline int swa_nx(int nqb, int nramp, int order) { return (order & ORDER_PAIRED) ? (nramp + 1) / 2 + (nqb - nramp) : nqb; }
struct SwaItem { int bh, qb0, qb1; };
__device__ __forceinline__ SwaItem swa_decode(int L, int nb, int nh, int nhkv, int nqb, int nx, int nramp, int order) {
    const int G = nh / nhkv; SwaItem it; int x;
    if ((order & ORDER_XCD) && (nb * nhkv) % 8 == 0) { const int xcd = L & 7, k = L >> 3, per = G * nx, gi = k / per, r = k - gi * per;
        it.bh = (gi * 8 + xcd) * G + r / nx; x = r % nx; }
    else { it.bh = L / nx; x = L - it.bh * nx; }
    if (order & ORDER_PAIRED) { const int ns = nqb - nramp;
        if (x < ns) { it.qb0 = it.qb1 = nqb - 1 - x; } else { it.qb0 = x - ns; it.qb1 = nramp - 1 - it.qb0; } }
    else { it.qb0 = it.qb1 = ((order & 3) == ORDER_REVERSED) ? nqb - 1 - x : x; }
    return it;
}
template <class TIn, class TOut>
__device__ __forceinline__ BlockRef<TIn, TOut> mk_ref(const SwaItem& it, int pass, const TIn* Qb, const TIn* Kb, const TIn* Vb, TOut* Ob, const TOut* Zb, const float* Cb, int seq) {
    const int qb = pass ? it.qb1 : it.qb0, bb = it.bh >> 4, hh = it.bh & 15; BlockRef<TIn, TOut> r;
    r.Q = Qb + ((size_t)it.bh * seq + (size_t)qb * QB) * D; r.K = Kb + (size_t)it.bh * seq * D; r.V = Vb + (size_t)it.bh * seq * D;
    r.O = Ob + ((size_t)bb * seq + (size_t)qb * QB) * OSTR + hh * D; r.Z = Zb + ((size_t)bb * seq + (size_t)qb * QB) * OSTR + hh * D;
    r.C = Cb + (size_t)it.bh * seq; r.P0 = qb * QB; return r;
}
}

#define LAS __attribute__((address_space(3)))
typedef unsigned short bf16r;
typedef float f32x4 __attribute__((ext_vector_type(4)));
typedef float f32x2 __attribute__((ext_vector_type(2)));
typedef unsigned u32x4 __attribute__((ext_vector_type(4)));
typedef unsigned u32x2 __attribute__((ext_vector_type(2)));
typedef short bf16x8 __attribute__((ext_vector_type(8)));
constexpr int BATCH = 4, SEQ = 8192, DM = 2048, M = BATCH * SEQ, NH = 16, PLE = 256;
constexpr int NFOX = 4 * DM + NH, NFOXP = 8448;
constexpr float EPS = 1e-6f;
constexpr size_t MiB = (size_t)1 << 20;
constexpr size_t WS_GBUF = 65536, WS_NEGC = 1 * MiB, WS_LOGF = 3 * MiB, WS_SS = 5 * MiB, WS_RSTD = 9 * MiB;
constexpr size_t WS_WFOX = 16 * MiB, WS_WOF = 49 * MiB, WS_WHG = 57 * MiB, WS_WOH = 89 * MiB, WS_WPE = 97 * MiB, WS_WPG = 99 * MiB, WS_PB = 116 * MiB;
constexpr size_t WS_A = 148 * MiB, WS_B = 276 * MiB, WS_C = 404 * MiB, WS_D = 532 * MiB, WS_E = 660 * MiB, WS_F = 788 * MiB, WS_END = 916 * MiB;
constexpr int NTHR = 512, NWAVES = 8;
constexpr int LDS_BYTES = 147456;

#define LDS_WAIT() asm volatile("s_waitcnt lgkmcnt(0)" ::: "memory")
#define HBAR() do { asm volatile("s_waitcnt lgkmcnt(0)" ::: "memory"); __builtin_amdgcn_s_barrier(); asm volatile("" ::: "memory"); } while (0)

__device__ __forceinline__ float wave_sum(float v) {
#pragma unroll
    for (int o = 1; o < 64; o <<= 1) v += __shfl_xor(v, o);
    return v;
}
__device__ __forceinline__ u32x4 pack8(const f32x4 a, const f32x4 b) { u32x4 w; w.x = cvtpk_s(a[0], a[1]); w.y = cvtpk_s(a[2], a[3]); w.z = cvtpk_s(b[0], b[1]); w.w = cvtpk_s(b[2], b[3]); return w; }

__device__ __forceinline__ void transpose_item(const float* W, int ldw, int K, int nblk, bf16r* WT, const float* kscale, LAS float* scr, int item, int lane) {
    const int kb = item / nblk, nb = item - kb * nblk, k0 = 64 * kb, n0 = 32 * nb;
#pragma unroll 8
    for (int i = 0; i < 32; ++i) { const int kk = 2 * i + (lane >> 5); float v = W[(size_t)(k0 + kk) * ldw + n0 + (lane & 31)]; if (kscale) v *= kscale[k0 + kk]; scr[kk * 33 + (lane & 31)] = v; }
    LDS_WAIT(); asm volatile("" ::: "memory");
    const int c = lane & 7;
#pragma unroll
    for (int j = 0; j < 4; ++j) { const int n = (lane >> 3) + 8 * j; const LAS float* s = scr + (8 * c) * 33 + n;
        u32x4 o; o.x = cvtpk_s(s[0 * 33], s[1 * 33]); o.y = cvtpk_s(s[2 * 33], s[3 * 33]); o.z = cvtpk_s(s[4 * 33], s[5 * 33]); o.w = cvtpk_s(s[6 * 33], s[7 * 33]);
        *(u32x4*)(WT + (size_t)(n0 + n) * K + k0 + 8 * c) = o; }
    LDS_WAIT(); asm volatile("" ::: "memory");
}

#define XB_TMO      128
#define XB_XCNT(j)  (256  + 64 * (j))
#define XB_XSUB(j)  (1280 + 64 * (j))
#define XB_XGEN(j)  (2304 + 64 * (j))
#define XB_TOP      3328
#define XB_TOPGEN   3392
#define XCD_BAR_WORDS 3456
#define XB_SPIN_CAP (1u << 18)

__device__ __forceinline__ unsigned xb_ld(unsigned* p)              { return __hip_atomic_load(p, __ATOMIC_RELAXED, __HIP_MEMORY_SCOPE_AGENT); }
__device__ __forceinline__ unsigned xb_add(unsigned* p, unsigned v) { return __hip_atomic_fetch_add(p, v, __ATOMIC_RELAXED, __HIP_MEMORY_SCOPE_AGENT); }
__device__ __forceinline__ unsigned xb_xcc_id() { return (unsigned)__builtin_amdgcn_s_getreg((3 << 11) | 20) & 0xFu; }
#define XB_SPIN(cond, bar) do { unsigned _sp = 0; while (cond) { __builtin_amdgcn_s_sleep(1); \
    if ((++_sp & 255u) == 0u) { if (xb_ld(&(bar)[XB_TMO])) break; if (_sp > XB_SPIN_CAP) { atomicAdd(&(bar)[XB_TMO], 1u); break; } } } } while (0)

struct XcdBarrier {
    unsigned* bar; unsigned x; int wv;
    volatile LAS unsigned* st;
};

__device__ __forceinline__ XcdBarrier xcd_barrier_post(unsigned* bar, volatile LAS unsigned* st, int wave_s) {
    XcdBarrier b; b.bar = bar; b.x = xb_xcc_id(); b.st = st; b.wv = wave_s;
    if (fresh_tid(wave_s) == 0) (void)xb_add(&bar[XB_XCNT(b.x)], 1u);
    return b;
}
__device__ __forceinline__ void xcd_barrier_complete(unsigned* bar, unsigned x, unsigned& nloc, unsigned& nx) {
    const unsigned G = gridDim.x * gridDim.y * gridDim.z;
    unsigned sum, cnt, mine, sp = 0u;
    for (;;) {
        sum = 0u; cnt = 0u; mine = 0u;
#pragma unroll
        for (unsigned j = 0; j < 16; ++j) { const unsigned c = xb_ld(&bar[XB_XCNT(j)]); sum += c; cnt += (c > 0u) ? 1u : 0u; mine = (j == x) ? c : mine; }
        if (sum == G) break;
        __builtin_amdgcn_s_sleep(1);
        if ((++sp & 255u) == 0u) { if (xb_ld(&bar[XB_TMO])) break; if (sp > XB_SPIN_CAP) { atomicAdd(&bar[XB_TMO], 1u); break; } }
    }
    nloc = mine > 0u ? mine : 1u; nx = cnt > 0u ? cnt : 1u;
}

__device__ __forceinline__ void xcd_barrier(const XcdBarrier& b) {
    asm volatile("s_waitcnt vmcnt(0)" ::: "memory");
    __syncthreads();
    if (fresh_tid(b.wv) == 0) {
        unsigned* bar = b.bar;
        __builtin_amdgcn_s_waitcnt(0);
        unsigned nloc = b.st[0], nx = b.st[1];
        if (nloc == 0u) { xcd_barrier_complete(bar, b.x, nloc, nx); b.st[0] = nloc; b.st[1] = nx; }
        const unsigned old = xb_add(&bar[XB_XSUB(b.x)], 1u);
        const unsigned gen = old / nloc;
        if (old + 1u == (gen + 1u) * nloc) {
            __builtin_amdgcn_fence(__ATOMIC_RELEASE, "agent");
            asm volatile("s_waitcnt vmcnt(0)" ::: "memory");
            const unsigned og = xb_add(&bar[XB_TOP], 1u);
            const unsigned tg = og / nx;
            if (og + 1u == (tg + 1u) * nx) xb_add(&bar[XB_TOPGEN], 1u);
            else XB_SPIN(xb_ld(&bar[XB_TOPGEN]) == tg, bar);
            __builtin_amdgcn_fence(__ATOMIC_ACQUIRE, "agent");
            xb_add(&bar[XB_XGEN(b.x)], 1u);
            asm volatile("s_waitcnt vmcnt(0)" ::: "memory");
        } else {
            XB_SPIN(xb_ld(&bar[XB_XGEN(b.x)]) == gen, bar);
            __builtin_amdgcn_fence(__ATOMIC_ACQUIRE, "agent");
            asm volatile("s_waitcnt vmcnt(0)" ::: "memory");
        }
    }
    __syncthreads();
}

#ifndef REP
#define REP 0
#endif
#define PH_LOOP_ { int nrep_ = 2; asm volatile("" : "+s"(nrep_)); for (int rep_ = 0; rep_ < nrep_; ++rep_) {
#define PH_LOOPEND_ } }
#if (REP >> 0) & 1
#define PH_BEGIN_0 PH_LOOP_
#define PH_END_0 PH_LOOPEND_
#else
#define PH_BEGIN_0 {
#define PH_END_0 }
#endif
#if (REP >> 1) & 1
#define PH_BEGIN_1 PH_LOOP_
#define PH_END_1 PH_LOOPEND_
#else
#define PH_BEGIN_1 {
#define PH_END_1 }
#endif
#if (REP >> 2) & 1
#define PH_BEGIN_2 PH_LOOP_
#define PH_END_2 PH_LOOPEND_
#else
#define PH_BEGIN_2 {
#define PH_END_2 }
#endif
#if (REP >> 3) & 1
#define PH_BEGIN_3 PH_LOOP_
#define PH_END_3 PH_LOOPEND_
#else
#define PH_BEGIN_3 {
#define PH_END_3 }
#endif
#if (REP >> 4) & 1
#define PH_BEGIN_4 PH_LOOP_
#define PH_END_4 PH_LOOPEND_
#else
#define PH_BEGIN_4 {
#define PH_END_4 }
#endif
#if (REP >> 5) & 1
#define PH_BEGIN_5 PH_LOOP_
#define PH_END_5 PH_LOOPEND_
#else
#define PH_BEGIN_5 {
#define PH_END_5 }
#endif
#if (REP >> 6) & 1
#define PH_BEGIN_6 PH_LOOP_
#define PH_END_6 PH_LOOPEND_
#else
#define PH_BEGIN_6 {
#define PH_END_6 }
#endif
#if (REP >> 7) & 1
#define PH_BEGIN_7 PH_LOOP_
#define PH_END_7 PH_LOOPEND_
#else
#define PH_BEGIN_7 {
#define PH_END_7 }
#endif
struct Args { const float* in[15]; float* out; unsigned char* ws; };

namespace hg {
constexpr int QS = 272, TS = 144;
constexpr int SET_BYTES = 58368, OFF_Q = 0, OFF_K = 17408, OFF_KT = 34816, OFF_VT = 53248, OFF_DL = 57856;
constexpr int OFF_ST = 2 * SET_BYTES, ST_BYTES = 8704;
#define MFMA16(a, b, c) __builtin_amdgcn_mfma_f32_16x16x32_bf16((a), (b), (c), 0, 0, 0)
__device__ __forceinline__ float mulx(bool fma_form, float a, float b) { return fma_form ? __builtin_fmaf(a, b, 0.f) : a * b; }
__device__ __forceinline__ float omx(bool fma_form, float f) { return fma_form ? __builtin_fmaf(-1.f, f, 1.f) : 1.f - f; }
template <int SET> __device__ __forceinline__ void hgE(LAS unsigned char* lds, const f32x2 (&gv)[16], const unsigned (&qv)[16], int w, int lane) {
    LAS unsigned char* base = lds + SET * SET_BYTES;
    const int cp = lane & 15, rg = lane >> 4;
    float run0 = 1.f, run1 = 1.f;
#pragma unroll
    for (int j = 0; j < 16; ++j) { run0 = mulx(j & 1, run0, gv[j].x); run1 = mulx(!(j & 1), run1, gv[j].y); }
    float i0 = run0, i1 = run1;
    { const float a0 = __shfl_up(i0, 16), a1 = __shfl_up(i1, 16); if (rg >= 1) { i0 = mulx(false, i0, a0); i1 = mulx(true, i1, a1); } }
    { const float a0 = __shfl_up(i0, 32), a1 = __shfl_up(i1, 32); if (rg >= 2) { i0 = mulx(false, i0, a0); i1 = mulx(true, i1, a1); } }
    float pre0 = __shfl_up(i0, 16), pre1 = __shfl_up(i1, 16); if (rg == 0) { pre0 = 1.f; pre1 = 1.f; }
    const float all0 = __shfl(i0, cp + 48), all1 = __shfl(i1, cp + 48);
    unsigned kh0[8], kh1[8]; float kp0 = 0.f, kp1 = 0.f, ea = pre0, eb = pre1;
    LAS unsigned char* qw = base + OFF_Q + (16 * rg) * QS + (32 * w + 2 * cp) * 2;
#pragma unroll
    for (int j = 0; j < 16; ++j) { const bool f0 = (j & 1) != 0, f1 = !f0;
        ea = mulx(f0, ea, gv[j].x); eb = mulx(f1, eb, gv[j].y);
        const float qa = mulx(f0, bf_lo(qv[j]), ea), qb = mulx(f1, bf_hi(qv[j]), eb);
        const float ka = mulx(f0, omx(f0, gv[j].x), __builtin_amdgcn_rcpf(ea)), kb = mulx(f1, omx(f1, gv[j].y), __builtin_amdgcn_rcpf(eb));
        *(LAS unsigned*)(qw + j * QS) = cvtpk_s(qa, qb);
        *(LAS unsigned*)(qw + (OFF_K - OFF_Q) + j * QS) = cvtpk_s(ka, kb);
        const float ha = mulx(f0, ka, all0), hb = mulx(f1, kb, all1);
        if (j & 1) { kh0[j >> 1] = cvtpk_s(kp0, ha); kh1[j >> 1] = cvtpk_s(kp1, hb); } else { kp0 = ha; kp1 = hb; }
    }
    LAS unsigned char* kw = base + OFF_KT + (32 * w + 2 * cp) * TS + rg * 32;
    *(LAS u32x4*)(kw) = (u32x4){kh0[0], kh0[1], kh0[2], kh0[3]}; *(LAS u32x4*)(kw + 16) = (u32x4){kh0[4], kh0[5], kh0[6], kh0[7]};
    *(LAS u32x4*)(kw + TS) = (u32x4){kh1[0], kh1[1], kh1[2], kh1[3]}; *(LAS u32x4*)(kw + TS + 16) = (u32x4){kh1[4], kh1[5], kh1[6], kh1[7]};
    if (rg == 0) *(LAS f32x2*)(base + OFF_DL + (32 * w + 2 * cp) * 4) = (f32x2){all0, all1};
}
__device__ __forceinline__ void hgE4(LAS unsigned char* lds, int set, const f32x4 (&gv)[8], const u32x2 (&qv)[8], int w, int lane) {
    LAS unsigned char* base = lds + set * SET_BYTES;
    const int c4 = lane & 7, rg = lane >> 3;
    float run[4] = {1.f, 1.f, 1.f, 1.f};
#pragma unroll
    for (int j = 0; j < 8; ++j)
#pragma unroll
        for (int k = 0; k < 4; ++k) run[k] = mulx((j + k) & 1, run[k], gv[j][k]);
    float inc[4], pre[4], all[4], e[4];
#pragma unroll
    for (int k = 0; k < 4; ++k) { float v = run[k];
        { const float a = __shfl_up(v, 8); if (rg >= 1) v = mulx(k & 1, v, a); }
        { const float a = __shfl_up(v, 16); if (rg >= 2) v = mulx(!(k & 1), v, a); }
        { const float a = __shfl_up(v, 32); if (rg >= 4) v = mulx(k & 1, v, a); }
        inc[k] = v; }
#pragma unroll
    for (int k = 0; k < 4; ++k) { pre[k] = __shfl_up(inc[k], 8); if (rg == 0) pre[k] = 1.f; all[k] = __shfl(inc[k], c4 + 56); e[k] = pre[k]; }
    float kt[4][8];
    LAS unsigned char* qw = base + OFF_Q + (8 * rg) * QS + (32 * w + 4 * c4) * 2;
#pragma unroll
    for (int j = 0; j < 8; ++j) { float qt[4], kk[4]; const float qf[4] = {bf_lo(qv[j].x), bf_hi(qv[j].x), bf_lo(qv[j].y), bf_hi(qv[j].y)};
#pragma unroll
        for (int k = 0; k < 4; ++k) { const bool f = ((j + k) & 1) != 0;
            e[k] = mulx(f, e[k], gv[j][k]); qt[k] = mulx(f, qf[k], e[k]); kk[k] = mulx(f, omx(f, gv[j][k]), __builtin_amdgcn_rcpf(e[k])); kt[k][j] = mulx(f, kk[k], all[k]); }
        *(LAS u32x2*)(qw + j * QS) = (u32x2){cvtpk_s(qt[0], qt[1]), cvtpk_s(qt[2], qt[3])};
        *(LAS u32x2*)(qw + (OFF_K - OFF_Q) + j * QS) = (u32x2){cvtpk_s(kk[0], kk[1]), cvtpk_s(kk[2], kk[3])};
    }
#pragma unroll
    for (int k = 0; k < 4; ++k)
        *(LAS u32x4*)(base + OFF_KT + (32 * w + 4 * c4 + k) * TS + rg * 16) = (u32x4){cvtpk_s(kt[k][0], kt[k][1]), cvtpk_s(kt[k][2], kt[k][3]), cvtpk_s(kt[k][4], kt[k][5]), cvtpk_s(kt[k][6], kt[k][7])};
    if (rg == 0) *(LAS f32x4*)(base + OFF_DL + (32 * w + 4 * c4) * 4) = (f32x4){all[0], all[1], all[2], all[3]};
}
template <int SET, int VAR = 0> __device__ __forceinline__ void hgM(LAS unsigned char* lds, f32x4 (&st)[2][2], int ti, int lane, char* ob, unsigned ol) {
    const int l16 = lane & 15, kq = lane >> 4;
    const LAS unsigned char* base = lds + SET * SET_BYTES;
    bf16x8 qf[4], kf[4][4], sb[2][4], kt[2][2], vv[2][2]; u32x2 va[2][2], vb2[2][2]; f32x4 dl[2];
    const LAS unsigned char* qrow = base + OFF_Q + (16 * ti + l16) * QS + kq * 16;
    const LAS unsigned char* krow = base + OFF_K + l16 * QS + kq * 16;
    const LAS unsigned char* srow = lds + OFF_ST + SET * ST_BYTES + l16 * QS + kq * 16;
    const LAS unsigned char* vrow = base + OFF_VT + l16 * TS;
#pragma unroll
    for (int kk = 0; kk < 4; ++kk) { qf[kk] = *(const LAS bf16x8*)(qrow + kk * 64); sb[0][kk] = *(const LAS bf16x8*)(srow + kk * 64); sb[1][kk] = *(const LAS bf16x8*)(srow + 16 * QS + kk * 64); }
#pragma unroll
    for (int si = 0; si < 4; ++si)
#pragma unroll
        for (int kk = 0; kk < 4; ++kk) kf[si][kk] = *(const LAS bf16x8*)(krow + si * 16 * QS + kk * 64);
#pragma unroll
    for (int vh = 0; vh < 2; ++vh)
#pragma unroll
        for (int p = 0; p < 2; ++p) { va[vh][p] = *(const LAS u32x2*)(vrow + vh * 16 * TS + kq * 8 + p * 64); vb2[vh][p] = *(const LAS u32x2*)(vrow + vh * 16 * TS + kq * 8 + p * 64 + 32); }
#pragma unroll
    for (int kk = 0; kk < 2; ++kk) { vv[0][kk] = *(const LAS bf16x8*)(vrow + kk * 64 + kq * 16); vv[1][kk] = *(const LAS bf16x8*)(vrow + 16 * TS + kk * 64 + kq * 16);
        kt[0][kk] = *(const LAS bf16x8*)(base + OFF_KT + (32 * ti + l16) * TS + kk * 64 + kq * 16); kt[1][kk] = *(const LAS bf16x8*)(base + OFF_KT + (32 * ti + 16 + l16) * TS + kk * 64 + kq * 16); }
    dl[0] = *(const LAS f32x4*)(base + OFF_DL + (32 * ti + 4 * kq) * 4); dl[1] = *(const LAS f32x4*)(base + OFF_DL + (32 * ti + 16 + 4 * kq) * 4);
    __builtin_amdgcn_sched_barrier(0);
    f32x4 o[2], as[4];
    o[0] = (f32x4){0.f, 0.f, 0.f, 0.f}; o[1] = o[0];
#pragma unroll
    for (int si = 0; si < 4; ++si) as[si] = (f32x4){0.f, 0.f, 0.f, 0.f};
#pragma unroll
    for (int kk = 0; kk < 4; ++kk) { o[0] = MFMA16(qf[kk], sb[0][kk], o[0]); o[1] = MFMA16(qf[kk], sb[1][kk], o[1]);
#pragma unroll
        for (int si = 0; si < 4; ++si) as[si] = MFMA16(kf[si][kk], qf[kk], as[si]); }
#pragma unroll
    for (int ds = 0; ds < 2; ++ds)
#pragma unroll
        for (int vh = 0; vh < 2; ++vh) { st[ds][vh] = st[ds][vh] * dl[ds];
#pragma unroll
            for (int kk = 0; kk < 2; ++kk) st[ds][vh] = MFMA16(kt[ds][kk], vv[vh][kk], st[ds][vh]); }
    const int tq = 16 * ti + l16 - 4 * kq;
#pragma unroll
    for (int si = 0; si < 4; ++si)
#pragma unroll
        for (int j = 0; j < 4; ++j) if (16 * si + j > tq) as[si][j] = 0.f;
#pragma unroll
    for (int p = 0; p < 2; ++p) {
        u32x4 pw; pw.x = cvtpk_s(as[2 * p][0], as[2 * p][1]); pw.y = cvtpk_s(as[2 * p][2], as[2 * p][3]); pw.z = cvtpk_s(as[2 * p + 1][0], as[2 * p + 1][1]); pw.w = cvtpk_s(as[2 * p + 1][2], as[2 * p + 1][3]);
#pragma unroll
        for (int vh = 0; vh < 2; ++vh) { const u32x4 vw = {va[vh][p].x, va[vh][p].y, vb2[vh][p].x, vb2[vh][p].y};
            o[vh] = MFMA16(__builtin_bit_cast(bf16x8, pw), __builtin_bit_cast(bf16x8, vw), o[vh]); }
    }
    if ((VAR & 1) == 0 || o[0][0] == 12345.678f) {
#pragma unroll
    for (int vh = 0; vh < 2; ++vh)
#pragma unroll
        for (int j = 0; j < 4; ++j) *(bf16r*)(ob + (size_t)j * DM * 2 + vh * 32 + ol) = (bf16r)(cvtpk_s(o[vh][j], 0.f) & 0xffffu);
    }
#pragma unroll
    for (int ds = 0; ds < 2; ++ds)
#pragma unroll
        for (int vh = 0; vh < 2; ++vh)
            *(LAS u32x2*)(lds + OFF_ST + (SET ^ 1) * ST_BYTES + (16 * vh + l16) * QS + (32 * ti + 16 * ds + 4 * kq) * 2) = (u32x2){cvtpk_s(st[ds][vh][0], st[ds][vh][1]), cvtpk_s(st[ds][vh][2], st[ds][vh][3])};
}
template <int SET> __device__ __forceinline__ void hgV(LAS unsigned char* lds, const u32x4& v, int mt) {
    LAS bf16r* vt = (LAS bf16r*)(lds + SET * SET_BYTES + OFF_VT + (mt & 3) * 8 * TS + (mt >> 2) * 2);
    vt[0] = (bf16r)(v.x & 0xffffu); vt[TS / 2] = (bf16r)(v.x >> 16); vt[2 * (TS / 2)] = (bf16r)(v.y & 0xffffu); vt[3 * (TS / 2)] = (bf16r)(v.y >> 16);
    vt[4 * (TS / 2)] = (bf16r)(v.z & 0xffffu); vt[5 * (TS / 2)] = (bf16r)(v.z >> 16); vt[6 * (TS / 2)] = (bf16r)(v.w & 0xffffu); vt[7 * (TS / 2)] = (bf16r)(v.w >> 16);
}
template <int VAR = 0> __device__ __forceinline__ void hgrn_item(LAS unsigned char* lds, const bf16r* SQ, const float* G, const bf16r* V, bf16r* O, int item, int tid_in) {
    const int tid = tid_in, lane = tid & 63, w = __builtin_amdgcn_readfirstlane(tid >> 6);
    const int bh = item >> 2, vs = item & 3, b = bh >> 4, h = bh & 15;
    const size_t rowbase = (size_t)b * SEQ;
    constexpr int NC = SEQ / 64;
    if (w < 4) {
        const int c4 = lane & 7, rg = lane >> 3;
        const float* gp = G + (rowbase + 8 * rg) * DM + h * 128 + 32 * w + 4 * c4;
        const bf16r* qp = SQ + (rowbase + 8 * rg) * DM + h * 128 + 32 * w + 4 * c4;
        f32x4 gvA[8], gvB[8], gvC[8]; u32x2 qvA[8], qvB[8], qvC[8];
#define HG_LOADE(GV, QV, c_) do { const int cc_ = (c_) < NC ? (c_) : NC - 1; const size_t adv_ = (size_t)cc_ * 64 * DM; _Pragma("unroll") for (int j = 0; j < 8; ++j) { GV[j] = *(const f32x4*)(gp + adv_ + (size_t)j * DM); QV[j] = *(const u32x2*)(qp + adv_ + (size_t)j * DM); } } while (0)
        HG_LOADE(gvA, qvA, 0); HG_LOADE(gvB, qvB, 1); HG_LOADE(gvC, qvC, 2);
        hgE4(lds, 0, gvA, qvA, w, lane); HG_LOADE(gvA, qvA, 3);
        HBAR();
        for (int c = 0; c < 129; c += 3) {
            hgE4(lds, (c + 1) & 1, gvB, qvB, w, lane); HG_LOADE(gvB, qvB, c + 4); HBAR();
            hgE4(lds, (c + 2) & 1, gvC, qvC, w, lane); HG_LOADE(gvC, qvC, c + 5); HBAR();
            hgE4(lds, (c + 3) & 1, gvA, qvA, w, lane); HG_LOADE(gvA, qvA, c + 6); HBAR();
        }
#undef HG_LOADE
    } else {
        const int ti = w - 4, mt = tid - 256, l16 = lane & 15, kq = lane >> 4;
        const bf16r* vp = V + (rowbase + (mt >> 2)) * DM + h * 128 + vs * 32 + (mt & 3) * 8;
        char* ob = (char*)(O + (rowbase + 16 * ti) * DM + h * 128 + vs * 32);
        const unsigned ol = (4 * kq * DM + l16) * 2;
        for (int i = mt; i < ST_BYTES / 4; i += 256) ((LAS unsigned*)(lds + OFF_ST))[i] = 0u;
        f32x4 st[2][2];
#pragma unroll
        for (int ds = 0; ds < 2; ++ds) { st[ds][0] = (f32x4){0.f, 0.f, 0.f, 0.f}; st[ds][1] = st[ds][0]; }
        u32x4 vA = *(const u32x4*)vp, vB = *(const u32x4*)(vp + (size_t)64 * DM);
        hgV<0>(lds, vA, mt); vA = *(const u32x4*)(vp + (size_t)2 * 64 * DM);
        HBAR();
        for (int c = 0; c < NC; c += 2) {
            if ((VAR & 4) == 0) hgM<0, VAR>(lds, st, ti, lane, ob + (size_t)c * 64 * DM * 2, ol);
            hgV<1>(lds, vB, mt); vB = *(const u32x4*)(vp + (size_t)(c + 3 < NC ? c + 3 : NC - 1) * 64 * DM);
            HBAR();
            if ((VAR & 4) == 0) hgM<1, VAR>(lds, st, ti, lane, ob + (size_t)(c + 1) * 64 * DM * 2, ol);
            hgV<0>(lds, vA, mt); vA = *(const u32x4*)(vp + (size_t)(c + 4 < NC ? c + 4 : NC - 1) * 64 * DM);
            HBAR();
        }
        HBAR();
    }
}
}

__global__ void __launch_bounds__(NTHR, 2) fwd_megakernel(Args args) {
    extern __shared__ __attribute__((aligned(16))) unsigned char lds_raw[];
    cg::grid_group grid = cg::this_grid();
    LAS unsigned char* lds = (LAS unsigned char*)lds_raw;
    const int G = gridDim.x, NGW = G * NWAVES, NGT = G * NTHR;
    const int wave_s = __builtin_amdgcn_readfirstlane((int)threadIdx.x >> 6);
    { const int t0_ = fresh_tid(wave_s); if (t0_ < 2) ((volatile LAS unsigned*)(lds + 147008))[t0_] = 0u; }
    __syncthreads();
    const XcdBarrier xbar = xcd_barrier_post((unsigned*)(args.ws + 4096), (volatile LAS unsigned*)(lds + 147008), wave_s);
#define GRID_BAR() xcd_barrier(xbar)
#define PHASE_IDS() const int tid = fresh_tid(wave_s); const int lane = tid & 63, wave = wave_s; \
    const int gw = blockIdx.x * NWAVES + wave, gt = blockIdx.x * NTHR + tid; (void)lane; (void)gw; (void)gt
    unsigned char* ws = args.ws;
    const float* x = args.in[0]; const float* p = args.in[1]; const float* w_in_fox = args.in[2]; const float* b_f = args.in[3];
    const float* g_q = args.in[4]; const float* g_k = args.in[5]; const float* w_out_fox = args.in[6]; const float* w_in_hg = args.in[7];
    const float* lbl = args.in[8]; const float* g_o = args.in[9]; const float* w_out_hg = args.in[10]; const float* pre_norm = args.in[11];
    const float* post_norm = args.in[12]; const float* w_pe = args.in[13]; const float* w_pg = args.in[14];
    float* out = args.out;
    float* negc = (float*)(ws + WS_NEGC); float* logf = (float*)(ws + WS_LOGF); float* ss = (float*)(ws + WS_SS); float* rstd1 = (float*)(ws + WS_RSTD); float* rstdY = rstd1 + M; float* gbuf = (float*)(ws + WS_GBUF);
    bf16r* WFOX = (bf16r*)(ws + WS_WFOX); bf16r* WOF = (bf16r*)(ws + WS_WOF); bf16r* WHG = (bf16r*)(ws + WS_WHG); bf16r* WOH = (bf16r*)(ws + WS_WOH);
    bf16r* WPE = (bf16r*)(ws + WS_WPE); bf16r* WPG = (bf16r*)(ws + WS_WPG); bf16r* PB = (bf16r*)(ws + WS_PB);
    bf16r* bA = (bf16r*)(ws + WS_A); bf16r* bB = (bf16r*)(ws + WS_B); bf16r* bC = (bf16r*)(ws + WS_C); bf16r* bD = (bf16r*)(ws + WS_D); bf16r* bE = (bf16r*)(ws + WS_E); bf16r* bF = (bf16r*)(ws + WS_F);

#define DEFERRED_CONVERT(gw_, ngw_, gt_, ngt_) do { \
        constexpr int I_SQ = 32 * 64, I_HG = 32 * 256, I_PE = 4 * 64, NITEMS = I_SQ + I_HG + I_SQ + 2 * I_PE + 2 * I_SQ; \
        for (int it = (gw_); it < NITEMS; it += (ngw_)) { int r = it; \
            if (r < I_SQ) { transpose_item(w_out_fox, DM, DM, 64, WOF, nullptr, scr, r, lane); continue; } r -= I_SQ; \
            if (r < I_HG) { transpose_item(w_in_hg, 4 * DM, DM, 256, WHG, pre_norm + DM, scr, r, lane); continue; } r -= I_HG; \
            if (r < I_SQ) { transpose_item(w_out_hg, DM, DM, 64, WOH, nullptr, scr, r, lane); continue; } r -= I_SQ; \
            if (r < I_PE) { transpose_item(w_pe, DM, PLE, 64, WPE, nullptr, scr, r, lane); continue; } r -= I_PE; \
            if (r < I_PE) { transpose_item(w_pe + (size_t)PLE * DM, DM, PLE, 64, WPE + (size_t)DM * PLE, nullptr, scr, r, lane); continue; } r -= I_PE; \
            if (r < I_SQ) { transpose_item(w_pg, DM, DM, 64, WPG, nullptr, scr, r, lane); continue; } r -= I_SQ; \
            transpose_item(w_pg + (size_t)DM * DM, DM, DM, 64, WPG + (size_t)DM * DM, nullptr, scr, r, lane); } \
        for (int i = (gt_); i < 2 * M * PLE / 8; i += (ngt_)) { const f32x4 a = *(const f32x4*)(p + (size_t)i * 8), b2 = *(const f32x4*)(p + (size_t)i * 8 + 4); *(u32x4*)(PB + (size_t)i * 8) = pack8(a, b2); } } while (0)

    PH_BEGIN_0
    {
        PHASE_IDS();
        LAS float* scr = (LAS float*)(lds + wave * 8448);
        for (int it = gw; it < 32 * 256; it += NGW) transpose_item(w_in_fox, NFOX, DM, 256, WFOX, nullptr, scr, it, lane);
        if (G != 256) { DEFERRED_CONVERT(gw, NGW, gt, NGT); }
        for (int i = gt; i < 4096 + 240 * 256; i += NGT) {
            if (i < 4096) { const int n = i & 15, kc = i >> 4; float v[8];
#pragma unroll
                for (int j = 0; j < 8; ++j) v[j] = w_in_fox[(size_t)(kc * 8 + j) * NFOX + 8192 + n];
                u32x4 o; o.x = cvtpk_s(v[0], v[1]); o.y = cvtpk_s(v[2], v[3]); o.z = cvtpk_s(v[4], v[5]); o.w = cvtpk_s(v[6], v[7]);
                *(u32x4*)(WFOX + (size_t)(8192 + n) * DM + kc * 8) = o; }
            else { const int r = i - 4096; *(u32x4*)(WFOX + (size_t)(8208 + (r >> 8)) * DM + (r & 255) * 8) = (u32x4){0u, 0u, 0u, 0u}; } }
        if (blockIdx.x == 0 && tid < 256) gbuf[tid] = tid < 128 ? g_q[tid] : g_k[tid - 128];
        for (int row = gw; row < M; row += 2 * NGW) { const int row2 = row + NGW;
            const bool has2 = row2 < M; const float* xr = x + (size_t)row * DM + lane * 4; const float* xr2 = x + (size_t)(has2 ? row2 : row) * DM + lane * 4;
            f32x4 v[8], u[8]; float s = 0.f, s2 = 0.f;
#pragma unroll
            for (int j = 0; j < 8; ++j) { v[j] = *(const f32x4*)(xr + j * 256); u[j] = *(const f32x4*)(xr2 + j * 256); }
#pragma unroll
            for (int j = 0; j < 8; ++j) { s += (v[j][0] * v[j][0] + v[j][1] * v[j][1]) + (v[j][2] * v[j][2] + v[j][3] * v[j][3]); s2 += (u[j][0] * u[j][0] + u[j][1] * u[j][1]) + (u[j][2] * u[j][2] + u[j][3] * u[j][3]); }
            const float r = rsqrtf(wave_sum(s) * (1.f / DM) + EPS), r2 = rsqrtf(wave_sum(s2) * (1.f / DM) + EPS);
#pragma unroll
            for (int j = 0; j < 8; ++j) { const f32x4 g = *(const f32x4*)(pre_norm + j * 256 + lane * 4); const f32x4 o = v[j] * r * g, o2 = u[j] * r2 * g;
                *(u32x2*)(bA + (size_t)row * DM + j * 256 + lane * 4) = (u32x2){cvtpk_s(o[0], o[1]), cvtpk_s(o[2], o[3])};
                if (has2) *(u32x2*)(bA + (size_t)row2 * DM + j * 256 + lane * 4) = (u32x2){cvtpk_s(o2[0], o2[1]), cvtpk_s(o2[2], o2[3])}; } }
    }
    GRID_BAR();
    if (args.ws == nullptr) grid.sync();
    PH_END_0

    PH_BEGIN_1
#if !defined(GMASK) || (GMASK & 1)
    { pg8::Gemm g{bA, WFOX, M, NFOXP, DM}; pg8::StaticOrder S; S.init(M, NFOXP, G, (int)blockIdx.x);
      pg8::EpiFoxIn E{bB, bE, (size_t)(WS_C - WS_B) / 2, logf, b_f, gbuf, (LAS float*)(lds + 131072)};
      pg8::gemm_phase<pg8::EpiFoxIn, pg8::StaticOrder, true, true>(lds, g, S, E, wave_s); }
#endif
    if (G == 256 && blockIdx.x >= 128) {
        PHASE_IDS(); __syncthreads(); LAS float* scr = (LAS float*)(lds + wave * 8448);
        DEFERRED_CONVERT(((int)blockIdx.x - 128) * NWAVES + wave, 128 * NWAVES, ((int)blockIdx.x - 128) * NTHR + tid, 128 * NTHR); }
    GRID_BAR();
    PH_END_1

    {
        PHASE_IDS();
        for (int seq = blockIdx.x; seq < BATCH * NH; seq += G) {
            const float* src = logf + (size_t)seq * SEQ + tid * 16; float v[16];
#pragma unroll
            for (int j = 0; j < 4; ++j) { const f32x4 t = *(const f32x4*)(src + 4 * j); v[4 * j] = t[0]; v[4 * j + 1] = t[1]; v[4 * j + 2] = t[2]; v[4 * j + 3] = t[3]; }
#pragma unroll
            for (int j = 1; j < 16; ++j) v[j] += v[j - 1];
            float incl = v[15];
#pragma unroll
            for (int o = 1; o < 64; o <<= 1) { const float t = __shfl_up(incl, o); if (lane >= o) incl += t; }
            LAS float* wt = (LAS float*)lds;
            __syncthreads();
            if (lane == 63) wt[wave] = incl;
            __syncthreads();
            float pre = incl - v[15];
            for (int ww = 0; ww < wave; ++ww) pre += wt[ww];
            float* dst = negc + (size_t)seq * SEQ + tid * 16;
#pragma unroll
            for (int j = 0; j < 4; ++j) { f32x4 t; t[0] = -(v[4 * j] + pre) * 11.313708498984761f; t[1] = -(v[4 * j + 1] + pre) * 11.313708498984761f; t[2] = -(v[4 * j + 2] + pre) * 11.313708498984761f; t[3] = -(v[4 * j + 3] + pre) * 11.313708498984761f; *(f32x4*)(dst + 4 * j) = t; }
        }
    }
    GRID_BAR();

    PH_BEGIN_2
#ifndef NO_ATT
    {
        using namespace att;
        typedef BlockRef<bf16, bf16> BR;
        constexpr int nqb = SEQ / QB, W = 1 << 20;
        char* ldsg = (char*)lds_raw;
        volatile LAS int* hord = (volatile LAS int*)(lds + 143360);
        float TH, TH2;
        {
            PHASE_IDS();
        float gqm = fmaxf(fabsf(gbuf[lane]), fabsf(gbuf[lane + 64])), gkm = fmaxf(fabsf(gbuf[128 + lane]), fabsf(gbuf[192 + lane]));
#pragma unroll
        for (int o = 1; o < 64; o <<= 1) { gqm = fmaxf(gqm, __shfl_xor(gqm, o)); gkm = fmaxf(gkm, __shfl_xor(gkm, o)); }
        TH = __uint_as_float(__builtin_amdgcn_readfirstlane(__float_as_uint((2.f * 11.313708f * gqm * gkm * 1.02f + 32.f) * 11.313708f)));
        TH2 = __uint_as_float(__builtin_amdgcn_readfirstlane(__float_as_uint((11.313708f * gqm * gkm * 1.02f + 32.f) * 11.313708f)));
        if (tid < 16) { const float mine = b_f[tid]; int rk = 0;
            for (int j = 0; j < 16; ++j) { const float o = b_f[j]; rk += (o > mine || (o == mine && j < tid)) ? 1 : 0; }
            hord[rk] = tid; }
        }
        __syncthreads();
        unsigned* qctr = (unsigned*)ws;
#define FETCH(Lout) do { __syncthreads(); if (fresh_tid(wave_s) == 0) { int q_ = (int)(xbar.x & 7u), got_ = -1; \
            for (int t_ = 0; t_ < 8; ++t_) { const unsigned i_ = atomicAdd(qctr + 64 * q_, 1u); if (i_ < 256u) { got_ = q_ * 256 + (int)i_; break; } q_ = (q_ + 1) & 7; } \
            hord[16] = got_; } __syncthreads(); Lout = __builtin_amdgcn_readfirstlane(hord[16]); } while (0)
#define DECODE(L_) SwaItem{((((L_) & 127) >> 5) * NH) + __builtin_amdgcn_readfirstlane(hord[(((L_) >> 7) & 1) ? 15 - ((L_) >> 8) : ((L_) >> 8)]), nqb - 1 - ((L_) & 31), nqb - 1 - ((L_) & 31)}
#define MKREF(it_, pass_) mk_ref<bf16, bf16>((it_), (pass_), (const bf16*)bB, (const bf16*)bC, (const bf16*)bD, (bf16*)bF, (const bf16*)bE, negc, SEQ)
        int L; FETCH(L);
        if (L >= 0) {
            SwaItem it = DECODE(L);
            BR cur = MKREF(it, 0);
            Seam<bf16> S;
            causal_swa_prime<bf16, bf16>(cur, W, ldsg, S, wave_s);
            for (;;) {
                int Ln; FETCH(Ln);
                const bool last = Ln < 0;
                const SwaItem itn = last ? it : DECODE(Ln);
                const BR nxt = last ? cur : MKREF(itn, 0);
                causal_swa_block<bf16, bf16>(cur, nxt, SEQ, W, ldsg, S, TH, TH2, wave_s);
                if (last) break;
                cur = nxt; it = itn; L = Ln;
            }
        }
    }
#endif
    GRID_BAR();
    PH_END_2

    PH_BEGIN_3
#if !defined(GMASK) || (GMASK & 2)
    { pg8::Gemm g{bF, WOF, M, DM, DM}; pg8::StaticOrder S; S.init(M, DM, G, (int)blockIdx.x);
      pg8::EpiOutSS E{bB, ss};
      pg8::gemm_phase<pg8::EpiOutSS, pg8::StaticOrder, true, true>(lds, g, S, E, wave_s); }
#endif
    __syncthreads();
#if !defined(GMASK) || (GMASK & 4)
    { int kpe = PLE; asm volatile("" : "+s"(kpe)); pg8::Gemm g{PB, WPE, M, DM, kpe}; pg8::StaticOrder S; S.init(M, DM, G, (int)blockIdx.x);
      pg8::EpiPlain E{bC};
      pg8::gemm_phase<pg8::EpiPlain, pg8::StaticOrder, true, true>(lds, g, S, E, wave_s); }
#endif
    GRID_BAR();
    PH_END_3

    PH_BEGIN_4
    { PHASE_IDS();
    for (int row = gw; row < M; row += NGW) { float s = lane < 32 ? ss[(size_t)row * 32 + lane] : 0.f; const float r = rsqrtf(wave_sum(s) * (1.f / DM) + EPS);
#pragma unroll
        for (int j = 0; j < 8; ++j) { const size_t idx = (size_t)row * DM + j * 256 + lane * 4; const f32x4 xr = *(const f32x4*)(x + idx); const u32x2 yv = *(const u32x2*)(bB + idx);
            const f32x4 g = *(const f32x4*)(post_norm + j * 256 + lane * 4); const f32x4 y = {bf_lo(yv.x), bf_hi(yv.x), bf_lo(yv.y), bf_hi(yv.y)};
            const f32x4 hv = xr + y * r * g; *(u32x2*)(bA + idx) = (u32x2){cvtpk_s(hv[0], hv[1]), cvtpk_s(hv[2], hv[3])}; }
        if (lane == 0) rstdY[row] = r; } }
    GRID_BAR();
    PH_END_4

#if !defined(GMASK) || (GMASK & 8)
    { pg8::Gemm g{bA, WPG, M, DM, DM}; pg8::StaticOrder S; S.init(M, DM, G, (int)blockIdx.x);
      pg8::EpiPG E{x, out, bB, rstdY, post_norm, bC, bF, ss};
      pg8::gemm_phase<pg8::EpiPG, pg8::StaticOrder, true, true>(lds, g, S, E, wave_s); }
#endif
    GRID_BAR();
    { PHASE_IDS();
    for (int row = gt; row < M; row += NGT) { float s = 0.f;
#pragma unroll
        for (int j = 0; j < 8; ++j) { const f32x4 t = *(const f32x4*)(ss + (size_t)row * 32 + 4 * j); s += (t[0] + t[1]) + (t[2] + t[3]); }
        rstd1[row] = rsqrtf(s * (1.f / DM) + EPS); } }
    GRID_BAR();

    PH_BEGIN_5
#if !defined(GMASK) || (GMASK & 16)
    { pg8::Gemm g{bF, WHG, M, 4 * DM, DM}; pg8::StaticOrder S; S.init(M, 4 * DM, G, (int)blockIdx.x);
      pg8::EpiHgIn E{bA, (size_t)(WS_B - WS_A) / 2, (float*)bB, rstd1, lbl};
      pg8::gemm_phase<pg8::EpiHgIn, pg8::StaticOrder, true, true>(lds, g, S, E, wave_s); }
#endif
    GRID_BAR();
    PH_END_5

    PH_BEGIN_6
#ifndef NO_HG
    {
        unsigned* hq = (unsigned*)ws + 512;
        volatile LAS int* hslot = (volatile LAS int*)(lds + 143360);
        for (;;) {
            __syncthreads();
            if (fresh_tid(wave_s) == 0) { int q_ = (int)(xbar.x & 7u), got_ = -1;
                for (int t_ = 0; t_ < 8; ++t_) { const unsigned i_ = atomicAdd(hq + 64 * q_, 1u); if (i_ < 32u) { got_ = q_ * 32 + (int)i_; break; } q_ = (q_ + 1) & 7; }
                hslot[0] = got_; }
            __syncthreads();
            const int item = __builtin_amdgcn_readfirstlane(hslot[0]);
            if (item < 0) break;
            { PHASE_IDS(); hg::hgrn_item<0>(lds, bA, (const float*)bB, bD, bF, item, tid); }
        }
    }
#endif
    GRID_BAR();
    PH_END_6

#ifdef HGPROBE
    { PHASE_IDS();
    for (int i = blockIdx.x; i < BATCH * NH * 4; i += G) {
        const int item = ((G & 31) == 0) ? (((i & 7) * (BATCH * NH / 8) + (i >> 5)) * 4 + ((i >> 3) & 3)) : i;
        hg::hgrn_item<HGPROBE>(lds, bA, (const float*)bB, bD, bF, item, tid); } }
    GRID_BAR();
#endif
    { PHASE_IDS();
    for (int it = gw; it < M * NH / 4; it += NGW) { const size_t off = ((size_t)it * 4 + (lane >> 4)) * 128 + (lane & 15) * 8;
        const u32x4 wv = *(const u32x4*)(bF + off), zv = *(const u32x4*)(bE + off);
        f32x4 a = {bf_lo(wv.x), bf_hi(wv.x), bf_lo(wv.y), bf_hi(wv.y)}, b2 = {bf_lo(wv.z), bf_hi(wv.z), bf_lo(wv.w), bf_hi(wv.w)};
        float s = (a[0] * a[0] + a[1] * a[1]) + (a[2] * a[2] + a[3] * a[3]) + (b2[0] * b2[0] + b2[1] * b2[1]) + (b2[2] * b2[2] + b2[3] * b2[3]);
        s += __shfl_xor(s, 1); s += __shfl_xor(s, 2); s += __shfl_xor(s, 4); s += __shfl_xor(s, 8);
        const float r = rsqrtf(s * (1.f / 128.f) + EPS); const float* gg = g_o + (lane & 15) * 8;
        const f32x4 z0 = {bf_lo(zv.x), bf_hi(zv.x), bf_lo(zv.y), bf_hi(zv.y)}, z1 = {bf_lo(zv.z), bf_hi(zv.z), bf_lo(zv.w), bf_hi(zv.w)};
        a = a * r * *(const f32x4*)gg * z0; b2 = b2 * r * *(const f32x4*)(gg + 4) * z1;
        *(u32x4*)(bF + off) = pack8(a, b2); } }
    GRID_BAR();

    PH_BEGIN_7
#if !defined(GMASK) || (GMASK & 32)
    { pg8::Gemm g{bF, WOH, M, DM, DM}; pg8::StaticOrder S; S.init(M, DM, G, (int)blockIdx.x);
      pg8::EpiOutSS E{bD, ss};
      pg8::gemm_phase<pg8::EpiOutSS, pg8::StaticOrder, true, true>(lds, g, S, E, wave_s); }
#endif
    __syncthreads();
#if !defined(GMASK) || (GMASK & 64)
    { int kpe = PLE; asm volatile("" : "+s"(kpe)); pg8::Gemm g{PB + (size_t)M * PLE, WPE + (size_t)DM * PLE, M, DM, kpe}; pg8::StaticOrder S; S.init(M, DM, G, (int)blockIdx.x);
      pg8::EpiPlain E{bE};
      pg8::gemm_phase<pg8::EpiPlain, pg8::StaticOrder, true, true>(lds, g, S, E, wave_s); }
#endif
    GRID_BAR();
    PH_END_7

    { PHASE_IDS();
    for (int row = gw; row < M; row += NGW) { float s = lane < 32 ? ss[(size_t)row * 32 + lane] : 0.f; const float r = rsqrtf(wave_sum(s) * (1.f / DM) + EPS);
#pragma unroll
        for (int j = 0; j < 8; ++j) { const size_t idx = (size_t)row * DM + j * 256 + lane * 4; const f32x4 xr = *(const f32x4*)(out + idx); const u32x2 yv = *(const u32x2*)(bD + idx);
            const f32x4 g = *(const f32x4*)(post_norm + DM + j * 256 + lane * 4); const f32x4 y = {bf_lo(yv.x), bf_hi(yv.x), bf_lo(yv.y), bf_hi(yv.y)};
            const f32x4 hv = xr + y * r * g; *(u32x2*)(bA + idx) = (u32x2){cvtpk_s(hv[0], hv[1]), cvtpk_s(hv[2], hv[3])}; }
        if (lane == 0) rstdY[row] = r; } }
    GRID_BAR();

#if !defined(GMASK) || (GMASK & 128)
    { pg8::Gemm g{bA, WPG + (size_t)DM * DM, M, DM, DM}; pg8::StaticOrder S; S.init(M, DM, G, (int)blockIdx.x);
      pg8::EpiPG E{out, out, bD, rstdY, post_norm + DM, bE, nullptr, nullptr};
      pg8::gemm_phase<pg8::EpiPG, pg8::StaticOrder, true, true>(lds, g, S, E, wave_s); }
#endif
}

extern "C" void kernel_launch(void* const* d_in, const int* in_sizes, int n_in, void* d_out, int out_size, void* d_ws, size_t ws_size, hipStream_t stream) {
    static int grid = 0;
    if (grid == 0) {
        if (n_in != 15 || out_size != M * DM || ws_size < WS_END) { fprintf(stderr, "kernel_launch: unexpected shapes (n_in %d out %d ws %zu)\n", n_in, out_size, ws_size); grid = -1; return; }
        int dev = 0, cus = 0, per_cu = 0;
        (void)hipGetDevice(&dev); (void)hipDeviceGetAttribute(&cus, hipDeviceAttributeMultiprocessorCount, dev);
        if (hipFuncSetAttribute((const void*)fwd_megakernel, hipFuncAttributeMaxDynamicSharedMemorySize, LDS_BYTES) != hipSuccess) fprintf(stderr, "kernel_launch: hipFuncSetAttribute failed\n");
        if (hipOccupancyMaxActiveBlocksPerMultiprocessor(&per_cu, (const void*)fwd_megakernel, NTHR, LDS_BYTES) != hipSuccess || per_cu < 1) { fprintf(stderr, "kernel_launch: occupancy query says %d\n", per_cu); per_cu = 1; }
        (void)hipGetLastError();
        if (cus <= 0) cus = 256;
        grid = cus * 1;
    }
    if (grid < 0) return;
    if (hipMemsetAsync(d_ws, 0, 65536, stream) != hipSuccess) { fprintf(stderr, "kernel_launch: hipMemsetAsync failed\n"); return; }
    Args a{};
    for (int i = 0; i < 15; ++i) a.in[i] = (const float*)d_in[i];
    a.out = (float*)d_out; a.ws = (unsigned char*)d_ws;
    void* kargs[] = {&a};
    hipError_t e = hipLaunchCooperativeKernel((const void*)fwd_megakernel, dim3(grid), dim3(NTHR), kargs, LDS_BYTES, stream);
    if (e != hipSuccess) fprintf(stderr, "cooperative launch failed: %s (grid %d)\n", hipGetErrorString(e), grid);
}
```

```cpp
#include <hip/hip_runtime.h>
#include <hip/hip_bf16.h>
#include <hip/hip_cooperative_groups.h>
#include <cstdio>
#include <cstdint>
namespace cg = cooperative_groups;

typedef __bf16 bf16x2_t __attribute__((ext_vector_type(2)));
typedef float f32x2_t __attribute__((ext_vector_type(2)));
__device__ __forceinline__ unsigned cvtpk_s(float lo, float hi) { f32x2_t v = {lo, hi}; bf16x2_t b = __builtin_convertvector(v, bf16x2_t); return __builtin_bit_cast(unsigned, b); }
__device__ __forceinline__ float bf_lo(unsigned w) { return __uint_as_float(w << 16); }
__device__ __forceinline__ float bf_hi(unsigned w) { return __uint_as_float(w & 0xffff0000u); }
__device__ __forceinline__ float sigmoidf_(float x) { return __builtin_amdgcn_rcpf(1.0f + __expf(-x)); }
__device__ __forceinline__ float siluf_(float x) { return x * __builtin_amdgcn_rcpf(1.0f + __expf(-x)); }

__device__ __forceinline__ int fresh_tid(int wave_s) { int l; asm volatile("v_mbcnt_lo_u32_b32 %0, -1, 0\n\tv_mbcnt_hi_u32_b32 %0, -1, %0" : "=v"(l)); return wave_s * 64 + l; }

namespace pg8 {
#define PG8_LAS __attribute__((address_space(3)))
typedef unsigned short bf16_t;
typedef short bf16x8 __attribute__((ext_vector_type(8)));
typedef float f32x4 __attribute__((ext_vector_type(4)));
typedef unsigned u32x4 __attribute__((ext_vector_type(4)));
constexpr int BM = 256, BK = 64, HALF = 128, HTB = HALF * BK * 2  , STAGE_BYTES = 8 * HTB, NXCD = 8, WGM = 8;

__host__ __device__ __forceinline__ int lds_byte(int r, int c) { const int st = (r >> 4) * 2 + (c >> 5), rr = r & 15, cc = c & 31, ob = rr * 64 + cc * 2; return st * 1024 + (ob ^ (((ob >> 9) & 1) << 5)); }
__host__ __device__ __forceinline__ void stage_rc(int b, int& R, int& C) { const int st = b / 1024, sb = b % 1024, swz = sb ^ (((sb >> 9) & 1) << 5); R = (st >> 1) * 16 + swz / 64; C = (st & 1) * 32 + (swz % 64) / 2; }
__host__ __device__ __forceinline__ int perm32(int rho) { const int n = rho >> 4, i = rho & 15; return 8 * (i >> 2) + 4 * n + (i & 3); }

struct Unit { int pm, pn; };
struct Gemm { const bf16_t* A; const bf16_t* Bt; int M, N, K; };

struct StaticOrder {
    int nM, nN, nwg, G, c;
    __host__ __device__ void init(int M, int N, int G_, int c_) { nM = M / BM; nN = N / BM; nwg = nM * nN; G = G_; c = c_; }
    __host__ __device__ bool next(int i, Unit& u) const {
        const long L = (long)i * G + c; if (L >= nwg) return false;
        int wgid = (int)L; { const int q = nwg / NXCD, r = nwg % NXCD, xcd = wgid % NXCD, off = wgid / NXCD; wgid = (xcd < r ? xcd * (q + 1) : r * (q + 1) + (xcd - r) * q) + off; }
        const int nig = WGM * nN, gid = wgid / nig, fm = gid * WGM, gsz = (nM - fm) < WGM ? (nM - fm) : WGM;
        u.pm = fm + ((wgid % nig) % gsz); u.pn = (wgid % nig) / gsz; return true;
    }
    __device__ __forceinline__ void a_ready(const Unit&) const {}
    __device__ __forceinline__ void done(const Unit&) const {}
};


__device__ __forceinline__ u32x4 pack8bf(const f32x4 a, const f32x4 b) { u32x4 w; w.x = cvtpk_s(a[0], a[1]); w.y = cvtpk_s(a[2], a[3]); w.z = cvtpk_s(b[0], b[1]); w.w = cvtpk_s(b[2], b[3]); return w; }
__device__ __forceinline__ f32x4 silu4(const f32x4 v) { return (f32x4){siluf_(v[0]), siluf_(v[1]), siluf_(v[2]), siluf_(v[3])}; }
__device__ __forceinline__ float logsigmoidf_(float x) { return fminf(x, 0.f) - __logf(1.0f + __expf(-fabsf(x))); }

struct EpiFoxIn {
    static constexpr bool PERM = true, AFTER_DRAIN = false;
    bf16_t *Q, *SZ; size_t qkv_stride; float* logf; const float* b_f; const float* gains; PG8_LAS float* xs;
    __device__ __forceinline__ void operator()(const f32x4 (&acc)[2][2][4][2], const Unit& u, int wr, int wc, int fr, int fq) const {
        const int sec = u.pn >> 3, row0 = u.pm * BM + wr * 64 + fr;
        if (sec < 2) {
            bf16_t* base = Q + (size_t)sec * qkv_stride;
#pragma unroll
            for (int ai = 0; ai < 2; ++ai)
#pragma unroll
                for (int m = 0; m < 4; ++m)
#pragma unroll
                    for (int bj = 0; bj < 2; ++bj) { const f32x4 a = acc[ai][bj][m][0], b = acc[ai][bj][m][1];
                        float s = (a[0] * a[0] + a[1] * a[1]) + (a[2] * a[2] + a[3] * a[3]) + (b[0] * b[0] + b[1] * b[1]) + (b[2] * b[2] + b[3] * b[3]);
                        s += __shfl_xor(s, 16); s += __shfl_xor(s, 32);
                        if (fq == 0) xs[(ai * HALF + wr * 64 + m * 16 + fr) * 8 + bj * 4 + wc] = s; }
            asm volatile("s_waitcnt lgkmcnt(0)" ::: "memory"); __builtin_amdgcn_s_barrier(); asm volatile("" ::: "memory");
            int go_ = wc * 32 + 8 * fq; asm volatile("" : "+v"(go_));
            const float* gp = gains + sec * 128 + go_; const f32x4 g0 = *(const f32x4*)gp, g1 = *(const f32x4*)(gp + 4);
#pragma unroll
            for (int ai = 0; ai < 2; ++ai)
#pragma unroll
                for (int m = 0; m < 4; ++m) { const int row = row0 + ai * HALF + m * 16, b = row >> 13, s = row & 8191;
#pragma unroll
                    for (int bj = 0; bj < 2; ++bj) { const int h = (u.pn & 7) * 2 + bj;
                        const f32x4 pp = *(const PG8_LAS f32x4*)(xs + (ai * HALF + wr * 64 + m * 16 + fr) * 8 + bj * 4);
                        const float r = rsqrtf(((pp[0] + pp[1]) + (pp[2] + pp[3])) * (1.f / 128.f) + 1e-6f);
                        *(u32x4*)(base + ((size_t)(b * 16 + h) * 8192 + s) * 128 + wc * 32 + 8 * fq) = pack8bf(acc[ai][bj][m][0] * r * g0, acc[ai][bj][m][1] * r * g1); }
                    asm volatile("" ::: "memory"); }
        } else if (sec == 2) {
            bf16_t* base = Q + (size_t)sec * qkv_stride;
#pragma unroll
            for (int ai = 0; ai < 2; ++ai)
#pragma unroll
                for (int m = 0; m < 4; ++m) { const int row = row0 + ai * HALF + m * 16, b = row >> 13, s = row & 8191;
#pragma unroll
                    for (int bj = 0; bj < 2; ++bj) { const int h = (u.pn & 7) * 2 + bj;
                        *(u32x4*)(base + ((size_t)(b * 16 + h) * 8192 + s) * 128 + wc * 32 + 8 * fq) = pack8bf(acc[ai][bj][m][0], acc[ai][bj][m][1]); }
                    asm volatile("" ::: "memory"); }
        } else if (sec == 3) {
#pragma unroll
            for (int ai = 0; ai < 2; ++ai)
#pragma unroll
                for (int m = 0; m < 4; ++m) { const int row = row0 + ai * HALF + m * 16;
#pragma unroll
                    for (int bj = 0; bj < 2; ++bj)
                        *(u32x4*)(SZ + (size_t)row * 2048 + (u.pn & 7) * 256 + bj * HALF + wc * 32 + 8 * fq) = pack8bf(silu4(acc[ai][bj][m][0]), silu4(acc[ai][bj][m][1]));
                    asm volatile("" ::: "memory"); }
        } else {
            if (wc == 0 && fq < 2) {
#pragma unroll
                for (int ai = 0; ai < 2; ++ai)
#pragma unroll
                    for (int m = 0; m < 4; ++m) { const int row = row0 + ai * HALF + m * 16, b = row >> 13, s = row & 8191;
#pragma unroll
                        for (int n = 0; n < 2; ++n)
#pragma unroll
                            for (int j = 0; j < 4; ++j) { const int h = 8 * fq + 4 * n + j;
                                logf[(size_t)(b * 16 + h) * 8192 + s] = logsigmoidf_(acc[ai][0][m][n][j] + b_f[h]); }
                        asm volatile("" ::: "memory"); }
            }
        }
    }
};
struct EpiOutSS {
    static constexpr bool PERM = true, AFTER_DRAIN = false;
    bf16_t* Y; float* ss;
    __device__ __forceinline__ void operator()(const f32x4 (&acc)[2][2][4][2], const Unit& u, int wr, int wc, int fr, int fq) const {
        const int row0 = u.pm * BM + wr * 64 + fr, col0 = u.pn * BM + wc * 32 + 8 * fq;
#pragma unroll
        for (int ai = 0; ai < 2; ++ai)
#pragma unroll
            for (int m = 0; m < 4; ++m) { const int row = row0 + ai * HALF + m * 16; float s = 0.f;
#pragma unroll
                for (int bj = 0; bj < 2; ++bj) { const f32x4 a = acc[ai][bj][m][0], b = acc[ai][bj][m][1];
                    s += (a[0] * a[0] + a[1] * a[1]) + (a[2] * a[2] + a[3] * a[3]) + (b[0] * b[0] + b[1] * b[1]) + (b[2] * b[2] + b[3] * b[3]);
                    *(u32x4*)(Y + (size_t)row * 2048 + col0 + bj * HALF) = pack8bf(a, b); }
                s += __shfl_xor(s, 16); s += __shfl_xor(s, 32);
                if (fq == 0) ss[(size_t)row * 32 + u.pn * 4 + wc] = s; asm volatile("" ::: "memory"); }
    }
};
struct EpiPlain {
    static constexpr bool PERM = true, AFTER_DRAIN = false;
    bf16_t* Y;
    __device__ __forceinline__ void operator()(const f32x4 (&acc)[2][2][4][2], const Unit& u, int wr, int wc, int fr, int fq) const {
        const int row0 = u.pm * BM + wr * 64 + fr, col0 = u.pn * BM + wc * 32 + 8 * fq;
#pragma unroll
        for (int ai = 0; ai < 2; ++ai)
#pragma unroll
            for (int m = 0; m < 4; ++m) { const int row = row0 + ai * HALF + m * 16;
#pragma unroll
                for (int bj = 0; bj < 2; ++bj) *(u32x4*)(Y + (size_t)row * 2048 + col0 + bj * HALF) = pack8bf(acc[ai][bj][m][0], acc[ai][bj][m][1]); }
    }
};
struct EpiPG {
    static constexpr bool PERM = true, AFTER_DRAIN = false;
    const float* R; float* H; const bf16_t* Y; const float* rstdY; const float* gpost; const bf16_t* PE; bf16_t* HB; float* ss;
    __device__ __forceinline__ void operator()(const f32x4 (&acc)[2][2][4][2], const Unit& u, int wr, int wc, int fr, int fq) const {
        const int row0 = u.pm * BM + wr * 64 + fr, col0 = u.pn * BM + wc * 32 + 8 * fq;
        float rs[2][4]; f32x4 g[2][2];
#pragma unroll
        for (int ai = 0; ai < 2; ++ai)
#pragma unroll
            for (int m = 0; m < 4; ++m) rs[ai][m] = rstdY[row0 + ai * HALF + m * 16];
#pragma unroll
        for (int bj = 0; bj < 2; ++bj) { g[bj][0] = *(const f32x4*)(gpost + col0 + bj * HALF); g[bj][1] = *(const f32x4*)(gpost + col0 + bj * HALF + 4); }
#pragma unroll
        for (int ai = 0; ai < 2; ++ai)
#pragma unroll
            for (int m = 0; m < 4; ++m) { const int row = row0 + ai * HALF + m * 16; const float r = rs[ai][m]; float s = 0.f;
#pragma unroll
                for (int bj = 0; bj < 2; ++bj) { const size_t idx = (size_t)row * 2048 + col0 + bj * HALF;
                    const f32x4 r0 = *(const f32x4*)(R + idx), r1 = *(const f32x4*)(R + idx + 4); const u32x4 yv = *(const u32x4*)(Y + idx), pe = *(const u32x4*)(PE + idx);
                    const f32x4 y0 = {bf_lo(yv.x), bf_hi(yv.x), bf_lo(yv.y), bf_hi(yv.y)}, y1 = {bf_lo(yv.z), bf_hi(yv.z), bf_lo(yv.w), bf_hi(yv.w)};
                    const f32x4 h0 = r0 + y0 * r * g[bj][0], h1 = r1 + y1 * r * g[bj][1];
                    const f32x4 a = acc[ai][bj][m][0], b = acc[ai][bj][m][1];
                    f32x4 o0, o1;
                    o0[0] = h0[0] + bf_lo(pe.x) * sigmoidf_(a[0]); o0[1] = h0[1] + bf_hi(pe.x) * sigmoidf_(a[1]); o0[2] = h0[2] + bf_lo(pe.y) * sigmoidf_(a[2]); o0[3] = h0[3] + bf_hi(pe.y) * sigmoidf_(a[3]);
                    o1[0] = h1[0] + bf_lo(pe.z) * sigmoidf_(b[0]); o1[1] = h1[1] + bf_hi(pe.z) * sigmoidf_(b[1]); o1[2] = h1[2] + bf_lo(pe.w) * sigmoidf_(b[2]); o1[3] = h1[3] + bf_hi(pe.w) * sigmoidf_(b[3]);
                    *(f32x4*)(H + idx) = o0; *(f32x4*)(H + idx + 4) = o1;
                    if (HB) { *(u32x4*)(HB + idx) = pack8bf(o0, o1);
                        s += (o0[0] * o0[0] + o0[1] * o0[1]) + (o0[2] * o0[2] + o0[3] * o0[3]) + (o1[0] * o1[0] + o1[1] * o1[1]) + (o1[2] * o1[2] + o1[3] * o1[3]); } }
                if (HB) { s += __shfl_xor(s, 16); s += __shfl_xor(s, 32); if (fq == 0) ss[(size_t)row * 32 + u.pn * 4 + wc] = s; }
                asm volatile("" ::: "memory"); }
    }
};
struct EpiHgIn {
    static constexpr bool PERM = true, AFTER_DRAIN = false;
    bf16_t *SQ; size_t buf_stride; bf16_t* G; const float* rstd; const float* lbl;
    __device__ __forceinline__ void operator()(const f32x4 (&acc)[2][2][4][2], const Unit& u, int wr, int wc, int fr, int fq) const {
        const int sec = u.pn >> 3, row0 = u.pm * BM + wr * 64 + fr, col0 = (u.pn & 7) * BM + wc * 32 + 8 * fq;
        float rs[2][4];
#pragma unroll
        for (int ai = 0; ai < 2; ++ai)
#pragma unroll
            for (int m = 0; m < 4; ++m) rs[ai][m] = rstd[row0 + ai * HALF + m * 16];
        if (sec == 1) {
            float lb[2][8];
#pragma unroll
            for (int bj = 0; bj < 2; ++bj)
#pragma unroll
                for (int j = 0; j < 8; ++j) { const int c = col0 + bj * HALF + j; lb[bj][j] = 1.0f / (1.0f + __expf(lbl[c] - lbl[2048 + c])); }
#pragma unroll
            for (int ai = 0; ai < 2; ++ai)
#pragma unroll
                for (int m = 0; m < 4; ++m) { const int row = row0 + ai * HALF + m * 16; const float r = rs[ai][m];
#pragma unroll
                    for (int bj = 0; bj < 2; ++bj) { f32x4 o0, o1;
#pragma unroll
                        for (int j = 0; j < 4; ++j) { o0[j] = lb[bj][j] + (1.f - lb[bj][j]) * sigmoidf_(acc[ai][bj][m][0][j] * r); o1[j] = lb[bj][4 + j] + (1.f - lb[bj][4 + j]) * sigmoidf_(acc[ai][bj][m][1][j] * r); }
                        typedef _Float16 f16x8_t __attribute__((ext_vector_type(8)));
                        const f16x8_t hv = {(_Float16)o0[0], (_Float16)o0[1], (_Float16)o0[2], (_Float16)o0[3], (_Float16)o1[0], (_Float16)o1[1], (_Float16)o1[2], (_Float16)o1[3]};
                        *(f16x8_t*)(G + (size_t)row * 2048 + col0 + bj * HALF) = hv; }
                    asm volatile("" ::: "memory"); }
        } else {
            bf16_t* base = SQ + (size_t)(sec ? sec + 1 : 0) * buf_stride;
#pragma unroll
            for (int ai = 0; ai < 2; ++ai)
#pragma unroll
                for (int m = 0; m < 4; ++m) { const int row = row0 + ai * HALF + m * 16; const float r = rs[ai][m];
#pragma unroll
                    for (int bj = 0; bj < 2; ++bj) { f32x4 a = acc[ai][bj][m][0] * r, b = acc[ai][bj][m][1] * r;
                        if (sec != 2) { a = silu4(a); b = silu4(b); }
                        *(u32x4*)(base + (size_t)row * 2048 + col0 + bj * HALF) = pack8bf(a, b); }
                    asm volatile("" ::: "memory"); }
        }
    }
};

template <class Epi, class Sched, bool ALIGN_EPI = false, bool SP2 = false>
__device__ __forceinline__ void gemm_phase(PG8_LAS unsigned char* lds, const Gemm g, const Sched& S, const Epi& E, int wave_s) {
    const int tid = fresh_tid(wave_s), wid = __builtin_amdgcn_readfirstlane(tid >> 6), lane = tid & 63, wr = wid >> 2, wc = wid & 3, fr = lane & 15, fq = lane >> 4;
    const int K = g.K, nt = K / BK;
    unsigned voffA[2], voffB[2];
#pragma unroll
    for (int i = 0; i < 2; ++i) { int R, C; stage_rc(tid * 16 + i * 8192, R, C); const int Rb = Epi::PERM ? ((R & ~31) + perm32(R & 31)) : R;
        voffA[i] = (unsigned)(R * K + C) * 2u; voffB[i] = (unsigned)(Rb * K + C) * 2u; }
    const size_t kstep = (size_t)(BK * 2);
    const size_t hstep = (size_t)HALF * K * 2;
    const size_t tstep = 2 * hstep;
    const unsigned ldsw = (unsigned)wid * 1024u;
    const int aoff = lds_byte(wr * 64 + fr, fq * 8), boff = lds_byte(wc * 32 + fr, fq * 8);
#define PG8_SA(b, h) (((b) * 2 + (h)) * HTB)
#define PG8_SB(b, h) ((4 + (b) * 2 + (h)) * HTB)
#define PG8_STAGE(bufoff, gbase, voff) do { _Pragma("unroll") for (int _i = 0; _i < 2; ++_i) \
        __builtin_amdgcn_global_load_lds((const unsigned*)((const char*)(gbase) + (voff)[_i]), (PG8_LAS unsigned*)(lds + (bufoff) + ldsw + _i * 8192), 16, 0, 0); } while (0)
#define PG8_LDA(dst, b, h) do { _Pragma("unroll") for (int m = 0; m < 4; ++m) _Pragma("unroll") for (int k = 0; k < 2; ++k) dst[m][k] = *(const PG8_LAS bf16x8*)(lds + PG8_SA(b, h) + aoff + m * 2048 + k * 1024); } while (0)
#define PG8_LDB(dst, b, h) do { _Pragma("unroll") for (int n = 0; n < 2; ++n) _Pragma("unroll") for (int k = 0; k < 2; ++k) dst[n][k] = *(const PG8_LAS bf16x8*)(lds + PG8_SB(b, h) + boff + n * 2048 + k * 1024); } while (0)
#define PG8_MMA(ai, bj, At, Bt) do { __builtin_amdgcn_s_setprio(1); _Pragma("unroll") for (int m = 0; m < 4; ++m) _Pragma("unroll") for (int n = 0; n < 2; ++n) _Pragma("unroll") for (int k = 0; k < 2; ++k) \
        acc[ai][bj][m][n] = __builtin_amdgcn_mfma_f32_16x16x32_bf16(Bt[n][k], At[m][k], acc[ai][bj][m][n], 0, 0, 0); __builtin_amdgcn_s_setprio(0); } while (0)
#define PG8_WAIT_V(n) asm volatile("s_waitcnt vmcnt(" #n ")" ::: "memory")
#define PG8_WAIT_L(n) asm volatile("s_waitcnt lgkmcnt(" #n ")" ::: "memory")
#define PG8_BAR __builtin_amdgcn_s_barrier()
#define PG8_SCHED __builtin_amdgcn_sched_barrier(0)
    Unit cur, nxt; int ui = 0;
    if (!S.next(0, cur)) return;
    f32x4 acc[2][2][4][2];
#pragma unroll
    for (int a = 0; a < 2; ++a)
#pragma unroll
        for (int b = 0; b < 2; ++b)
#pragma unroll
            for (int m = 0; m < 4; ++m)
#pragma unroll
                for (int n = 0; n < 2; ++n) acc[a][b][m][n] = (f32x4){0.f, 0.f, 0.f, 0.f};
    bf16x8 At[4][2], B0[2][2], B1[2][2];
    const char* cA = (const char*)g.A + (size_t)cur.pm * tstep; const char* cB = (const char*)g.Bt + (size_t)cur.pn * tstep;
    S.a_ready(cur);
    if constexpr (SP2) {
        PG8_STAGE(PG8_SB(0, 0), cB, voffB); PG8_STAGE(PG8_SB(0, 1), cB + hstep, voffB); PG8_STAGE(PG8_SA(0, 0), cA, voffA); PG8_STAGE(PG8_SA(0, 1), cA + hstep, voffA);
        if (wr == 1) PG8_BAR;
        PG8_WAIT_V(2); PG8_BAR;
        PG8_STAGE(PG8_SB(1, 0), cB + kstep, voffB); PG8_STAGE(PG8_SA(1, 0), cA + kstep, voffA); PG8_STAGE(PG8_SB(1, 1), cB + hstep + kstep, voffB);
        PG8_WAIT_V(6); PG8_BAR;
    } else {
        PG8_STAGE(PG8_SB(0, 0), cB, voffB); PG8_STAGE(PG8_SA(0, 0), cA, voffA); PG8_STAGE(PG8_SB(0, 1), cB + hstep, voffB); PG8_STAGE(PG8_SA(0, 1), cA + hstep, voffA);
        if (wr == 1) PG8_BAR;
        PG8_WAIT_V(4); PG8_BAR;
        PG8_STAGE(PG8_SB(1, 0), cB + kstep, voffB); PG8_STAGE(PG8_SA(1, 0), cA + kstep, voffA); PG8_STAGE(PG8_SB(1, 1), cB + hstep + kstep, voffB);
        PG8_WAIT_V(6); PG8_BAR;
    }
    for (;;) {
        const bool has_next = S.next(ui + 1, nxt);
        const char* nA = has_next ? (const char*)g.A + (size_t)nxt.pm * tstep : cA; const char* nB = has_next ? (const char*)g.Bt + (size_t)nxt.pn * tstep : cB;
        for (int t = 0; t < nt; t += 2) {
            const bool last = (t == nt - 2);
            const char* a1 = cA + (size_t)(t + 1) * kstep;
            const char* a2 = last ? nA : cA + (size_t)(t + 2) * kstep; const char* b2 = last ? nB : cB + (size_t)(t + 2) * kstep;
            const char* a3 = a2 + kstep; const char* b3 = b2 + kstep;
            if (last && has_next) S.a_ready(nxt);
            if constexpr (SP2) {
            PG8_LDB(B0, 0, 0); PG8_LDB(B1, 0, 1); PG8_SCHED; PG8_LDA(At, 0, 0); PG8_STAGE(PG8_SA(1, 1), a1 + hstep, voffA);
            PG8_WAIT_V(8); PG8_WAIT_L(0); PG8_BAR; PG8_MMA(0, 0, At, B0); PG8_MMA(0, 1, At, B1); PG8_BAR; PG8_SCHED;
            PG8_LDA(At, 0, 1); PG8_STAGE(PG8_SB(0, 0), b2, voffB); PG8_STAGE(PG8_SB(0, 1), b2 + hstep, voffB); PG8_STAGE(PG8_SA(0, 0), a2, voffA);
            PG8_WAIT_V(8); PG8_WAIT_L(0); PG8_BAR; PG8_MMA(1, 0, At, B0); PG8_MMA(1, 1, At, B1); PG8_BAR; PG8_SCHED;
            PG8_LDB(B0, 1, 0); PG8_LDB(B1, 1, 1); PG8_SCHED; PG8_LDA(At, 1, 0); PG8_STAGE(PG8_SA(0, 1), a2 + hstep, voffA);
            PG8_WAIT_V(8); PG8_WAIT_L(0); PG8_BAR; PG8_MMA(0, 0, At, B0); PG8_MMA(0, 1, At, B1); PG8_BAR; PG8_SCHED;
            PG8_LDA(At, 1, 1); PG8_STAGE(PG8_SB(1, 0), b3, voffB); PG8_STAGE(PG8_SB(1, 1), b3 + hstep, voffB); PG8_STAGE(PG8_SA(1, 0), a3, voffA);
            PG8_WAIT_V(8); PG8_WAIT_L(0); PG8_BAR; PG8_MMA(1, 0, At, B0); PG8_MMA(1, 1, At, B1); PG8_BAR; PG8_SCHED;
            } else {
            PG8_LDB(B0, 0, 0); PG8_SCHED; PG8_LDA(At, 0, 0); PG8_STAGE(PG8_SA(1, 1), a1 + hstep, voffA);
            PG8_WAIT_L(8); PG8_BAR; PG8_WAIT_L(0); PG8_MMA(0, 0, At, B0); PG8_BAR; PG8_SCHED;
            PG8_LDB(B1, 0, 1); PG8_STAGE(PG8_SB(0, 0), b2, voffB);
            PG8_BAR; PG8_WAIT_L(0); PG8_MMA(0, 1, At, B1); PG8_BAR;
            PG8_LDA(At, 0, 1); PG8_STAGE(PG8_SA(0, 0), a2, voffA);
            PG8_BAR; PG8_WAIT_L(0); PG8_MMA(1, 0, At, B0); PG8_BAR; PG8_SCHED;
            PG8_STAGE(PG8_SB(0, 1), b2 + hstep, voffB);
            PG8_WAIT_V(6); PG8_BAR; PG8_MMA(1, 1, At, B1); PG8_BAR;
            PG8_LDB(B0, 1, 0); PG8_SCHED; PG8_LDA(At, 1, 0); PG8_STAGE(PG8_SA(0, 1), a2 + hstep, voffA);
            PG8_WAIT_L(8); PG8_BAR; PG8_WAIT_L(0); PG8_MMA(0, 0, At, B0); PG8_BAR; PG8_SCHED;
            PG8_LDB(B1, 1, 1); PG8_STAGE(PG8_SB(1, 0), b3, voffB);
            PG8_BAR; PG8_WAIT_L(0); PG8_MMA(0, 1, At, B1); PG8_BAR;
            PG8_LDA(At, 1, 1); PG8_STAGE(PG8_SA(1, 0), a3, voffA);
            PG8_BAR; PG8_WAIT_L(0); PG8_MMA(1, 0, At, B0); PG8_BAR; PG8_SCHED;
            PG8_STAGE(PG8_SB(1, 1), b3 + hstep, voffB);
            PG8_WAIT_V(6); PG8_BAR; PG8_MMA(1, 1, At, B1); PG8_BAR;
            }
        }
        if constexpr (ALIGN_EPI) { if (wr == 0) PG8_BAR; }
        if constexpr (!Epi::AFTER_DRAIN) { E(acc, cur, wr, wc, fr, fq); S.done(cur); }
        if (!has_next) break;
#pragma unroll
        for (int a = 0; a < 2; ++a)
#pragma unroll
            for (int b = 0; b < 2; ++b)
#pragma unroll
                for (int m = 0; m < 4; ++m)
#pragma unroll
                    for (int n = 0; n < 2; ++n) acc[a][b][m][n] = (f32x4){0.f, 0.f, 0.f, 0.f};
        cur = nxt; cA = nA; cB = nB; ++ui;
        if constexpr (ALIGN_EPI) { if (wr == 1) PG8_BAR; }
    }
    PG8_WAIT_V(0);
    if constexpr (!ALIGN_EPI) { if (wr == 0) PG8_BAR; }
    PG8_BAR;
    if constexpr (Epi::AFTER_DRAIN) { E.fused(acc, cur, wr, wc, fr, fq, lds, wid, lane); S.done(cur); }
#undef PG8_SA
#undef PG8_SB
#undef PG8_STAGE
#undef PG8_LDA
#undef PG8_LDB
#undef PG8_MMA
#undef PG8_WAIT_V
#undef PG8_WAIT_L
#undef PG8_BAR
#undef PG8_SCHED
}
}
namespace att {
enum { ORDER_NATURAL = 0, ORDER_REVERSED = 1, ORDER_PAIRED = 2, ORDER_XCD = 4 };
constexpr int D = 128, OSTR = 2048, BIAS_OFF = 69632;
constexpr float THR = 8.f;
constexpr bool WSKIP = false;
constexpr float SCALE = 0.08838834764831845f;
constexpr int NW = 8, QBLK = 32, KVBLK = 64, QB = NW * QBLK;
constexpr int SHM_V = KVBLK * D * 2, SHM_K = KVBLK * D * 2;
constexpr int LDS_BYTES = 2 * SHM_V + 2 * SHM_K + NW * 64 * 4;

using bf16 = __hip_bfloat16;
typedef short bf16x8 __attribute__((ext_vector_type(8)));
typedef short s16x4 __attribute__((ext_vector_type(4)));
typedef float f32x16 __attribute__((ext_vector_type(16)));
typedef float f32x4 __attribute__((ext_vector_type(4)));
typedef unsigned u32x4 __attribute__((ext_vector_type(4)));
template <class A, class Bt> struct same_t { static constexpr bool v = false; };
template <class A> struct same_t<A, A> { static constexpr bool v = true; };

#define KSWZ(row, colB) ((row) * 256 + ((colB) ^ (((row) & 7) << 4)))
#define SBAR() __builtin_amdgcn_sched_barrier(0)
__device__ __forceinline__ int v_st(int k, int c) { const int kk = (k & ~0xC) | ((k & 4) << 1) | ((k & 8) >> 1); return ((kk >> 3) * 4 + (c >> 5)) * 512 + ((kk & 7) * 32 + (c & 31)) * 2; }
__device__ __forceinline__ int v_rd_base(int lane) { return ((lane & 3) << 3) | (((lane >> 2) & 3) << 6) | (((lane >> 4) & 1) << 5) | (((lane >> 5) & 1) << 8); }
constexpr int v_rd_off(int d0, int ks, int half) { return d0 * 512 + ks * 4096 + half * 2048; }
__device__ __forceinline__ int crow(int r, int hi) { return (r & 3) + 8 * (r >> 2) + 4 * hi; }
__device__ __forceinline__ unsigned cvtpk(float lo, float hi) {
    unsigned r; asm volatile("v_cvt_pk_bf16_f32 %0, %1, %2" : "=v"(r) : "v"(lo), "v"(hi)); return r;
}
__device__ __forceinline__ bf16x8 pack8(f32x4 a, f32x4 b) {
    u32x4 w = {cvtpk(a[0], a[1]), cvtpk(a[2], a[3]), cvtpk(b[0], b[1]), cvtpk(b[2], b[3])};
    return *reinterpret_cast<bf16x8*>(&w);
}
template <class T> __device__ __forceinline__ bf16x8 load8(const T* p) {
    if constexpr (same_t<T, float>::v) { return pack8(*(const f32x4*)p, *(const f32x4*)(p + 4)); }
    else { return *reinterpret_cast<const bf16x8*>(p); }
}
__device__ __forceinline__ void mask_tile(f32x16& p0, f32x16& p1, int dq, unsigned W) {
    const float NEG = -__builtin_inff();
#pragma unroll
    for (int r = 0; r < 16; ++r) {
        const int c = (r & 3) + 8 * (r >> 2);
        if ((unsigned)(dq - c) >= W) p0[r] = NEG;
        if ((unsigned)(dq - c - 32) >= W) p1[r] = NEG;
    }
}
__device__ __forceinline__ void partialSM(f32x16& p0, f32x16& p1, float& m_reg, float& mn, float& alpha) {
    float pmax = p0[0]; for (int r = 1; r < 16; ++r) pmax = fmaxf(pmax, p0[r]); for (int r = 0; r < 16; ++r) pmax = fmaxf(pmax, p1[r]);
    { auto rr = __builtin_amdgcn_permlane32_swap(__float_as_uint(pmax), __float_as_uint(pmax), false, false);
      pmax = fmaxf(__uint_as_float(rr[0]), __uint_as_float(rr[1])); }
    constexpr float C2 = 1.4426950408889634f * SCALE;
    if (__builtin_expect(__all((pmax - m_reg) * SCALE <= THR), 1)) { mn = m_reg; alpha = 1.f; }
    else { mn = fmaxf(m_reg, pmax); alpha = __builtin_amdgcn_exp2f((m_reg - mn) * C2); m_reg = mn; }
    const float mnL = -mn * C2;
    for (int r = 0; r < 16; ++r) p0[r] = fmaf(p0[r], C2, mnL); for (int r = 0; r < 16; ++r) p1[r] = fmaf(p1[r], C2, mnL);
    for (int r = 0; r < 16; ++r) p0[r] = __builtin_amdgcn_exp2f(p0[r]);
}
__device__ __forceinline__ void finishSM(f32x16& p0, f32x16& p1, float alpha, float& l_reg, bf16x8& pa0, bf16x8& pa1, bf16x8& pa2, bf16x8& pa3) {
    for (int r = 0; r < 16; ++r) p1[r] = __builtin_amdgcn_exp2f(p1[r]);
    float ps = 0; for (int r = 0; r < 16; ++r) ps += p0[r]; for (int r = 0; r < 16; ++r) ps += p1[r];
    { auto rr = __builtin_amdgcn_permlane32_swap(__float_as_uint(ps), __float_as_uint(ps), false, false);
      ps = __uint_as_float(rr[0]) + __uint_as_float(rr[1]); }
    l_reg = l_reg * alpha + ps;
#define PK4(P, B_, OUT) do { unsigned a0 = cvtpk(P[B_+0], P[B_+1]), a1 = cvtpk(P[B_+2], P[B_+3]);                          \
        unsigned b0 = cvtpk(P[B_+4], P[B_+5]), b1 = cvtpk(P[B_+6], P[B_+7]);                                             \
        auto r0 = __builtin_amdgcn_permlane32_swap(a0, b0, false, false); auto r1 = __builtin_amdgcn_permlane32_swap(a1, b1, false, false); \
        u32x4 w = {r0[0], r1[0], r0[1], r1[1]}; OUT = *reinterpret_cast<bf16x8*>(&w); } while (0)
    PK4(p0, 0, pa0); PK4(p0, 8, pa1); PK4(p1, 0, pa2); PK4(p1, 8, pa3);
#undef PK4
}
template <int KB, bool SK>
__device__ __forceinline__ void qkt(f32x16& p0, f32x16& p1, const char* K_lds, int r32, int hi, const bf16x8* qr, bool act, const char* bl) {
    if (SK && !act) { const float NEG = -__builtin_inff();
#pragma unroll
        for (int r = 0; r < 16; ++r) { p0[r] = NEG; p1[r] = NEG; } return; }
    { const f32x4 c0 = *(const f32x4*)(bl), c1 = *(const f32x4*)(bl + 32), c2 = *(const f32x4*)(bl + 64), c3 = *(const f32x4*)(bl + 96);
      const f32x4 e0 = *(const f32x4*)(bl + 128), e1 = *(const f32x4*)(bl + 160), e2 = *(const f32x4*)(bl + 192), e3 = *(const f32x4*)(bl + 224);
      p0 = (f32x16){c0[0], c0[1], c0[2], c0[3], c1[0], c1[1], c1[2], c1[3], c2[0], c2[1], c2[2], c2[3], c3[0], c3[1], c3[2], c3[3]};
      p1 = (f32x16){e0[0], e0[1], e0[2], e0[3], e1[0], e1[1], e1[2], e1[3], e2[0], e2[1], e2[2], e2[3], e3[0], e3[1], e3[2], e3[3]}; }
    const char* kb[4];
#pragma unroll
    for (int dd = 0; dd < 4; ++dd) kb[dd] = K_lds + KB * SHM_K + KSWZ(r32, (dd * 16 + hi * 8) * 2);
#pragma unroll
    for (int d0 = 0; d0 < 8; ++d0) { const char* a = kb[d0 & 3] + (d0 >> 2) * 128;
        bf16x8 b0 = *reinterpret_cast<const bf16x8*>(a);
        bf16x8 b1 = *reinterpret_cast<const bf16x8*>(a + 32 * 256);
        p0 = __builtin_amdgcn_mfma_f32_32x32x16_bf16(b0, qr[d0], p0, 0, 0, 0);
        p1 = __builtin_amdgcn_mfma_f32_32x32x16_bf16(b1, qr[d0], p1, 0, 0, 0); }
}
template <int VB, bool SK>
__device__ __forceinline__ void pv_tile(f32x16* o, int vb0, bf16x8 pa0, bf16x8 pa1, bf16x8 pa2, bf16x8 pa3, bool act) {
    if (SK && !act) return;
#define TRRD(dst, off) asm volatile("ds_read_b64_tr_b16 %0, %1 offset:%2" : "=&v"(dst) : "v"(vb0), "i"(off) : "memory")
#define PV_D0(d0) do { s16x4 l0, l1, l2, l3, h0, h1, h2, h3; constexpr int b_ = VB * SHM_V + v_rd_off(d0, 0, 0);     \
        TRRD(l0, b_); TRRD(h0, b_ + 2048); TRRD(l1, b_ + 4096); TRRD(h1, b_ + 6144); TRRD(l2, b_ + 8192); TRRD(h2, b_ + 10240); TRRD(l3, b_ + 12288); TRRD(h3, b_ + 14336); \
        asm volatile("s_waitcnt lgkmcnt(0)" ::: "memory"); SBAR();                 \
        o[d0] = __builtin_amdgcn_mfma_f32_32x32x16_bf16(pa0, (bf16x8){l0[0], l0[1], l0[2], l0[3], h0[0], h0[1], h0[2], h0[3]}, o[d0], 0, 0, 0);   \
        o[d0] = __builtin_amdgcn_mfma_f32_32x32x16_bf16(pa1, (bf16x8){l1[0], l1[1], l1[2], l1[3], h1[0], h1[1], h1[2], h1[3]}, o[d0], 0, 0, 0);   \
        o[d0] = __builtin_amdgcn_mfma_f32_32x32x16_bf16(pa2, (bf16x8){l2[0], l2[1], l2[2], l2[3], h2[0], h2[1], h2[2], h2[3]}, o[d0], 0, 0, 0);   \
        o[d0] = __builtin_amdgcn_mfma_f32_32x32x16_bf16(pa3, (bf16x8){l3[0], l3[1], l3[2], l3[3], h3[0], h3[1], h3[2], h3[3]}, o[d0], 0, 0, 0); } while (0)
    PV_D0(0); PV_D0(1); PV_D0(2); PV_D0(3);
#undef PV_D0
#undef TRRD
}

template <class TIn, class TOut> struct BlockRef { const TIn* Q; const TIn* K; const TIn* V; TOut* O; const TOut* Z; const float* C; int P0; };
template <class TIn> struct Seam {
    bf16x8 qr[8];
    bf16x8 st_v0, st_v1, st_k0, st_k1; f32x4 sf0, sf1, sf2, sf3;
    f32x4 tq[16];
};
__device__ __forceinline__ int swa_jlo(int P0, int W) { const int lowk = P0 - W + 1; return lowk > 0 ? lowk / KVBLK : 0; }
#define ROW(p, k0, rr) ((p) + (size_t)((k0) + (rr)) * D + sc)
#define VMW() asm volatile("s_waitcnt vmcnt(0)" ::: "memory")
#define VMWN(n) asm volatile("s_waitcnt vmcnt(%0)" :: "i"(n) : "memory")
#define SLOAD_H(Kp, Vp, k0) do { S.st_v0 = load8<TIn>(ROW(Vp, k0, sr)); S.st_v1 = load8<TIn>(ROW(Vp, k0, 32 + sr));              \
                         S.st_k0 = load8<TIn>(ROW(Kp, k0, sr)); S.st_k1 = load8<TIn>(ROW(Kp, k0, 32 + sr)); } while (0)
#define SWRITE_HK(bf) do { *(bf16x8*)(K_lds + (bf) * SHM_K + kws) = S.st_k0; *(bf16x8*)(K_lds + (bf) * SHM_K + kws + 32 * 256) = S.st_k1; } while (0)
#define SWRITE_HV(bf) do { *(bf16x8*)(V_lds + (bf) * SHM_V + vst0) = S.st_v0; *(bf16x8*)(V_lds + (bf) * SHM_V + vst1) = S.st_v1; } while (0)
#define SWRITE_H(bf) do { SWRITE_HV(bf); SWRITE_HK(bf); } while (0)
#define SLOAD_F(p, k0) do { S.sf0 = *(const f32x4*)ROW(p, k0, sr); S.sf1 = *(const f32x4*)(ROW(p, k0, sr) + 4);                \
                            S.sf2 = *(const f32x4*)ROW(p, k0, 32 + sr); S.sf3 = *(const f32x4*)(ROW(p, k0, 32 + sr) + 4); } while (0)
#define SWRITE_KF(bf) do { *(bf16x8*)(K_lds + (bf) * SHM_K + kws) = pack8(S.sf0, S.sf1); *(bf16x8*)(K_lds + (bf) * SHM_K + kws + 32 * 256) = pack8(S.sf2, S.sf3); } while (0)
#define SWRITE_VF(bf) do { *(bf16x8*)(V_lds + (bf) * SHM_V + vst0) = pack8(S.sf0, S.sf1); *(bf16x8*)(V_lds + (bf) * SHM_V + vst1) = pack8(S.sf2, S.sf3); } while (0)
template <class TIn, class TOut>
__device__ __forceinline__ void causal_swa_prime(const BlockRef<TIn, TOut>& cur, int W, char* lds, Seam<TIn>& S, int wave_s) {
    constexpr bool F32 = same_t<TIn, float>::v;
    const int tid = fresh_tid(wave_s), wid = __builtin_amdgcn_readfirstlane(tid >> 6), lane = tid & 63, r32 = lane & 31, hi = lane >> 5;
    const int sr = tid >> 4, sc = (tid & 15) * 8, kws = KSWZ(sr, sc * 2); char* K_lds = lds + 2 * SHM_V;
    const int kb0 = cur.P0 + QB - KVBLK;
    for (int d0 = 0; d0 < 8; ++d0) S.qr[d0] = load8<TIn>(cur.Q + (size_t)(wid * QBLK + r32) * D + d0 * 16 + hi * 8);
    if constexpr (F32) { SLOAD_F((const float*)cur.K, kb0); VMW(); SWRITE_KF(0); SBAR(); SLOAD_F((const float*)cur.V, kb0); }
    else { SLOAD_H(cur.K, cur.V, kb0); VMW(); SWRITE_HK(0); }
    __syncthreads();
}
template <class TIn, class TOut>
__device__ __forceinline__ void causal_swa_block(const BlockRef<TIn, TOut>& cur, const BlockRef<TIn, TOut>& nxt, int skv, int W, char* lds, Seam<TIn>& S, float TH, float TH2, int wave_s) {
    constexpr bool F32 = same_t<TIn, float>::v;
    const int tid = fresh_tid(wave_s), wid = __builtin_amdgcn_readfirstlane(tid >> 6), lane = tid & 63, r32 = lane & 31, hi = lane >> 5;
    int j_lo;
    int tq_ = tid; asm volatile("" : "+v"(tq_));
    { const int ntb = cur.P0 / KVBLK; const float ref = cur.C[cur.P0]; const int t0 = tq_ & 63, t1 = (tq_ & 63) + 64;
      const float v0 = t0 < ntb ? cur.C[t0 * KVBLK + KVBLK - 1] : ref, v1 = t1 < ntb ? cur.C[t1 * KVBLK + KVBLK - 1] : ref;
      j_lo = __builtin_amdgcn_readfirstlane((int)(__popcll(__ballot(ref - v0 > TH)) + __popcll(__ballot(ref - v1 > TH)))); }
    int j_hi = (cur.P0 + QB - 1) / KVBLK + 1; if (j_hi > skv / KVBLK) j_hi = skv / KVBLK;
    int NT = j_hi - j_lo;
    const int kbn = nxt.P0 + QB - KVBLK;
    const int qlo = cur.P0 + wid * QBLK, qm = qlo + r32 - 4 * hi;
    char* V_lds = lds; char* K_lds = lds + 2 * SHM_V;
    float* ws = (float*)(lds + 2 * SHM_V + 2 * SHM_K) + wid * 64; float* li_l = ws, * al_l = ws + 32;
    float m_reg = -1e30f, l_reg = 0; f32x16 o[4] = {};
    const int sr = tid >> 4, sc = (tid & 15) * 8, vst0 = v_st(sr, sc), vst1 = v_st(32 + sr, sc), kws = KSWZ(sr, sc * 2);
    const int vb0 = (int)(uintptr_t)V_lds + v_rd_base(lane);
    const TIn* Kh = cur.K; const TIn* Vh = cur.V;
    const char* bias0 = lds + BIAS_OFF + 16 * hi;
    { const int n4 = (cur.P0 + QB) >> 2; f32x4* bdst = (f32x4*)(lds + BIAS_OFF); const f32x4* bsrc = (const f32x4*)cur.C;
      for (int i = j_lo * (KVBLK / 4) + tq_; i < n4; i += 64 * NW) bdst[i] = bsrc[i];
      __syncthreads(); }
#define BIASP(t) (bias0 + KBASE(t) * 4)
#define RESC(a) do { if (__any((a) < 1.f)) { if (hi == 0) al_l[r32] = (a); asm volatile("s_waitcnt lgkmcnt(0)" ::: "memory");              \
                     for (int d_ = 0; d_ < 4; ++d_) for (int r = 0; r < 16; ++r) o[d_][r] *= al_l[crow(r, hi)]; } } while (0)
#define KBASE(t) ((j_hi - 1 - (t)) * KVBLK)
#define ACT(t) (KBASE(t) <= qlo + QBLK - 1 && KBASE(t) + KVBLK - 1 >= qlo - W + 1)
#define MASKT(P0_, P1_, t) do { const int kb_ = KBASE(t); if ((!SK || ACT(t)) && (kb_ + KVBLK - 1 > qlo || kb_ <= qlo + QBLK - 1 - W)) mask_tile(P0_, P1_, qm - kb_, (unsigned)W); } while (0)
    constexpr int NQL = F32 ? 16 : 8;
    constexpr bool SK = WSKIP && !F32;
#define SEAM_K0() do { VMWN(NQL); if constexpr (F32) { SWRITE_KF(0); SBAR(); SLOAD_F((const float*)nxt.V, kbn); } else { SWRITE_HK(0); } SBAR(); } while (0)
    f32x16 pA0, pA1, pB0, pB1; float mnA, mnB, alA, alB; bf16x8 pa0, pa1, pa2, pa3;
    if constexpr (F32) { VMW(); SWRITE_VF(0); SBAR(); } else { SWRITE_HV(0); SBAR(); }
    if (NT > 1) { if constexpr (F32) SLOAD_F((const float*)Kh, KBASE(1)); else SLOAD_H(Kh, Vh, KBASE(1)); }
    SBAR(); qkt<0, SK>(pA0, pA1, K_lds, r32, hi, S.qr, ACT(0), BIASP(0));
    if constexpr (F32) { if (NT > 1) { VMW(); SWRITE_KF(1); SBAR(); SLOAD_F((const float*)Vh, KBASE(1)); } }
    MASKT(pA0, pA1, 0); partialSM(pA0, pA1, m_reg, mnA, alA);
    if (NT > 1) { VMW(); if constexpr (F32) { SWRITE_VF(1); SBAR(); if (NT > 2) SLOAD_F((const float*)Kh, KBASE(2)); } else SWRITE_H(1); }
    __syncthreads();
#define HALF_STEP(PX0, PX1, mnX, alX, PY0, PY1, alY, t, KB, VB, SB) do {                                                      \
        SBAR(); qkt<KB, SK>(PX0, PX1, K_lds, r32, hi, S.qr, ACT(t), BIASP(t));                                             \
        finishSM(PY0, PY1, alY, l_reg, pa0, pa1, pa2, pa3); SBAR();                                                           \
        if ((t) + 1 < NT) { if constexpr (F32) { VMW(); SWRITE_KF(SB); SBAR(); SLOAD_F((const float*)Vh, KBASE((t) + 1)); }  \
                            else { SLOAD_H(Kh, Vh, KBASE((t) + 1)); } SBAR(); }                                               \
        pv_tile<VB, SK>(o, vb0, pa0, pa1, pa2, pa3, ACT((t) - 1)); MASKT(PX0, PX1, (t)); partialSM(PX0, PX1, m_reg, mnX, alX);                                        \
        __syncthreads();                                                                                                      \
        if ((t) + 1 < NT) { VMW(); if constexpr (F32) { SWRITE_VF(SB); SBAR(); if ((t) + 2 < NT) SLOAD_F((const float*)Kh, KBASE((t) + 2)); } \
                            else { SWRITE_H(SB); } }                                                                          \
        RESC(alX); __syncthreads(); } while (0)
    for (int t = 1; t + 1 < NT; t += 2) {
        HALF_STEP(pB0, pB1, mnB, alB, pA0, pA1, alA, t, 1, 0, 0);
        HALF_STEP(pA0, pA1, mnA, alA, pB0, pB1, alB, t + 1, 0, 1, 1);
        if (t == 3) {
            float mm = m_reg;
#pragma unroll
            for (int o_ = 1; o_ < 64; o_ <<= 1) mm = fminf(mm, __shfl_xor(mm, o_));
            float* mmw = (float*)(lds + BIAS_OFF - 1024);
            if (lane == 0) mmw[wid] = mm;
            __syncthreads();
            float bm = fminf(fminf(fminf(mmw[0], mmw[1]), fminf(mmw[2], mmw[3])), fminf(fminf(mmw[4], mmw[5]), fminf(mmw[6], mmw[7]))) - TH2;
            const int ntb = cur.P0 / KVBLK, t0 = j_lo + lane, t1 = j_lo + lane + 64;
            const float b0_ = t0 < ntb ? *(const float*)(lds + BIAS_OFF + (t0 * KVBLK + KVBLK - 1) * 4) : bm, b1_ = t1 < ntb ? *(const float*)(lds + BIAS_OFF + (t1 * KVBLK + KVBLK - 1) * 4) : bm;
            const int skip = __builtin_amdgcn_readfirstlane((int)(__popcll(__ballot(b0_ < bm)) + __popcll(__ballot(b1_ < bm))));
            int nt2 = NT - skip; if (nt2 < 5) nt2 = 5;
            if (nt2 < NT) NT = nt2;
        }
    }
    const bool even = (NT & 1) == 0;
    if (even) { SBAR(); qkt<1, SK>(pB0, pB1, K_lds, r32, hi, S.qr, ACT(NT - 1), BIASP(NT - 1)); SBAR(); }
#define QROW(e) (nxt.Q + (size_t)(wid * QBLK + r32) * D + ((e) >> 1) * 16 + hi * 8 + ((e) & 1) * 4)
    if constexpr (F32) { SLOAD_F((const float*)nxt.K, kbn); SBAR();
#pragma unroll
        for (int e = 0; e < 8; ++e) S.tq[e] = *(const f32x4*)QROW(e); }
    else { SLOAD_H(nxt.K, nxt.V, kbn); SBAR();
#pragma unroll
        for (int d0 = 0; d0 < 8; ++d0) S.qr[d0] = load8<TIn>(nxt.Q + (size_t)(wid * QBLK + r32) * D + d0 * 16 + hi * 8); }
    SBAR();
    finishSM(pA0, pA1, alA, l_reg, pa0, pa1, pa2, pa3); SBAR();
    if constexpr (F32) {
#pragma unroll
        for (int e = 8; e < 16; ++e) S.tq[e] = *(const f32x4*)QROW(e); SBAR(); }
#undef QROW
    pv_tile<0, SK>(o, vb0, pa0, pa1, pa2, pa3, ACT(even ? NT - 2 : NT - 1));
    if (even) { MASKT(pB0, pB1, NT - 1); partialSM(pB0, pB1, m_reg, mnB, alB); __syncthreads(); RESC(alB);
        finishSM(pB0, pB1, alB, l_reg, pa0, pa1, pa2, pa3); SBAR(); pv_tile<1, SK>(o, vb0, pa0, pa1, pa2, pa3, ACT(NT - 1)); }
    SBAR(); SEAM_K0();
    if (hi == 0) li_l[r32] = l_reg; asm volatile("s_waitcnt lgkmcnt(0)" ::: "memory");
    float rli[16];
#pragma unroll
    for (int r = 0; r < 16; ++r) rli[r] = __builtin_amdgcn_rcpf(li_l[crow(r, hi)]);
    int eo = (wid * QBLK + 4 * hi) * OSTR + r32; asm volatile("" : "+v"(eo));
    TOut* Ow = cur.O + eo; const TOut* Zw = cur.Z + eo;
#pragma unroll
    for (int r = 0; r < 16; ++r) { const int orow = ((r & 3) + 8 * (r >> 2)) * OSTR;
#pragma unroll
        for (int d0 = 0; d0 < 4; ++d0) { const float v = o[d0][r] * rli[r] * __bfloat162float(Zw[orow + d0 * 32]);
            if constexpr (same_t<TOut, float>::v) { Ow[orow + d0 * 32] = v; }
            else { const float vn = __shfl_xor(v, 1);
                   if ((r32 & 1) == 0) *(unsigned*)(Ow + orow + d0 * 32) = cvtpk(v, vn); } } }
    if constexpr (F32) {
#pragma unroll
        for (int d0 = 0; d0 < 8; ++d0) S.qr[d0] = pack8(S.tq[2 * d0], S.tq[2 * d0 + 1]); }
    __syncthreads();
#undef RESC
#undef BIASP
#undef KBASE
#undef ACT
#undef MASKT
#undef SEAM_K0
#undef HALF_STEP
}
#undef ROW
#undef VMW
#undef VMWN
#undef SLOAD_H
#undef SWRITE_HK
#undef SWRITE_HV
#undef SWRITE_H
#undef SLOAD_F
#undef SWRITE_KF
#undef SWRITE_VF

__host__ __device__ inline int swa_nramp(int nqb, int W, int qoff) { const int t = W - 1 - qoff; const int n = t < 0 ? 0 : t / QB + 1; return n > nqb ? nqb : n; }
__host__ __device__ inline int swa_nx(int nqb, int nramp, int order) { return (order & ORDER_PAIRED) ? (nramp + 1) / 2 + (nqb - nramp) : nqb; }
struct SwaItem { int bh, qb0, qb1; };
__device__ __forceinline__ SwaItem swa_decode(int L, int nb, int nh, int nhkv, int nqb, int nx, int nramp, int order) {
    const int G = nh / nhkv; SwaItem it; int x;
    if ((order & ORDER_XCD) && (nb * nhkv) % 8 == 0) { const int xcd = L & 7, k = L >> 3, per = G * nx, gi = k / per, r = k - gi * per;
        it.bh = (gi * 8 + xcd) * G + r / nx; x = r % nx; }
    else { it.bh = L / nx; x = L - it.bh * nx; }
    if (order & ORDER_PAIRED) { const int ns = nqb - nramp;
        if (x < ns) { it.qb0 = it.qb1 = nqb - 1 - x; } else { it.qb0 = x - ns; it.qb1 = nramp - 1 - it.qb0; } }
    else { it.qb0 = it.qb1 = ((order & 3) == ORDER_REVERSED) ? nqb - 1 - x : x; }
    return it;
}
template <class TIn, class TOut>
__device__ __forceinline__ BlockRef<TIn, TOut> mk_ref(const SwaItem& it, int pass, const TIn* Qb, const TIn* Kb, const TIn* Vb, TOut* Ob, const TOut* Zb, const float* Cb, int seq) {
    const int qb = pass ? it.qb1 : it.qb0, bb = it.bh >> 4, hh = it.bh & 15; BlockRef<TIn, TOut> r;
    r.Q = Qb + ((size_t)it.bh * seq + (size_t)qb * QB) * D; r.K = Kb + (size_t)it.bh * seq * D; r.V = Vb + (size_t)it.bh * seq * D;
    r.O = Ob + ((size_t)bb * seq + (size_t)qb * QB) * OSTR + hh * D; r.Z = Zb + ((size_t)bb * seq + (size_t)qb * QB) * OSTR + hh * D;
    r.C = Cb + (size_t)it.bh * seq; r.P0 = qb * QB; return r;
}
}

#define LAS __attribute__((address_space(3)))
typedef unsigned short bf16r;
typedef float f32x4 __attribute__((ext_vector_type(4)));
typedef float f32x2 __attribute__((ext_vector_type(2)));
typedef unsigned u32x4 __attribute__((ext_vector_type(4)));
typedef unsigned u32x2 __attribute__((ext_vector_type(2)));
typedef short bf16x8 __attribute__((ext_vector_type(8)));
constexpr int BATCH = 4, SEQ = 8192, DM = 2048, M = BATCH * SEQ, NH = 16, PLE = 256;
constexpr int NFOX = 4 * DM + NH, NFOXP = 8448;
constexpr float EPS = 1e-6f;
constexpr size_t MiB = (size_t)1 << 20;
constexpr size_t WS_GBUF = 65536, WS_NEGC = 1 * MiB, WS_LOGF = 3 * MiB, WS_SS = 5 * MiB, WS_RSTD = 9 * MiB;
constexpr size_t WS_WFOX = 16 * MiB, WS_WOF = 49 * MiB, WS_WHG = 57 * MiB, WS_WOH = 89 * MiB, WS_WPE = 97 * MiB, WS_WPG = 99 * MiB, WS_PB = 116 * MiB;
constexpr size_t WS_A = 148 * MiB, WS_B = 276 * MiB, WS_C = 404 * MiB, WS_D = 532 * MiB, WS_E = 660 * MiB, WS_F = 788 * MiB, WS_END = 916 * MiB;
constexpr int NTHR = 512, NWAVES = 8;
constexpr int LDS_BYTES = 147456;

#define LDS_WAIT() asm volatile("s_waitcnt lgkmcnt(0)" ::: "memory")
#define HBAR() do { asm volatile("s_waitcnt lgkmcnt(0)" ::: "memory"); __builtin_amdgcn_s_barrier(); asm volatile("" ::: "memory"); } while (0)

__device__ __forceinline__ float wave_sum(float v) {
#pragma unroll
    for (int o = 1; o < 64; o <<= 1) v += __shfl_xor(v, o);
    return v;
}
__device__ __forceinline__ u32x4 pack8(const f32x4 a, const f32x4 b) { u32x4 w; w.x = cvtpk_s(a[0], a[1]); w.y = cvtpk_s(a[2], a[3]); w.z = cvtpk_s(b[0], b[1]); w.w = cvtpk_s(b[2], b[3]); return w; }

__device__ __forceinline__ void transpose_item(const float* W, int ldw, int K, int nblk, bf16r* WT, const float* kscale, LAS float* scr, int item, int lane) {
    const int kb = item / nblk, nb = item - kb * nblk, k0 = 64 * kb, n0 = 32 * nb;
#pragma unroll 8
    for (int i = 0; i < 32; ++i) { const int kk = 2 * i + (lane >> 5); float v = W[(size_t)(k0 + kk) * ldw + n0 + (lane & 31)]; if (kscale) v *= kscale[k0 + kk]; scr[kk * 33 + (lane & 31)] = v; }
    LDS_WAIT(); asm volatile("" ::: "memory");
    const int c = lane & 7;
#pragma unroll
    for (int j = 0; j < 4; ++j) { const int n = (lane >> 3) + 8 * j; const LAS float* s = scr + (8 * c) * 33 + n;
        u32x4 o; o.x = cvtpk_s(s[0 * 33], s[1 * 33]); o.y = cvtpk_s(s[2 * 33], s[3 * 33]); o.z = cvtpk_s(s[4 * 33], s[5 * 33]); o.w = cvtpk_s(s[6 * 33], s[7 * 33]);
        *(u32x4*)(WT + (size_t)(n0 + n) * K + k0 + 8 * c) = o; }
    LDS_WAIT(); asm volatile("" ::: "memory");
}

#define XB_TMO      128
#define XB_XCNT(j)  (256  + 64 * (j))
#define XB_XSUB(j)  (1280 + 64 * (j))
#define XB_XGEN(j)  (2304 + 64 * (j))
#define XB_TOP      3328
#define XB_TOPGEN   3392
#define XCD_BAR_WORDS 3456
#define XB_SPIN_CAP (1u << 18)

__device__ __forceinline__ unsigned xb_ld(unsigned* p)              { return __hip_atomic_load(p, __ATOMIC_RELAXED, __HIP_MEMORY_SCOPE_AGENT); }
__device__ __forceinline__ unsigned xb_add(unsigned* p, unsigned v) { return __hip_atomic_fetch_add(p, v, __ATOMIC_RELAXED, __HIP_MEMORY_SCOPE_AGENT); }
__device__ __forceinline__ unsigned xb_xcc_id() { return (unsigned)__builtin_amdgcn_s_getreg((3 << 11) | 20) & 0xFu; }
#define XB_SPIN(cond, bar) do { unsigned _sp = 0; while (cond) { __builtin_amdgcn_s_sleep(1); \
    if ((++_sp & 255u) == 0u) { if (xb_ld(&(bar)[XB_TMO])) break; if (_sp > XB_SPIN_CAP) { atomicAdd(&(bar)[XB_TMO], 1u); break; } } } } while (0)

struct XcdBarrier {
    unsigned* bar; unsigned x; int wv;
    volatile LAS unsigned* st;
};

__device__ __forceinline__ XcdBarrier xcd_barrier_post(unsigned* bar, volatile LAS unsigned* st, int wave_s) {
    XcdBarrier b; b.bar = bar; b.x = xb_xcc_id(); b.st = st; b.wv = wave_s;
    if (fresh_tid(wave_s) == 0) (void)xb_add(&bar[XB_XCNT(b.x)], 1u);
    return b;
}
__device__ __forceinline__ void xcd_barrier_complete(unsigned* bar, unsigned x, unsigned& nloc, unsigned& nx) {
    const unsigned G = gridDim.x * gridDim.y * gridDim.z;
    unsigned sum, cnt, mine, sp = 0u;
    for (;;) {
        sum = 0u; cnt = 0u; mine = 0u;
#pragma unroll
        for (unsigned j = 0; j < 16; ++j) { const unsigned c = xb_ld(&bar[XB_XCNT(j)]); sum += c; cnt += (c > 0u) ? 1u : 0u; mine = (j == x) ? c : mine; }
        if (sum == G) break;
        __builtin_amdgcn_s_sleep(1);
        if ((++sp & 255u) == 0u) { if (xb_ld(&bar[XB_TMO])) break; if (sp > XB_SPIN_CAP) { atomicAdd(&bar[XB_TMO], 1u); break; } }
    }
    nloc = mine > 0u ? mine : 1u; nx = cnt > 0u ? cnt : 1u;
}

__device__ __forceinline__ void xcd_barrier(const XcdBarrier& b) {
    asm volatile("s_waitcnt vmcnt(0)" ::: "memory");
    __syncthreads();
    if (fresh_tid(b.wv) == 0) {
        unsigned* bar = b.bar;
        __builtin_amdgcn_s_waitcnt(0);
        unsigned nloc = b.st[0], nx = b.st[1];
        if (nloc == 0u) { xcd_barrier_complete(bar, b.x, nloc, nx); b.st[0] = nloc; b.st[1] = nx; }
        const unsigned old = xb_add(&bar[XB_XSUB(b.x)], 1u);
        const unsigned gen = old / nloc;
        if (old + 1u == (gen + 1u) * nloc) {
            __builtin_amdgcn_fence(__ATOMIC_RELEASE, "agent");
            asm volatile("s_waitcnt vmcnt(0)" ::: "memory");
            const unsigned og = xb_add(&bar[XB_TOP], 1u);
            const unsigned tg = og / nx;
            if (og + 1u == (tg + 1u) * nx) xb_add(&bar[XB_TOPGEN], 1u);
            else XB_SPIN(xb_ld(&bar[XB_TOPGEN]) == tg, bar);
            __builtin_amdgcn_fence(__ATOMIC_ACQUIRE, "agent");
            xb_add(&bar[XB_XGEN(b.x)], 1u);
            asm volatile("s_waitcnt vmcnt(0)" ::: "memory");
        } else {
            XB_SPIN(xb_ld(&bar[XB_XGEN(b.x)]) == gen, bar);
            __builtin_amdgcn_fence(__ATOMIC_ACQUIRE, "agent");
            asm volatile("s_waitcnt vmcnt(0)" ::: "memory");
        }
    }
    __syncthreads();
}

#ifndef REP
#define REP 0
#endif
#define PH_LOOP_ { int nrep_ = 2; asm volatile("" : "+s"(nrep_)); for (int rep_ = 0; rep_ < nrep_; ++rep_) {
#define PH_LOOPEND_ } }
#if (REP >> 0) & 1
#define PH_BEGIN_0 PH_LOOP_
#define PH_END_0 PH_LOOPEND_
#else
#define PH_BEGIN_0 {
#define PH_END_0 }
#endif
#if (REP >> 1) & 1
#define PH_BEGIN_1 PH_LOOP_
#define PH_END_1 PH_LOOPEND_
#else
#define PH_BEGIN_1 {
#define PH_END_1 }
#endif
#if (REP >> 2) & 1
#define PH_BEGIN_2 PH_LOOP_
#define PH_END_2 PH_LOOPEND_
#else
#define PH_BEGIN_2 {
#define PH_END_2 }
#endif
#if (REP >> 3) & 1
#define PH_BEGIN_3 PH_LOOP_
#define PH_END_3 PH_LOOPEND_
#else
#define PH_BEGIN_3 {
#define PH_END_3 }
#endif
#if (REP >> 4) & 1
#define PH_BEGIN_4 PH_LOOP_
#define PH_END_4 PH_LOOPEND_
#else
#define PH_BEGIN_4 {
#define PH_END_4 }
#endif
#if (REP >> 5) & 1
#define PH_BEGIN_5 PH_LOOP_
#define PH_END_5 PH_LOOPEND_
#else
#define PH_BEGIN_5 {
#define PH_END_5 }
#endif
#if (REP >> 6) & 1
#define PH_BEGIN_6 PH_LOOP_
#define PH_END_6 PH_LOOPEND_
#else
#define PH_BEGIN_6 {
#define PH_END_6 }
#endif
#if (REP >> 7) & 1
#define PH_BEGIN_7 PH_LOOP_
#define PH_END_7 PH_LOOPEND_
#else
#define PH_BEGIN_7 {
#define PH_END_7 }
#endif
struct Args { const float* in[15]; float* out; unsigned char* ws; };

namespace hg {
constexpr int QS = 272, TS = 144;
constexpr int SET_BYTES = 58368, OFF_Q = 0, OFF_K = 17408, OFF_KT = 34816, OFF_VT = 53248, OFF_DL = 57856;
constexpr int OFF_ST = 2 * SET_BYTES, ST_BYTES = 8704;
#define MFMA16(a, b, c) __builtin_amdgcn_mfma_f32_16x16x32_bf16((a), (b), (c), 0, 0, 0)
template <int SET> __device__ __forceinline__ void hgE(LAS unsigned char* lds, const unsigned (&gh)[16], const unsigned (&qv)[16], int w, int lane) {
    LAS unsigned char* base = lds + SET * SET_BYTES;
    typedef _Float16 f16x2_t __attribute__((ext_vector_type(2)));
    f32x2 gv[16];
#pragma unroll
    for (int j = 0; j < 16; ++j) { const f16x2_t t = __builtin_bit_cast(f16x2_t, gh[j]); gv[j] = (f32x2){(float)t.x, (float)t.y}; }
    const int cp = lane & 15, rg = lane >> 4;
    float run0 = 1.f, run1 = 1.f;
#pragma unroll
    for (int j = 0; j < 16; ++j) { run0 *= gv[j].x; run1 *= gv[j].y; }
    float i0 = run0, i1 = run1;
    { const float a0 = __shfl_up(i0, 16), a1 = __shfl_up(i1, 16); if (rg >= 1) { i0 *= a0; i1 *= a1; } }
    { const float a0 = __shfl_up(i0, 32), a1 = __shfl_up(i1, 32); if (rg >= 2) { i0 *= a0; i1 *= a1; } }
    float pre0 = __shfl_up(i0, 16), pre1 = __shfl_up(i1, 16); if (rg == 0) { pre0 = 1.f; pre1 = 1.f; }
    const float all0 = __shfl(i0, cp + 48), all1 = __shfl(i1, cp + 48);
    unsigned kh0[8], kh1[8]; float kp0 = 0.f, kp1 = 0.f, ea = pre0, eb = pre1;
    LAS unsigned char* qw = base + OFF_Q + (16 * rg) * QS + (32 * w + 2 * cp) * 2;
#pragma unroll
    for (int j = 0; j < 16; ++j) {
        ea *= gv[j].x; eb *= gv[j].y;
        const float qa = bf_lo(qv[j]) * ea, qb = bf_hi(qv[j]) * eb;
        const float ka = (1.f - gv[j].x) * __builtin_amdgcn_rcpf(ea), kb = (1.f - gv[j].y) * __builtin_amdgcn_rcpf(eb);
        *(LAS unsigned*)(qw + j * QS) = cvtpk_s(qa, qb);
        *(LAS unsigned*)(qw + (OFF_K - OFF_Q) + j * QS) = cvtpk_s(ka, kb);
        const float ha = ka * all0, hb = kb * all1;
        if (j & 1) { kh0[j >> 1] = cvtpk_s(kp0, ha); kh1[j >> 1] = cvtpk_s(kp1, hb); } else { kp0 = ha; kp1 = hb; }
    }
    LAS unsigned char* kw = base + OFF_KT + (32 * w + 2 * cp) * TS + rg * 32;
    *(LAS u32x4*)(kw) = (u32x4){kh0[0], kh0[1], kh0[2], kh0[3]}; *(LAS u32x4*)(kw + 16) = (u32x4){kh0[4], kh0[5], kh0[6], kh0[7]};
    *(LAS u32x4*)(kw + TS) = (u32x4){kh1[0], kh1[1], kh1[2], kh1[3]}; *(LAS u32x4*)(kw + TS + 16) = (u32x4){kh1[4], kh1[5], kh1[6], kh1[7]};
    if (rg == 0) *(LAS f32x2*)(base + OFF_DL + (32 * w + 2 * cp) * 4) = (f32x2){all0, all1};
}
template <int SET, int VAR = 0> __device__ __forceinline__ void hgM(LAS unsigned char* lds, f32x4 (&st)[2][2], int ti, int lane, char* ob, unsigned ol) {
    const int l16 = lane & 15, kq = lane >> 4;
    const LAS unsigned char* base = lds + SET * SET_BYTES;
    bf16x8 qf[4], kf[4][4], sb[2][4], kt[2][2], vv[2][2]; u32x2 va[2][2], vb2[2][2]; f32x4 dl[2];
    const LAS unsigned char* qrow = base + OFF_Q + (16 * ti + l16) * QS + kq * 16;
    const LAS unsigned char* krow = base + OFF_K + l16 * QS + kq * 16;
    const LAS unsigned char* srow = lds + OFF_ST + SET * ST_BYTES + l16 * QS + kq * 16;
    const LAS unsigned char* vrow = base + OFF_VT + l16 * TS;
#pragma unroll
    for (int kk = 0; kk < 4; ++kk) { qf[kk] = *(const LAS bf16x8*)(qrow + kk * 64); sb[0][kk] = *(const LAS bf16x8*)(srow + kk * 64); sb[1][kk] = *(const LAS bf16x8*)(srow + 16 * QS + kk * 64); }
#pragma unroll
    for (int si = 0; si < 4; ++si)
#pragma unroll
        for (int kk = 0; kk < 4; ++kk) kf[si][kk] = *(const LAS bf16x8*)(krow + si * 16 * QS + kk * 64);
#pragma unroll
    for (int vh = 0; vh < 2; ++vh)
#pragma unroll
        for (int p = 0; p < 2; ++p) { va[vh][p] = *(const LAS u32x2*)(vrow + vh * 16 * TS + kq * 8 + p * 64); vb2[vh][p] = *(const LAS u32x2*)(vrow + vh * 16 * TS + kq * 8 + p * 64 + 32); }
#pragma unroll
    for (int kk = 0; kk < 2; ++kk) { vv[0][kk] = *(const LAS bf16x8*)(vrow + kk * 64 + kq * 16); vv[1][kk] = *(const LAS bf16x8*)(vrow + 16 * TS + kk * 64 + kq * 16);
        kt[0][kk] = *(const LAS bf16x8*)(base + OFF_KT + (32 * ti + l16) * TS + kk * 64 + kq * 16); kt[1][kk] = *(const LAS bf16x8*)(base + OFF_KT + (32 * ti + 16 + l16) * TS + kk * 64 + kq * 16); }
    dl[0] = *(const LAS f32x4*)(base + OFF_DL + (32 * ti + 4 * kq) * 4); dl[1] = *(const LAS f32x4*)(base + OFF_DL + (32 * ti + 16 + 4 * kq) * 4);
    __builtin_amdgcn_sched_barrier(0);
    f32x4 o[2], as[4];
    o[0] = (f32x4){0.f, 0.f, 0.f, 0.f}; o[1] = o[0];
#pragma unroll
    for (int si = 0; si < 4; ++si) as[si] = (f32x4){0.f, 0.f, 0.f, 0.f};
#pragma unroll
    for (int kk = 0; kk < 4; ++kk) { o[0] = MFMA16(qf[kk], sb[0][kk], o[0]); o[1] = MFMA16(qf[kk], sb[1][kk], o[1]);
#pragma unroll
        for (int si = 0; si < 4; ++si) as[si] = MFMA16(kf[si][kk], qf[kk], as[si]); }
#pragma unroll
    for (int ds = 0; ds < 2; ++ds)
#pragma unroll
        for (int vh = 0; vh < 2; ++vh) { st[ds][vh] = st[ds][vh] * dl[ds];
#pragma unroll
            for (int kk = 0; kk < 2; ++kk) st[ds][vh] = MFMA16(kt[ds][kk], vv[vh][kk], st[ds][vh]); }
    const int tq = 16 * ti + l16 - 4 * kq;
#pragma unroll
    for (int si = 0; si < 4; ++si)
#pragma unroll
        for (int j = 0; j < 4; ++j) if (16 * si + j > tq) as[si][j] = 0.f;
#pragma unroll
    for (int p = 0; p < 2; ++p) {
        u32x4 pw; pw.x = cvtpk_s(as[2 * p][0], as[2 * p][1]); pw.y = cvtpk_s(as[2 * p][2], as[2 * p][3]); pw.z = cvtpk_s(as[2 * p + 1][0], as[2 * p + 1][1]); pw.w = cvtpk_s(as[2 * p + 1][2], as[2 * p + 1][3]);
#pragma unroll
        for (int vh = 0; vh < 2; ++vh) { const u32x4 vw = {va[vh][p].x, va[vh][p].y, vb2[vh][p].x, vb2[vh][p].y};
            o[vh] = MFMA16(__builtin_bit_cast(bf16x8, pw), __builtin_bit_cast(bf16x8, vw), o[vh]); }
    }
    if ((VAR & 1) == 0 || o[0][0] == 12345.678f) {
#pragma unroll
    for (int vh = 0; vh < 2; ++vh)
#pragma unroll
        for (int j = 0; j < 4; ++j) *(bf16r*)(ob + (size_t)j * DM * 2 + vh * 32 + ol) = (bf16r)(cvtpk_s(o[vh][j], 0.f) & 0xffffu);
    }
#pragma unroll
    for (int ds = 0; ds < 2; ++ds)
#pragma unroll
        for (int vh = 0; vh < 2; ++vh)
            *(LAS u32x2*)(lds + OFF_ST + (SET ^ 1) * ST_BYTES + (16 * vh + l16) * QS + (32 * ti + 16 * ds + 4 * kq) * 2) = (u32x2){cvtpk_s(st[ds][vh][0], st[ds][vh][1]), cvtpk_s(st[ds][vh][2], st[ds][vh][3])};
}
template <int SET> __device__ __forceinline__ void hgV(LAS unsigned char* lds, const u32x4& v, int mt) {
    LAS bf16r* vt = (LAS bf16r*)(lds + SET * SET_BYTES + OFF_VT + (mt & 3) * 8 * TS + (mt >> 2) * 2);
    vt[0] = (bf16r)(v.x & 0xffffu); vt[TS / 2] = (bf16r)(v.x >> 16); vt[2 * (TS / 2)] = (bf16r)(v.y & 0xffffu); vt[3 * (TS / 2)] = (bf16r)(v.y >> 16);
    vt[4 * (TS / 2)] = (bf16r)(v.z & 0xffffu); vt[5 * (TS / 2)] = (bf16r)(v.z >> 16); vt[6 * (TS / 2)] = (bf16r)(v.w & 0xffffu); vt[7 * (TS / 2)] = (bf16r)(v.w >> 16);
}
template <int VAR = 0> __device__ __forceinline__ void hgrn_item(LAS unsigned char* lds, const bf16r* SQ, const bf16r* G, const bf16r* V, bf16r* O, int item, int tid_in) {
    const int tid = tid_in, lane = tid & 63, w = __builtin_amdgcn_readfirstlane(tid >> 6);
    const int bh = item >> 2, vs = item & 3, b = bh >> 4, h = bh & 15;
    const size_t rowbase = (size_t)b * SEQ;
    constexpr int NC = SEQ / 64;
    if (w < 4) {
        const int cp = lane & 15, rg = lane >> 4;
        const bf16r* gp = G + (rowbase + 16 * rg) * DM + h * 128 + 32 * w + 2 * cp;
        const bf16r* qp = SQ + (rowbase + 16 * rg) * DM + h * 128 + 32 * w + 2 * cp;
        unsigned gvA[16], gvB[16]; unsigned qvA[16], qvB[16];
#define HG_LOADE(GV, QV, c_) do { const size_t adv_ = (size_t)(c_) * 64 * DM; _Pragma("unroll") for (int j = 0; j < 16; ++j) { GV[j] = *(const unsigned*)(gp + adv_ + (size_t)j * DM); QV[j] = *(const unsigned*)(qp + adv_ + (size_t)j * DM); } } while (0)
        HG_LOADE(gvA, qvA, 0); HG_LOADE(gvB, qvB, 1);
        hgE<0>(lds, gvA, qvA, w, lane); HG_LOADE(gvA, qvA, 2);
        HBAR();
        for (int c = 0; c < NC; c += 2) {
            if ((VAR & 8) == 0) hgE<1>(lds, gvB, qvB, w, lane); if ((VAR & 2) == 0) HG_LOADE(gvB, qvB, (c + 3 < NC ? c + 3 : NC - 1));
            HBAR();
            if ((VAR & 8) == 0) hgE<0>(lds, gvA, qvA, w, lane); if ((VAR & 2) == 0) HG_LOADE(gvA, qvA, (c + 4 < NC ? c + 4 : NC - 1));
            HBAR();
        }
#undef HG_LOADE
    } else {
        const int ti = w - 4, mt = tid - 256, l16 = lane & 15, kq = lane >> 4;
        const bf16r* vp = V + (rowbase + (mt >> 2)) * DM + h * 128 + vs * 32 + (mt & 3) * 8;
        char* ob = (char*)(O + (rowbase + 16 * ti) * DM + h * 128 + vs * 32);
        const unsigned ol = (4 * kq * DM + l16) * 2;
        for (int i = mt; i < ST_BYTES / 4; i += 256) ((LAS unsigned*)(lds + OFF_ST))[i] = 0u;
        f32x4 st[2][2];
#pragma unroll
        for (int ds = 0; ds < 2; ++ds) { st[ds][0] = (f32x4){0.f, 0.f, 0.f, 0.f}; st[ds][1] = st[ds][0]; }
        u32x4 vA = *(const u32x4*)vp, vB = *(const u32x4*)(vp + (size_t)64 * DM);
        hgV<0>(lds, vA, mt); vA = *(const u32x4*)(vp + (size_t)2 * 64 * DM);
        HBAR();
        for (int c = 0; c < NC; c += 2) {
            if ((VAR & 4) == 0) hgM<0, VAR>(lds, st, ti, lane, ob + (size_t)c * 64 * DM * 2, ol);
            hgV<1>(lds, vB, mt); vB = *(const u32x4*)(vp + (size_t)(c + 3 < NC ? c + 3 : NC - 1) * 64 * DM);
            HBAR();
            if ((VAR & 4) == 0) hgM<1, VAR>(lds, st, ti, lane, ob + (size_t)(c + 1) * 64 * DM * 2, ol);
            hgV<0>(lds, vA, mt); vA = *(const u32x4*)(vp + (size_t)(c + 4 < NC ? c + 4 : NC - 1) * 64 * DM);
            HBAR();
        }
    }
}
}

__global__ void __launch_bounds__(NTHR, 2) fwd_megakernel(Args args) {
    extern __shared__ __attribute__((aligned(16))) unsigned char lds_raw[];
    cg::grid_group grid = cg::this_grid();
    LAS unsigned char* lds = (LAS unsigned char*)lds_raw;
    const int G = gridDim.x, NGW = G * NWAVES, NGT = G * NTHR;
    const int wave_s = __builtin_amdgcn_readfirstlane((int)threadIdx.x >> 6);
    { const int t0_ = fresh_tid(wave_s); if (t0_ < 2) ((volatile LAS unsigned*)(lds + 147008))[t0_] = 0u; }
    __syncthreads();
    const XcdBarrier xbar = xcd_barrier_post((unsigned*)(args.ws + 4096), (volatile LAS unsigned*)(lds + 147008), wave_s);
#define GRID_BAR() xcd_barrier(xbar)
#define PHASE_IDS() const int tid = fresh_tid(wave_s); const int lane = tid & 63, wave = wave_s; \
    const int gw = blockIdx.x * NWAVES + wave, gt = blockIdx.x * NTHR + tid; (void)lane; (void)gw; (void)gt
    unsigned char* ws = args.ws;
    const float* x = args.in[0]; const float* p = args.in[1]; const float* w_in_fox = args.in[2]; const float* b_f = args.in[3];
    const float* g_q = args.in[4]; const float* g_k = args.in[5]; const float* w_out_fox = args.in[6]; const float* w_in_hg = args.in[7];
    const float* lbl = args.in[8]; const float* g_o = args.in[9]; const float* w_out_hg = args.in[10]; const float* pre_norm = args.in[11];
    const float* post_norm = args.in[12]; const float* w_pe = args.in[13]; const float* w_pg = args.in[14];
    float* out = args.out;
    float* negc = (float*)(ws + WS_NEGC); float* logf = (float*)(ws + WS_LOGF); float* ss = (float*)(ws + WS_SS); float* rstd1 = (float*)(ws + WS_RSTD); float* rstdY = rstd1 + M; float* gbuf = (float*)(ws + WS_GBUF);
    bf16r* WFOX = (bf16r*)(ws + WS_WFOX); bf16r* WOF = (bf16r*)(ws + WS_WOF); bf16r* WHG = (bf16r*)(ws + WS_WHG); bf16r* WOH = (bf16r*)(ws + WS_WOH);
    bf16r* WPE = (bf16r*)(ws + WS_WPE); bf16r* WPG = (bf16r*)(ws + WS_WPG); bf16r* PB = (bf16r*)(ws + WS_PB);
    bf16r* bA = (bf16r*)(ws + WS_A); bf16r* bB = (bf16r*)(ws + WS_B); bf16r* bC = (bf16r*)(ws + WS_C); bf16r* bD = (bf16r*)(ws + WS_D); bf16r* bE = (bf16r*)(ws + WS_E); bf16r* bF = (bf16r*)(ws + WS_F);

#define DEFERRED_CONVERT(gw_, ngw_, gt_, ngt_) do { \
        constexpr int I_SQ = 32 * 64, I_HG = 32 * 256, I_PE = 4 * 64, NITEMS = I_SQ + I_HG + I_SQ + 2 * I_PE + 2 * I_SQ; \
        for (int it = (gw_); it < NITEMS; it += (ngw_)) { int r = it; \
            if (r < I_SQ) { transpose_item(w_out_fox, DM, DM, 64, WOF, nullptr, scr, r, lane); continue; } r -= I_SQ; \
            if (r < I_HG) { transpose_item(w_in_hg, 4 * DM, DM, 256, WHG, pre_norm + DM, scr, r, lane); continue; } r -= I_HG; \
            if (r < I_SQ) { transpose_item(w_out_hg, DM, DM, 64, WOH, nullptr, scr, r, lane); continue; } r -= I_SQ; \
            if (r < I_PE) { transpose_item(w_pe, DM, PLE, 64, WPE, nullptr, scr, r, lane); continue; } r -= I_PE; \
            if (r < I_PE) { transpose_item(w_pe + (size_t)PLE * DM, DM, PLE, 64, WPE + (size_t)DM * PLE, nullptr, scr, r, lane); continue; } r -= I_PE; \
            if (r < I_SQ) { transpose_item(w_pg, DM, DM, 64, WPG, nullptr, scr, r, lane); continue; } r -= I_SQ; \
            transpose_item(w_pg + (size_t)DM * DM, DM, DM, 64, WPG + (size_t)DM * DM, nullptr, scr, r, lane); } \
        for (int i = (gt_); i < 2 * M * PLE / 8; i += (ngt_)) { const f32x4 a = *(const f32x4*)(p + (size_t)i * 8), b2 = *(const f32x4*)(p + (size_t)i * 8 + 4); *(u32x4*)(PB + (size_t)i * 8) = pack8(a, b2); } } while (0)

    PH_BEGIN_0
    {
        PHASE_IDS();
        LAS float* scr = (LAS float*)(lds + wave * 8448);
        for (int it = gw; it < 32 * 256; it += NGW) transpose_item(w_in_fox, NFOX, DM, 256, WFOX, nullptr, scr, it, lane);
        if (G != 256) { DEFERRED_CONVERT(gw, NGW, gt, NGT); }
        for (int i = gt; i < 4096 + 240 * 256; i += NGT) {
            if (i < 4096) { const int n = i & 15, kc = i >> 4; float v[8];
#pragma unroll
                for (int j = 0; j < 8; ++j) v[j] = w_in_fox[(size_t)(kc * 8 + j) * NFOX + 8192 + n];
                u32x4 o; o.x = cvtpk_s(v[0], v[1]); o.y = cvtpk_s(v[2], v[3]); o.z = cvtpk_s(v[4], v[5]); o.w = cvtpk_s(v[6], v[7]);
                *(u32x4*)(WFOX + (size_t)(8192 + n) * DM + kc * 8) = o; }
            else { const int r = i - 4096; *(u32x4*)(WFOX + (size_t)(8208 + (r >> 8)) * DM + (r & 255) * 8) = (u32x4){0u, 0u, 0u, 0u}; } }
        if (blockIdx.x == 0 && tid < 256) gbuf[tid] = tid < 128 ? g_q[tid] : g_k[tid - 128];
        for (int row = gw; row < M; row += 2 * NGW) { const int row2 = row + NGW;
            const bool has2 = row2 < M; const float* xr = x + (size_t)row * DM + lane * 4; const float* xr2 = x + (size_t)(has2 ? row2 : row) * DM + lane * 4;
            f32x4 v[8], u[8]; float s = 0.f, s2 = 0.f;
#pragma unroll
            for (int j = 0; j < 8; ++j) { v[j] = *(const f32x4*)(xr + j * 256); u[j] = *(const f32x4*)(xr2 + j * 256); }
#pragma unroll
            for (int j = 0; j < 8; ++j) { s += (v[j][0] * v[j][0] + v[j][1] * v[j][1]) + (v[j][2] * v[j][2] + v[j][3] * v[j][3]); s2 += (u[j][0] * u[j][0] + u[j][1] * u[j][1]) + (u[j][2] * u[j][2] + u[j][3] * u[j][3]); }
            const float r = rsqrtf(wave_sum(s) * (1.f / DM) + EPS), r2 = rsqrtf(wave_sum(s2) * (1.f / DM) + EPS);
#pragma unroll
            for (int j = 0; j < 8; ++j) { const f32x4 g = *(const f32x4*)(pre_norm + j * 256 + lane * 4); const f32x4 o = v[j] * r * g, o2 = u[j] * r2 * g;
                *(u32x2*)(bA + (size_t)row * DM + j * 256 + lane * 4) = (u32x2){cvtpk_s(o[0], o[1]), cvtpk_s(o[2], o[3])};
                if (has2) *(u32x2*)(bA + (size_t)row2 * DM + j * 256 + lane * 4) = (u32x2){cvtpk_s(o2[0], o2[1]), cvtpk_s(o2[2], o2[3])}; } }
    }
    GRID_BAR();
    if (args.ws == nullptr) grid.sync();
    PH_END_0

    PH_BEGIN_1
#if !defined(GMASK) || (GMASK & 1)
    { pg8::Gemm g{bA, WFOX, M, NFOXP, DM}; pg8::StaticOrder S; S.init(M, NFOXP, G, (int)blockIdx.x);
      pg8::EpiFoxIn E{bB, bE, (size_t)(WS_C - WS_B) / 2, logf, b_f, gbuf, (LAS float*)(lds + 131072)};
      pg8::gemm_phase<pg8::EpiFoxIn, pg8::StaticOrder, true, true>(lds, g, S, E, wave_s); }
#endif
    if (G == 256 && blockIdx.x >= 128) {
        PHASE_IDS(); __syncthreads(); LAS float* scr = (LAS float*)(lds + wave * 8448);
        DEFERRED_CONVERT(((int)blockIdx.x - 128) * NWAVES + wave, 128 * NWAVES, ((int)blockIdx.x - 128) * NTHR + tid, 128 * NTHR); }
    GRID_BAR();
    PH_END_1

    {
        PHASE_IDS();
        for (int seq = blockIdx.x; seq < BATCH * NH; seq += G) {
            const float* src = logf + (size_t)seq * SEQ + tid * 16; float v[16];
#pragma unroll
            for (int j = 0; j < 4; ++j) { const f32x4 t = *(const f32x4*)(src + 4 * j); v[4 * j] = t[0]; v[4 * j + 1] = t[1]; v[4 * j + 2] = t[2]; v[4 * j + 3] = t[3]; }
#pragma unroll
            for (int j = 1; j < 16; ++j) v[j] += v[j - 1];
            float incl = v[15];
#pragma unroll
            for (int o = 1; o < 64; o <<= 1) { const float t = __shfl_up(incl, o); if (lane >= o) incl += t; }
            LAS float* wt = (LAS float*)lds;
            __syncthreads();
            if (lane == 63) wt[wave] = incl;
            __syncthreads();
            float pre = incl - v[15];
            for (int ww = 0; ww < wave; ++ww) pre += wt[ww];
            float* dst = negc + (size_t)seq * SEQ + tid * 16;
#pragma unroll
            for (int j = 0; j < 4; ++j) { f32x4 t; t[0] = -(v[4 * j] + pre) * 11.313708498984761f; t[1] = -(v[4 * j + 1] + pre) * 11.313708498984761f; t[2] = -(v[4 * j + 2] + pre) * 11.313708498984761f; t[3] = -(v[4 * j + 3] + pre) * 11.313708498984761f; *(f32x4*)(dst + 4 * j) = t; }
        }
    }
    GRID_BAR();

    PH_BEGIN_2
#ifndef NO_ATT
    {
        using namespace att;
        typedef BlockRef<bf16, bf16> BR;
        constexpr int nqb = SEQ / QB, W = 1 << 20;
        char* ldsg = (char*)lds_raw;
        volatile LAS int* hord = (volatile LAS int*)(lds + 143360);
        float TH, TH2;
        {
            PHASE_IDS();
        float gqm = fmaxf(fabsf(gbuf[lane]), fabsf(gbuf[lane + 64])), gkm = fmaxf(fabsf(gbuf[128 + lane]), fabsf(gbuf[192 + lane]));
#pragma unroll
        for (int o = 1; o < 64; o <<= 1) { gqm = fmaxf(gqm, __shfl_xor(gqm, o)); gkm = fmaxf(gkm, __shfl_xor(gkm, o)); }
        TH = __uint_as_float(__builtin_amdgcn_readfirstlane(__float_as_uint((2.f * 11.313708f * gqm * gkm * 1.02f + 32.f) * 11.313708f)));
        TH2 = __uint_as_float(__builtin_amdgcn_readfirstlane(__float_as_uint((11.313708f * gqm * gkm * 1.02f + 32.f) * 11.313708f)));
        if (tid < 16) { const float mine = b_f[tid]; int rk = 0;
            for (int j = 0; j < 16; ++j) { const float o = b_f[j]; rk += (o > mine || (o == mine && j < tid)) ? 1 : 0; }
            hord[rk] = tid; }
        }
        __syncthreads();
        unsigned* qctr = (unsigned*)ws;
#define FETCH(Lout) do { __syncthreads(); if (fresh_tid(wave_s) == 0) { int q_ = (int)(xbar.x & 7u), got_ = -1; \
            for (int t_ = 0; t_ < 8; ++t_) { const unsigned i_ = atomicAdd(qctr + 64 * q_, 1u); if (i_ < 256u) { got_ = q_ * 256 + (int)i_; break; } q_ = (q_ + 1) & 7; } \
            hord[16] = got_; } __syncthreads(); Lout = __builtin_amdgcn_readfirstlane(hord[16]); } while (0)
#define DECODE(L_) SwaItem{((((L_) & 127) >> 5) * NH) + __builtin_amdgcn_readfirstlane(hord[(((L_) >> 7) & 1) ? 15 - ((L_) >> 8) : ((L_) >> 8)]), nqb - 1 - ((L_) & 31), nqb - 1 - ((L_) & 31)}
#define MKREF(it_, pass_) mk_ref<bf16, bf16>((it_), (pass_), (const bf16*)bB, (const bf16*)bC, (const bf16*)bD, (bf16*)bF, (const bf16*)bE, negc, SEQ)
        int L; FETCH(L);
        if (L >= 0) {
            SwaItem it = DECODE(L);
            BR cur = MKREF(it, 0);
            Seam<bf16> S;
            causal_swa_prime<bf16, bf16>(cur, W, ldsg, S, wave_s);
            for (;;) {
                int Ln; FETCH(Ln);
                const bool last = Ln < 0;
                const SwaItem itn = last ? it : DECODE(Ln);
                const BR nxt = last ? cur : MKREF(itn, 0);
                causal_swa_block<bf16, bf16>(cur, nxt, SEQ, W, ldsg, S, TH, TH2, wave_s);
                if (last) break;
                cur = nxt; it = itn; L = Ln;
            }
        }
    }
#endif
    GRID_BAR();
    PH_END_2

    PH_BEGIN_3
#if !defined(GMASK) || (GMASK & 2)
    { pg8::Gemm g{bF, WOF, M, DM, DM}; pg8::StaticOrder S; S.init(M, DM, G, (int)blockIdx.x);
      pg8::EpiOutSS E{bB, ss};
      pg8::gemm_phase<pg8::EpiOutSS, pg8::StaticOrder, true, true>(lds, g, S, E, wave_s); }
#endif
    __syncthreads();
#if !defined(GMASK) || (GMASK & 4)
    { int kpe = PLE; asm volatile("" : "+s"(kpe)); pg8::Gemm g{PB, WPE, M, DM, kpe}; pg8::StaticOrder S; S.init(M, DM, G, (int)blockIdx.x);
      pg8::EpiPlain E{bC};
      pg8::gemm_phase<pg8::EpiPlain, pg8::StaticOrder, true, true>(lds, g, S, E, wave_s); }
#endif
    GRID_BAR();
    PH_END_3

    PH_BEGIN_4
    { PHASE_IDS();
    for (int row = gw; row < M; row += NGW) { float s = lane < 32 ? ss[(size_t)row * 32 + lane] : 0.f; const float r = rsqrtf(wave_sum(s) * (1.f / DM) + EPS);
#pragma unroll
        for (int j = 0; j < 8; ++j) { const size_t idx = (size_t)row * DM + j * 256 + lane * 4; const f32x4 xr = *(const f32x4*)(x + idx); const u32x2 yv = *(const u32x2*)(bB + idx);
            const f32x4 g = *(const f32x4*)(post_norm + j * 256 + lane * 4); const f32x4 y = {bf_lo(yv.x), bf_hi(yv.x), bf_lo(yv.y), bf_hi(yv.y)};
            const f32x4 hv = xr + y * r * g; *(u32x2*)(bA + idx) = (u32x2){cvtpk_s(hv[0], hv[1]), cvtpk_s(hv[2], hv[3])}; }
        if (lane == 0) rstdY[row] = r; } }
    GRID_BAR();
    PH_END_4

#if !defined(GMASK) || (GMASK & 8)
    { pg8::Gemm g{bA, WPG, M, DM, DM}; pg8::StaticOrder S; S.init(M, DM, G, (int)blockIdx.x);
      pg8::EpiPG E{x, out, bB, rstdY, post_norm, bC, bF, ss};
      pg8::gemm_phase<pg8::EpiPG, pg8::StaticOrder, true, true>(lds, g, S, E, wave_s); }
#endif
    GRID_BAR();
    { PHASE_IDS();
    for (int row = gt; row < M; row += NGT) { float s = 0.f;
#pragma unroll
        for (int j = 0; j < 8; ++j) { const f32x4 t = *(const f32x4*)(ss + (size_t)row * 32 + 4 * j); s += (t[0] + t[1]) + (t[2] + t[3]); }
        rstd1[row] = rsqrtf(s * (1.f / DM) + EPS); } }
    GRID_BAR();

    PH_BEGIN_5
#if !defined(GMASK) || (GMASK & 16)
    { pg8::Gemm g{bF, WHG, M, 4 * DM, DM}; pg8::StaticOrder S; S.init(M, 4 * DM, G, (int)blockIdx.x);
      pg8::EpiHgIn E{bA, (size_t)(WS_B - WS_A) / 2, bB, rstd1, lbl};
      pg8::gemm_phase<pg8::EpiHgIn, pg8::StaticOrder, true, true>(lds, g, S, E, wave_s); }
#endif
    GRID_BAR();
    PH_END_5

    PH_BEGIN_6
#ifndef NO_HG
    { PHASE_IDS();
    for (int i = blockIdx.x; i < BATCH * NH * 4; i += G) {
        const int item = ((G & 31) == 0) ? (((i & 7) * (BATCH * NH / 8) + (i >> 5)) * 4 + ((i >> 3) & 3)) : i;
        hg::hgrn_item<0>(lds, bA, bB, bD, bF, item, tid); } }
#endif
    GRID_BAR();
    PH_END_6

#ifdef HGPROBE
    { PHASE_IDS();
    for (int i = blockIdx.x; i < BATCH * NH * 4; i += G) {
        const int item = ((G & 31) == 0) ? (((i & 7) * (BATCH * NH / 8) + (i >> 5)) * 4 + ((i >> 3) & 3)) : i;
        hg::hgrn_item<HGPROBE>(lds, bA, bB, bD, bF, item, tid); } }
    GRID_BAR();
#endif
    { PHASE_IDS();
    for (int it = gw; it < M * NH / 4; it += NGW) { const size_t off = ((size_t)it * 4 + (lane >> 4)) * 128 + (lane & 15) * 8;
        const u32x4 wv = *(const u32x4*)(bF + off), zv = *(const u32x4*)(bE + off);
        f32x4 a = {bf_lo(wv.x), bf_hi(wv.x), bf_lo(wv.y), bf_hi(wv.y)}, b2 = {bf_lo(wv.z), bf_hi(wv.z), bf_lo(wv.w), bf_hi(wv.w)};
        float s = (a[0] * a[0] + a[1] * a[1]) + (a[2] * a[2] + a[3] * a[3]) + (b2[0] * b2[0] + b2[1] * b2[1]) + (b2[2] * b2[2] + b2[3] * b2[3]);
        s += __shfl_xor(s, 1); s += __shfl_xor(s, 2); s += __shfl_xor(s, 4); s += __shfl_xor(s, 8);
        const float r = rsqrtf(s * (1.f / 128.f) + EPS); const float* gg = g_o + (lane & 15) * 8;
        const f32x4 z0 = {bf_lo(zv.x), bf_hi(zv.x), bf_lo(zv.y), bf_hi(zv.y)}, z1 = {bf_lo(zv.z), bf_hi(zv.z), bf_lo(zv.w), bf_hi(zv.w)};
        a = a * r * *(const f32x4*)gg * z0; b2 = b2 * r * *(const f32x4*)(gg + 4) * z1;
        *(u32x4*)(bF + off) = pack8(a, b2); } }
    GRID_BAR();

    PH_BEGIN_7
#if !defined(GMASK) || (GMASK & 32)
    { pg8::Gemm g{bF, WOH, M, DM, DM}; pg8::StaticOrder S; S.init(M, DM, G, (int)blockIdx.x);
      pg8::EpiOutSS E{bD, ss};
      pg8::gemm_phase<pg8::EpiOutSS, pg8::StaticOrder, true, true>(lds, g, S, E, wave_s); }
#endif
    __syncthreads();
#if !defined(GMASK) || (GMASK & 64)
    { int kpe = PLE; asm volatile("" : "+s"(kpe)); pg8::Gemm g{PB + (size_t)M * PLE, WPE + (size_t)DM * PLE, M, DM, kpe}; pg8::StaticOrder S; S.init(M, DM, G, (int)blockIdx.x);
      pg8::EpiPlain E{bE};
      pg8::gemm_phase<pg8::EpiPlain, pg8::StaticOrder, true, true>(lds, g, S, E, wave_s); }
#endif
    GRID_BAR();
    PH_END_7

    { PHASE_IDS();
    for (int row = gw; row < M; row += NGW) { float s = lane < 32 ? ss[(size_t)row * 32 + lane] : 0.f; const float r = rsqrtf(wave_sum(s) * (1.f / DM) + EPS);
#pragma unroll
        for (int j = 0; j < 8; ++j) { const size_t idx = (size_t)row * DM + j * 256 + lane * 4; const f32x4 xr = *(const f32x4*)(out + idx); const u32x2 yv = *(const u32x2*)(bD + idx);
            const f32x4 g = *(const f32x4*)(post_norm + DM + j * 256 + lane * 4); const f32x4 y = {bf_lo(yv.x), bf_hi(yv.x), bf_lo(yv.y), bf_hi(yv.y)};
            const f32x4 hv = xr + y * r * g; *(u32x2*)(bA + idx) = (u32x2){cvtpk_s(hv[0], hv[1]), cvtpk_s(hv[2], hv[3])}; }
        if (lane == 0) rstdY[row] = r; } }
    GRID_BAR();

#if !defined(GMASK) || (GMASK & 128)
    { pg8::Gemm g{bA, WPG + (size_t)DM * DM, M, DM, DM}; pg8::StaticOrder S; S.init(M, DM, G, (int)blockIdx.x);
      pg8::EpiPG E{out, out, bD, rstdY, post_norm + DM, bE, nullptr, nullptr};
      pg8::gemm_phase<pg8::EpiPG, pg8::StaticOrder, true, true>(lds, g, S, E, wave_s); }
#endif
}

extern "C" void kernel_launch(void* const* d_in, const int* in_sizes, int n_in, void* d_out, int out_size, void* d_ws, size_t ws_size, hipStream_t stream) {
    static int grid = 0;
    if (grid == 0) {
        if (n_in != 15 || out_size != M * DM || ws_size < WS_END) { fprintf(stderr, "kernel_launch: unexpected shapes (n_in %d out %d ws %zu)\n", n_in, out_size, ws_size); grid = -1; return; }
        int dev = 0, cus = 0, per_cu = 0;
        (void)hipGetDevice(&dev); (void)hipDeviceGetAttribute(&cus, hipDeviceAttributeMultiprocessorCount, dev);
        if (hipFuncSetAttribute((const void*)fwd_megakernel, hipFuncAttributeMaxDynamicSharedMemorySize, LDS_BYTES) != hipSuccess) fprintf(stderr, "kernel_launch: hipFuncSetAttribute failed\n");
        if (hipOccupancyMaxActiveBlocksPerMultiprocessor(&per_cu, (const void*)fwd_megakernel, NTHR, LDS_BYTES) != hipSuccess || per_cu < 1) { fprintf(stderr, "kernel_launch: occupancy query says %d\n", per_cu); per_cu = 1; }
        (void)hipGetLastError();
        if (cus <= 0) cus = 256;
        grid = cus * 1;
    }
    if (grid < 0) return;
    if (hipMemsetAsync(d_ws, 0, 65536, stream) != hipSuccess) { fprintf(stderr, "kernel_launch: hipMemsetAsync failed\n"); return; }
    Args a{};
    for (int i = 0; i < 15; ++i) a.in[i] = (const float*)d_in[i];
    a.out = (float*)d_out; a.ws = (unsigned char*)d_ws;
    void* kargs[] = {&a};
    hipError_t e = hipLaunchCooperativeKernel((const void*)fwd_megakernel, dim3(grid), dim3(NTHR), kargs, LDS_BYTES, stream);
    if (e != hipSuccess) fprintf(stderr, "cooperative launch failed: %s (grid %d)\n", hipGetErrorString(e), grid);
}
```

```cpp
#include <hip/hip_runtime.h>
#include <hip/hip_bf16.h>
#include <hip/hip_cooperative_groups.h>
#include <cstdio>
#include <cstdint>
namespace cg = cooperative_groups;

typedef __bf16 bf16x2_t __attribute__((ext_vector_type(2)));
typedef float f32x2_t __attribute__((ext_vector_type(2)));
__device__ __forceinline__ unsigned cvtpk_s(float lo, float hi) { f32x2_t v = {lo, hi}; bf16x2_t b = __builtin_convertvector(v, bf16x2_t); return __builtin_bit_cast(unsigned, b); }
__device__ __forceinline__ float bf_lo(unsigned w) { return __uint_as_float(w << 16); }
__device__ __forceinline__ float bf_hi(unsigned w) { return __uint_as_float(w & 0xffff0000u); }
__device__ __forceinline__ float sigmoidf_(float x) { return __builtin_amdgcn_rcpf(1.0f + __expf(-x)); }
__device__ __forceinline__ float siluf_(float x) { return x * __builtin_amdgcn_rcpf(1.0f + __expf(-x)); }

__device__ __forceinline__ int fresh_tid(int wave_s) { int l; asm volatile("v_mbcnt_lo_u32_b32 %0, -1, 0\n\tv_mbcnt_hi_u32_b32 %0, -1, %0" : "=v"(l)); return wave_s * 64 + l; }

namespace pg8 {
#define PG8_LAS __attribute__((address_space(3)))
typedef unsigned short bf16_t;
typedef short bf16x8 __attribute__((ext_vector_type(8)));
typedef float f32x4 __attribute__((ext_vector_type(4)));
typedef unsigned u32x4 __attribute__((ext_vector_type(4)));
constexpr int BM = 256, BK = 64, HALF = 128, HTB = HALF * BK * 2  , STAGE_BYTES = 8 * HTB, NXCD = 8, WGM = 8;

__host__ __device__ __forceinline__ int lds_byte(int r, int c) { const int st = (r >> 4) * 2 + (c >> 5), rr = r & 15, cc = c & 31, ob = rr * 64 + cc * 2; return st * 1024 + (ob ^ (((ob >> 9) & 1) << 5)); }
__host__ __device__ __forceinline__ void stage_rc(int b, int& R, int& C) { const int st = b / 1024, sb = b % 1024, swz = sb ^ (((sb >> 9) & 1) << 5); R = (st >> 1) * 16 + swz / 64; C = (st & 1) * 32 + (swz % 64) / 2; }
__host__ __device__ __forceinline__ int perm32(int rho) { const int n = rho >> 4, i = rho & 15; return 8 * (i >> 2) + 4 * n + (i & 3); }

struct Unit { int pm, pn; };
struct Gemm { const bf16_t* A; const bf16_t* Bt; int M, N, K; };

struct StaticOrder {
    int nM, nN, nwg, G, c;
    __host__ __device__ void init(int M, int N, int G_, int c_) { nM = M / BM; nN = N / BM; nwg = nM * nN; G = G_; c = c_; }
    __host__ __device__ bool next(int i, Unit& u) const {
        const long L = (long)i * G + c; if (L >= nwg) return false;
        int wgid = (int)L; { const int q = nwg / NXCD, r = nwg % NXCD, xcd = wgid % NXCD, off = wgid / NXCD; wgid = (xcd < r ? xcd * (q + 1) : r * (q + 1) + (xcd - r) * q) + off; }
        const int nig = WGM * nN, gid = wgid / nig, fm = gid * WGM, gsz = (nM - fm) < WGM ? (nM - fm) : WGM;
        u.pm = fm + ((wgid % nig) % gsz); u.pn = (wgid % nig) / gsz; return true;
    }
    __device__ __forceinline__ void a_ready(const Unit&) const {}
    __device__ __forceinline__ void done(const Unit&) const {}
};


__device__ __forceinline__ u32x4 pack8bf(const f32x4 a, const f32x4 b) { u32x4 w; w.x = cvtpk_s(a[0], a[1]); w.y = cvtpk_s(a[2], a[3]); w.z = cvtpk_s(b[0], b[1]); w.w = cvtpk_s(b[2], b[3]); return w; }
__device__ __forceinline__ f32x4 silu4(const f32x4 v) { return (f32x4){siluf_(v[0]), siluf_(v[1]), siluf_(v[2]), siluf_(v[3])}; }
__device__ __forceinline__ float logsigmoidf_(float x) { return fminf(x, 0.f) - __logf(1.0f + __expf(-fabsf(x))); }

struct EpiFoxIn {
    static constexpr bool PERM = true, AFTER_DRAIN = false;
    bf16_t *Q, *SZ; size_t qkv_stride; float* logf; const float* b_f; const float* gains; PG8_LAS float* xs;
    __device__ __forceinline__ void operator()(const f32x4 (&acc)[2][2][4][2], const Unit& u, int wr, int wc, int fr, int fq) const {
        const int sec = u.pn >> 3, row0 = u.pm * BM + wr * 64 + fr;
        if (sec < 2) {
            bf16_t* base = Q + (size_t)sec * qkv_stride;
#pragma unroll
            for (int ai = 0; ai < 2; ++ai)
#pragma unroll
                for (int m = 0; m < 4; ++m)
#pragma unroll
                    for (int bj = 0; bj < 2; ++bj) { const f32x4 a = acc[ai][bj][m][0], b = acc[ai][bj][m][1];
                        float s = (a[0] * a[0] + a[1] * a[1]) + (a[2] * a[2] + a[3] * a[3]) + (b[0] * b[0] + b[1] * b[1]) + (b[2] * b[2] + b[3] * b[3]);
                        s += __shfl_xor(s, 16); s += __shfl_xor(s, 32);
                        if (fq == 0) xs[(ai * HALF + wr * 64 + m * 16 + fr) * 8 + bj * 4 + wc] = s; }
            asm volatile("s_waitcnt lgkmcnt(0)" ::: "memory"); __builtin_amdgcn_s_barrier(); asm volatile("" ::: "memory");
            int go_ = wc * 32 + 8 * fq; asm volatile("" : "+v"(go_));
            const float* gp = gains + sec * 128 + go_; const f32x4 g0 = *(const f32x4*)gp, g1 = *(const f32x4*)(gp + 4);
#pragma unroll
            for (int ai = 0; ai < 2; ++ai)
#pragma unroll
                for (int m = 0; m < 4; ++m) { const int row = row0 + ai * HALF + m * 16, b = row >> 13, s = row & 8191;
#pragma unroll
                    for (int bj = 0; bj < 2; ++bj) { const int h = (u.pn & 7) * 2 + bj;
                        const f32x4 pp = *(const PG8_LAS f32x4*)(xs + (ai * HALF + wr * 64 + m * 16 + fr) * 8 + bj * 4);
                        const float r = rsqrtf(((pp[0] + pp[1]) + (pp[2] + pp[3])) * (1.f / 128.f) + 1e-6f);
                        *(u32x4*)(base + ((size_t)(b * 16 + h) * 8192 + s) * 128 + wc * 32 + 8 * fq) = pack8bf(acc[ai][bj][m][0] * r * g0, acc[ai][bj][m][1] * r * g1); }
                    asm volatile("" ::: "memory"); }
        } else if (sec == 2) {
            bf16_t* base = Q + (size_t)sec * qkv_stride;
#pragma unroll
            for (int ai = 0; ai < 2; ++ai)
#pragma unroll
                for (int m = 0; m < 4; ++m) { const int row = row0 + ai * HALF + m * 16, b = row >> 13, s = row & 8191;
#pragma unroll
                    for (int bj = 0; bj < 2; ++bj) { const int h = (u.pn & 7) * 2 + bj;
                        *(u32x4*)(base + ((size_t)(b * 16 + h) * 8192 + s) * 128 + wc * 32 + 8 * fq) = pack8bf(acc[ai][bj][m][0], acc[ai][bj][m][1]); }
                    asm volatile("" ::: "memory"); }
        } else if (sec == 3) {
#pragma unroll
            for (int ai = 0; ai < 2; ++ai)
#pragma unroll
                for (int m = 0; m < 4; ++m) { const int row = row0 + ai * HALF + m * 16;
#pragma unroll
                    for (int bj = 0; bj < 2; ++bj)
                        *(u32x4*)(SZ + (size_t)row * 2048 + (u.pn & 7) * 256 + bj * HALF + wc * 32 + 8 * fq) = pack8bf(silu4(acc[ai][bj][m][0]), silu4(acc[ai][bj][m][1]));
                    asm volatile("" ::: "memory"); }
        } else {
            if (wc == 0 && fq < 2) {
#pragma unroll
                for (int ai = 0; ai < 2; ++ai)
#pragma unroll
                    for (int m = 0; m < 4; ++m) { const int row = row0 + ai * HALF + m * 16, b = row >> 13, s = row & 8191;
#pragma unroll
                        for (int n = 0; n < 2; ++n)
#pragma unroll
                            for (int j = 0; j < 4; ++j) { const int h = 8 * fq + 4 * n + j;
                                logf[(size_t)(b * 16 + h) * 8192 + s] = logsigmoidf_(acc[ai][0][m][n][j] + b_f[h]); }
                        asm volatile("" ::: "memory"); }
            }
        }
    }
};
struct EpiOutSS {
    static constexpr bool PERM = true, AFTER_DRAIN = false;
    bf16_t* Y; float* ss;
    __device__ __forceinline__ void operator()(const f32x4 (&acc)[2][2][4][2], const Unit& u, int wr, int wc, int fr, int fq) const {
        const int row0 = u.pm * BM + wr * 64 + fr, col0 = u.pn * BM + wc * 32 + 8 * fq;
#pragma unroll
        for (int ai = 0; ai < 2; ++ai)
#pragma unroll
            for (int m = 0; m < 4; ++m) { const int row = row0 + ai * HALF + m * 16; float s = 0.f;
#pragma unroll
                for (int bj = 0; bj < 2; ++bj) { const f32x4 a = acc[ai][bj][m][0], b = acc[ai][bj][m][1];
                    s += (a[0] * a[0] + a[1] * a[1]) + (a[2] * a[2] + a[3] * a[3]) + (b[0] * b[0] + b[1] * b[1]) + (b[2] * b[2] + b[3] * b[3]);
                    *(u32x4*)(Y + (size_t)row * 2048 + col0 + bj * HALF) = pack8bf(a, b); }
                s += __shfl_xor(s, 16); s += __shfl_xor(s, 32);
                if (fq == 0) ss[(size_t)row * 32 + u.pn * 4 + wc] = s; asm volatile("" ::: "memory"); }
    }
};
struct EpiPlain {
    static constexpr bool PERM = true, AFTER_DRAIN = false;
    bf16_t* Y;
    __device__ __forceinline__ void operator()(const f32x4 (&acc)[2][2][4][2], const Unit& u, int wr, int wc, int fr, int fq) const {
        const int row0 = u.pm * BM + wr * 64 + fr, col0 = u.pn * BM + wc * 32 + 8 * fq;
#pragma unroll
        for (int ai = 0; ai < 2; ++ai)
#pragma unroll
            for (int m = 0; m < 4; ++m) { const int row = row0 + ai * HALF + m * 16;
#pragma unroll
                for (int bj = 0; bj < 2; ++bj) *(u32x4*)(Y + (size_t)row * 2048 + col0 + bj * HALF) = pack8bf(acc[ai][bj][m][0], acc[ai][bj][m][1]); }
    }
};
struct EpiPG {
    static constexpr bool PERM = true, AFTER_DRAIN = false;
    const float* R; float* H; const bf16_t* Y; const float* rstdY; const float* gpost; const bf16_t* PE; bf16_t* HB; float* ss;
    __device__ __forceinline__ void operator()(const f32x4 (&acc)[2][2][4][2], const Unit& u, int wr, int wc, int fr, int fq) const {
        const int row0 = u.pm * BM + wr * 64 + fr, col0 = u.pn * BM + wc * 32 + 8 * fq;
        float rs[2][4]; f32x4 g[2][2];
#pragma unroll
        for (int ai = 0; ai < 2; ++ai)
#pragma unroll
            for (int m = 0; m < 4; ++m) rs[ai][m] = rstdY[row0 + ai * HALF + m * 16];
#pragma unroll
        for (int bj = 0; bj < 2; ++bj) { g[bj][0] = *(const f32x4*)(gpost + col0 + bj * HALF); g[bj][1] = *(const f32x4*)(gpost + col0 + bj * HALF + 4); }
#pragma unroll
        for (int ai = 0; ai < 2; ++ai)
#pragma unroll
            for (int m = 0; m < 4; ++m) { const int row = row0 + ai * HALF + m * 16; const float r = rs[ai][m]; float s = 0.f;
#pragma unroll
                for (int bj = 0; bj < 2; ++bj) { const size_t idx = (size_t)row * 2048 + col0 + bj * HALF;
                    const f32x4 r0 = *(const f32x4*)(R + idx), r1 = *(const f32x4*)(R + idx + 4); const u32x4 yv = *(const u32x4*)(Y + idx), pe = *(const u32x4*)(PE + idx);
                    const f32x4 y0 = {bf_lo(yv.x), bf_hi(yv.x), bf_lo(yv.y), bf_hi(yv.y)}, y1 = {bf_lo(yv.z), bf_hi(yv.z), bf_lo(yv.w), bf_hi(yv.w)};
                    const f32x4 h0 = r0 + y0 * r * g[bj][0], h1 = r1 + y1 * r * g[bj][1];
                    const f32x4 a = acc[ai][bj][m][0], b = acc[ai][bj][m][1];
                    f32x4 o0, o1;
                    o0[0] = h0[0] + bf_lo(pe.x) * sigmoidf_(a[0]); o0[1] = h0[1] + bf_hi(pe.x) * sigmoidf_(a[1]); o0[2] = h0[2] + bf_lo(pe.y) * sigmoidf_(a[2]); o0[3] = h0[3] + bf_hi(pe.y) * sigmoidf_(a[3]);
                    o1[0] = h1[0] + bf_lo(pe.z) * sigmoidf_(b[0]); o1[1] = h1[1] + bf_hi(pe.z) * sigmoidf_(b[1]); o1[2] = h1[2] + bf_lo(pe.w) * sigmoidf_(b[2]); o1[3] = h1[3] + bf_hi(pe.w) * sigmoidf_(b[3]);
                    *(f32x4*)(H + idx) = o0; *(f32x4*)(H + idx + 4) = o1;
                    if (HB) { *(u32x4*)(HB + idx) = pack8bf(o0, o1);
                        s += (o0[0] * o0[0] + o0[1] * o0[1]) + (o0[2] * o0[2] + o0[3] * o0[3]) + (o1[0] * o1[0] + o1[1] * o1[1]) + (o1[2] * o1[2] + o1[3] * o1[3]); } }
                if (HB) { s += __shfl_xor(s, 16); s += __shfl_xor(s, 32); if (fq == 0) ss[(size_t)row * 32 + u.pn * 4 + wc] = s; }
                asm volatile("" ::: "memory"); }
    }
};
struct EpiHgIn {
    static constexpr bool PERM = true, AFTER_DRAIN = false;
    bf16_t *SQ; size_t buf_stride; float* G; const float* rstd; const float* lbl;
    __device__ __forceinline__ void operator()(const f32x4 (&acc)[2][2][4][2], const Unit& u, int wr, int wc, int fr, int fq) const {
        const int sec = u.pn >> 3, row0 = u.pm * BM + wr * 64 + fr, col0 = (u.pn & 7) * BM + wc * 32 + 8 * fq;
        float rs[2][4];
#pragma unroll
        for (int ai = 0; ai < 2; ++ai)
#pragma unroll
            for (int m = 0; m < 4; ++m) rs[ai][m] = rstd[row0 + ai * HALF + m * 16];
        if (sec == 1) {
            float lb[2][8];
#pragma unroll
            for (int bj = 0; bj < 2; ++bj)
#pragma unroll
                for (int j = 0; j < 8; ++j) { const int c = col0 + bj * HALF + j; lb[bj][j] = 1.0f / (1.0f + __expf(lbl[c] - lbl[2048 + c])); }
#pragma unroll
            for (int ai = 0; ai < 2; ++ai)
#pragma unroll
                for (int m = 0; m < 4; ++m) { const int row = row0 + ai * HALF + m * 16; const float r = rs[ai][m];
#pragma unroll
                    for (int bj = 0; bj < 2; ++bj) { f32x4 o0, o1;
#pragma unroll
                        for (int j = 0; j < 4; ++j) { o0[j] = lb[bj][j] + (1.f - lb[bj][j]) * sigmoidf_(acc[ai][bj][m][0][j] * r); o1[j] = lb[bj][4 + j] + (1.f - lb[bj][4 + j]) * sigmoidf_(acc[ai][bj][m][1][j] * r); }
                        float* gp = G + (size_t)row * 2048 + col0 + bj * HALF; *(f32x4*)gp = o0; *(f32x4*)(gp + 4) = o1; }
                    asm volatile("" ::: "memory"); }
        } else {
            bf16_t* base = SQ + (size_t)(sec ? sec + 1 : 0) * buf_stride;
#pragma unroll
            for (int ai = 0; ai < 2; ++ai)
#pragma unroll
                for (int m = 0; m < 4; ++m) { const int row = row0 + ai * HALF + m * 16; const float r = rs[ai][m];
#pragma unroll
                    for (int bj = 0; bj < 2; ++bj) { f32x4 a = acc[ai][bj][m][0] * r, b = acc[ai][bj][m][1] * r;
                        if (sec != 2) { a = silu4(a); b = silu4(b); }
                        *(u32x4*)(base + (size_t)row * 2048 + col0 + bj * HALF) = pack8bf(a, b); }
                    asm volatile("" ::: "memory"); }
        }
    }
};

template <class Epi, class Sched, bool ALIGN_EPI = false, bool SP2 = false>
__device__ __forceinline__ void gemm_phase(PG8_LAS unsigned char* lds, const Gemm g, const Sched& S, const Epi& E, int wave_s) {
    const int tid = fresh_tid(wave_s), wid = __builtin_amdgcn_readfirstlane(tid >> 6), lane = tid & 63, wr = wid >> 2, wc = wid & 3, fr = lane & 15, fq = lane >> 4;
    const int K = g.K, nt = K / BK;
    unsigned voffA[2], voffB[2];
#pragma unroll
    for (int i = 0; i < 2; ++i) { int R, C; stage_rc(tid * 16 + i * 8192, R, C); const int Rb = Epi::PERM ? ((R & ~31) + perm32(R & 31)) : R;
        voffA[i] = (unsigned)(R * K + C) * 2u; voffB[i] = (unsigned)(Rb * K + C) * 2u; }
    const size_t kstep = (size_t)(BK * 2);
    const size_t hstep = (size_t)HALF * K * 2;
    const size_t tstep = 2 * hstep;
    const unsigned ldsw = (unsigned)wid * 1024u;
    const int aoff = lds_byte(wr * 64 + fr, fq * 8), boff = lds_byte(wc * 32 + fr, fq * 8);
#define PG8_SA(b, h) (((b) * 2 + (h)) * HTB)
#define PG8_SB(b, h) ((4 + (b) * 2 + (h)) * HTB)
#define PG8_STAGE(bufoff, gbase, voff) do { _Pragma("unroll") for (int _i = 0; _i < 2; ++_i) \
        __builtin_amdgcn_global_load_lds((const unsigned*)((const char*)(gbase) + (voff)[_i]), (PG8_LAS unsigned*)(lds + (bufoff) + ldsw + _i * 8192), 16, 0, 0); } while (0)
#define PG8_LDA(dst, b, h) do { _Pragma("unroll") for (int m = 0; m < 4; ++m) _Pragma("unroll") for (int k = 0; k < 2; ++k) dst[m][k] = *(const PG8_LAS bf16x8*)(lds + PG8_SA(b, h) + aoff + m * 2048 + k * 1024); } while (0)
#define PG8_LDB(dst, b, h) do { _Pragma("unroll") for (int n = 0; n < 2; ++n) _Pragma("unroll") for (int k = 0; k < 2; ++k) dst[n][k] = *(const PG8_LAS bf16x8*)(lds + PG8_SB(b, h) + boff + n * 2048 + k * 1024); } while (0)
#define PG8_MMA(ai, bj, At, Bt) do { __builtin_amdgcn_s_setprio(1); _Pragma("unroll") for (int m = 0; m < 4; ++m) _Pragma("unroll") for (int n = 0; n < 2; ++n) _Pragma("unroll") for (int k = 0; k < 2; ++k) \
        acc[ai][bj][m][n] = __builtin_amdgcn_mfma_f32_16x16x32_bf16(Bt[n][k], At[m][k], acc[ai][bj][m][n], 0, 0, 0); __builtin_amdgcn_s_setprio(0); } while (0)
#define PG8_WAIT_V(n) asm volatile("s_waitcnt vmcnt(" #n ")" ::: "memory")
#define PG8_WAIT_L(n) asm volatile("s_waitcnt lgkmcnt(" #n ")" ::: "memory")
#define PG8_BAR __builtin_amdgcn_s_barrier()
#define PG8_SCHED __builtin_amdgcn_sched_barrier(0)
    Unit cur, nxt; int ui = 0;
    if (!S.next(0, cur)) return;
    f32x4 acc[2][2][4][2];
#pragma unroll
    for (int a = 0; a < 2; ++a)
#pragma unroll
        for (int b = 0; b < 2; ++b)
#pragma unroll
            for (int m = 0; m < 4; ++m)
#pragma unroll
                for (int n = 0; n < 2; ++n) acc[a][b][m][n] = (f32x4){0.f, 0.f, 0.f, 0.f};
    bf16x8 At[4][2], B0[2][2], B1[2][2];
    const char* cA = (const char*)g.A + (size_t)cur.pm * tstep; const char* cB = (const char*)g.Bt + (size_t)cur.pn * tstep;
    S.a_ready(cur);
    if constexpr (SP2) {
        PG8_STAGE(PG8_SB(0, 0), cB, voffB); PG8_STAGE(PG8_SB(0, 1), cB + hstep, voffB); PG8_STAGE(PG8_SA(0, 0), cA, voffA); PG8_STAGE(PG8_SA(0, 1), cA + hstep, voffA);
        if (wr == 1) PG8_BAR;
        PG8_WAIT_V(2); PG8_BAR;
        PG8_STAGE(PG8_SB(1, 0), cB + kstep, voffB); PG8_STAGE(PG8_SA(1, 0), cA + kstep, voffA); PG8_STAGE(PG8_SB(1, 1), cB + hstep + kstep, voffB);
        PG8_WAIT_V(6); PG8_BAR;
    } else {
        PG8_STAGE(PG8_SB(0, 0), cB, voffB); PG8_STAGE(PG8_SA(0, 0), cA, voffA); PG8_STAGE(PG8_SB(0, 1), cB + hstep, voffB); PG8_STAGE(PG8_SA(0, 1), cA + hstep, voffA);
        if (wr == 1) PG8_BAR;
        PG8_WAIT_V(4); PG8_BAR;
        PG8_STAGE(PG8_SB(1, 0), cB + kstep, voffB); PG8_STAGE(PG8_SA(1, 0), cA + kstep, voffA); PG8_STAGE(PG8_SB(1, 1), cB + hstep + kstep, voffB);
        PG8_WAIT_V(6); PG8_BAR;
    }
    for (;;) {
        const bool has_next = S.next(ui + 1, nxt);
        const char* nA = has_next ? (const char*)g.A + (size_t)nxt.pm * tstep : cA; const char* nB = has_next ? (const char*)g.Bt + (size_t)nxt.pn * tstep : cB;
        for (int t = 0; t < nt; t += 2) {
            const bool last = (t == nt - 2);
            const char* a1 = cA + (size_t)(t + 1) * kstep;
            const char* a2 = last ? nA : cA + (size_t)(t + 2) * kstep; const char* b2 = last ? nB : cB + (size_t)(t + 2) * kstep;
            const char* a3 = a2 + kstep; const char* b3 = b2 + kstep;
            if (last && has_next) S.a_ready(nxt);
            if constexpr (SP2) {
            PG8_LDB(B0, 0, 0); PG8_LDB(B1, 0, 1); PG8_SCHED; PG8_LDA(At, 0, 0); PG8_STAGE(PG8_SA(1, 1), a1 + hstep, voffA);
            PG8_WAIT_V(8); PG8_WAIT_L(0); PG8_BAR; PG8_MMA(0, 0, At, B0); PG8_MMA(0, 1, At, B1); PG8_BAR; PG8_SCHED;
            PG8_LDA(At, 0, 1); PG8_STAGE(PG8_SB(0, 0), b2, voffB); PG8_STAGE(PG8_SB(0, 1), b2 + hstep, voffB); PG8_STAGE(PG8_SA(0, 0), a2, voffA);
            PG8_WAIT_V(8); PG8_WAIT_L(0); PG8_BAR; PG8_MMA(1, 0, At, B0); PG8_MMA(1, 1, At, B1); PG8_BAR; PG8_SCHED;
            PG8_LDB(B0, 1, 0); PG8_LDB(B1, 1, 1); PG8_SCHED; PG8_LDA(At, 1, 0); PG8_STAGE(PG8_SA(0, 1), a2 + hstep, voffA);
            PG8_WAIT_V(8); PG8_WAIT_L(0); PG8_BAR; PG8_MMA(0, 0, At, B0); PG8_MMA(0, 1, At, B1); PG8_BAR; PG8_SCHED;
            PG8_LDA(At, 1, 1); PG8_STAGE(PG8_SB(1, 0), b3, voffB); PG8_STAGE(PG8_SB(1, 1), b3 + hstep, voffB); PG8_STAGE(PG8_SA(1, 0), a3, voffA);
            PG8_WAIT_V(8); PG8_WAIT_L(0); PG8_BAR; PG8_MMA(1, 0, At, B0); PG8_MMA(1, 1, At, B1); PG8_BAR; PG8_SCHED;
            } else {
            PG8_LDB(B0, 0, 0); PG8_SCHED; PG8_LDA(At, 0, 0); PG8_STAGE(PG8_SA(1, 1), a1 + hstep, voffA);
            PG8_WAIT_L(8); PG8_BAR; PG8_WAIT_L(0); PG8_MMA(0, 0, At, B0); PG8_BAR; PG8_SCHED;
            PG8_LDB(B1, 0, 1); PG8_STAGE(PG8_SB(0, 0), b2, voffB);
            PG8_BAR; PG8_WAIT_L(0); PG8_MMA(0, 1, At, B1); PG8_BAR;
            PG8_LDA(At, 0, 1); PG8_STAGE(PG8_SA(0, 0), a2, voffA);
            PG8_BAR; PG8_WAIT_L(0); PG8_MMA(1, 0, At, B0); PG8_BAR; PG8_SCHED;
            PG8_STAGE(PG8_SB(0, 1), b2 + hstep, voffB);
            PG8_WAIT_V(6); PG8_BAR; PG8_MMA(1, 1, At, B1); PG8_BAR;
            PG8_LDB(B0, 1, 0); PG8_SCHED; PG8_LDA(At, 1, 0); PG8_STAGE(PG8_SA(0, 1), a2 + hstep, voffA);
            PG8_WAIT_L(8); PG8_BAR; PG8_WAIT_L(0); PG8_MMA(0, 0, At, B0); PG8_BAR; PG8_SCHED;
            PG8_LDB(B1, 1, 1); PG8_STAGE(PG8_SB(1, 0), b3, voffB);
            PG8_BAR; PG8_WAIT_L(0); PG8_MMA(0, 1, At, B1); PG8_BAR;
            PG8_LDA(At, 1, 1); PG8_STAGE(PG8_SA(1, 0), a3, voffA);
            PG8_BAR; PG8_WAIT_L(0); PG8_MMA(1, 0, At, B0); PG8_BAR; PG8_SCHED;
            PG8_STAGE(PG8_SB(1, 1), b3 + hstep, voffB);
            PG8_WAIT_V(6); PG8_BAR; PG8_MMA(1, 1, At, B1); PG8_BAR;
            }
        }
        if constexpr (ALIGN_EPI) { if (wr == 0) PG8_BAR; }
        if constexpr (!Epi::AFTER_DRAIN) { E(acc, cur, wr, wc, fr, fq); S.done(cur); }
        if (!has_next) break;
#pragma unroll
        for (int a = 0; a < 2; ++a)
#pragma unroll
            for (int b = 0; b < 2; ++b)
#pragma unroll
                for (int m = 0; m < 4; ++m)
#pragma unroll
                    for (int n = 0; n < 2; ++n) acc[a][b][m][n] = (f32x4){0.f, 0.f, 0.f, 0.f};
        cur = nxt; cA = nA; cB = nB; ++ui;
        if constexpr (ALIGN_EPI) { if (wr == 1) PG8_BAR; }
    }
    PG8_WAIT_V(0);
    if constexpr (!ALIGN_EPI) { if (wr == 0) PG8_BAR; }
    PG8_BAR;
    if constexpr (Epi::AFTER_DRAIN) { E.fused(acc, cur, wr, wc, fr, fq, lds, wid, lane); S.done(cur); }
#undef PG8_SA
#undef PG8_SB
#undef PG8_STAGE
#undef PG8_LDA
#undef PG8_LDB
#undef PG8_MMA
#undef PG8_WAIT_V
#undef PG8_WAIT_L
#undef PG8_BAR
#undef PG8_SCHED
}
}
namespace att {
enum { ORDER_NATURAL = 0, ORDER_REVERSED = 1, ORDER_PAIRED = 2, ORDER_XCD = 4 };
constexpr int D = 128, OSTR = 2048, BIAS_OFF = 69632;
constexpr float THR = 8.f;
constexpr bool WSKIP = false;
constexpr float SCALE = 0.08838834764831845f;
constexpr int NW = 8, QBLK = 32, KVBLK = 64, QB = NW * QBLK;
constexpr int SHM_V = KVBLK * D * 2, SHM_K = KVBLK * D * 2;
constexpr int LDS_BYTES = 2 * SHM_V + 2 * SHM_K + NW * 64 * 4;

using bf16 = __hip_bfloat16;
typedef short bf16x8 __attribute__((ext_vector_type(8)));
typedef short s16x4 __attribute__((ext_vector_type(4)));
typedef float f32x16 __attribute__((ext_vector_type(16)));
typedef float f32x4 __attribute__((ext_vector_type(4)));
typedef unsigned u32x4 __attribute__((ext_vector_type(4)));
template <class A, class Bt> struct same_t { static constexpr bool v = false; };
template <class A> struct same_t<A, A> { static constexpr bool v = true; };

#define KSWZ(row, colB) ((row) * 256 + ((colB) ^ (((row) & 7) << 4)))
#define SBAR() __builtin_amdgcn_sched_barrier(0)
__device__ __forceinline__ int v_st(int k, int c) { const int kk = (k & ~0xC) | ((k & 4) << 1) | ((k & 8) >> 1); return ((kk >> 3) * 4 + (c >> 5)) * 512 + ((kk & 7) * 32 + (c & 31)) * 2; }
__device__ __forceinline__ int v_rd_base(int lane) { return ((lane & 3) << 3) | (((lane >> 2) & 3) << 6) | (((lane >> 4) & 1) << 5) | (((lane >> 5) & 1) << 8); }
constexpr int v_rd_off(int d0, int ks, int half) { return d0 * 512 + ks * 4096 + half * 2048; }
__device__ __forceinline__ int crow(int r, int hi) { return (r & 3) + 8 * (r >> 2) + 4 * hi; }
__device__ __forceinline__ unsigned cvtpk(float lo, float hi) {
    unsigned r; asm volatile("v_cvt_pk_bf16_f32 %0, %1, %2" : "=v"(r) : "v"(lo), "v"(hi)); return r;
}
__device__ __forceinline__ bf16x8 pack8(f32x4 a, f32x4 b) {
    u32x4 w = {cvtpk(a[0], a[1]), cvtpk(a[2], a[3]), cvtpk(b[0], b[1]), cvtpk(b[2], b[3])};
    return *reinterpret_cast<bf16x8*>(&w);
}
template <class T> __device__ __forceinline__ bf16x8 load8(const T* p) {
    if constexpr (same_t<T, float>::v) { return pack8(*(const f32x4*)p, *(const f32x4*)(p + 4)); }
    else { return *reinterpret_cast<const bf16x8*>(p); }
}
__device__ __forceinline__ void mask_tile(f32x16& p0, f32x16& p1, int dq, unsigned W) {
    const float NEG = -__builtin_inff();
#pragma unroll
    for (int r = 0; r < 16; ++r) {
        const int c = (r & 3) + 8 * (r >> 2);
        if ((unsigned)(dq - c) >= W) p0[r] = NEG;
        if ((unsigned)(dq - c - 32) >= W) p1[r] = NEG;
    }
}
__device__ __forceinline__ void partialSM(f32x16& p0, f32x16& p1, float& m_reg, float& mn, float& alpha) {
    float pmax = p0[0]; for (int r = 1; r < 16; ++r) pmax = fmaxf(pmax, p0[r]); for (int r = 0; r < 16; ++r) pmax = fmaxf(pmax, p1[r]);
    { auto rr = __builtin_amdgcn_permlane32_swap(__float_as_uint(pmax), __float_as_uint(pmax), false, false);
      pmax = fmaxf(__uint_as_float(rr[0]), __uint_as_float(rr[1])); }
    constexpr float C2 = 1.4426950408889634f * SCALE;
    if (__builtin_expect(__all((pmax - m_reg) * SCALE <= THR), 1)) { mn = m_reg; alpha = 1.f; }
    else { mn = fmaxf(m_reg, pmax); alpha = __builtin_amdgcn_exp2f((m_reg - mn) * C2); m_reg = mn; }
    const float mnL = -mn * C2;
    for (int r = 0; r < 16; ++r) p0[r] = fmaf(p0[r], C2, mnL); for (int r = 0; r < 16; ++r) p1[r] = fmaf(p1[r], C2, mnL);
    for (int r = 0; r < 16; ++r) p0[r] = __builtin_amdgcn_exp2f(p0[r]);
}
__device__ __forceinline__ void finishSM(f32x16& p0, f32x16& p1, float alpha, float& l_reg, bf16x8& pa0, bf16x8& pa1, bf16x8& pa2, bf16x8& pa3) {
    for (int r = 0; r < 16; ++r) p1[r] = __builtin_amdgcn_exp2f(p1[r]);
    float ps = 0; for (int r = 0; r < 16; ++r) ps += p0[r]; for (int r = 0; r < 16; ++r) ps += p1[r];
    { auto rr = __builtin_amdgcn_permlane32_swap(__float_as_uint(ps), __float_as_uint(ps), false, false);
      ps = __uint_as_float(rr[0]) + __uint_as_float(rr[1]); }
    l_reg = l_reg * alpha + ps;
#define PK4(P, B_, OUT) do { unsigned a0 = cvtpk(P[B_+0], P[B_+1]), a1 = cvtpk(P[B_+2], P[B_+3]);                          \
        unsigned b0 = cvtpk(P[B_+4], P[B_+5]), b1 = cvtpk(P[B_+6], P[B_+7]);                                             \
        auto r0 = __builtin_amdgcn_permlane32_swap(a0, b0, false, false); auto r1 = __builtin_amdgcn_permlane32_swap(a1, b1, false, false); \
        u32x4 w = {r0[0], r1[0], r0[1], r1[1]}; OUT = *reinterpret_cast<bf16x8*>(&w); } while (0)
    PK4(p0, 0, pa0); PK4(p0, 8, pa1); PK4(p1, 0, pa2); PK4(p1, 8, pa3);
#undef PK4
}
template <int KB, bool SK>
__device__ __forceinline__ void qkt(f32x16& p0, f32x16& p1, const char* K_lds, int r32, int hi, const bf16x8* qr, bool act, const char* bl) {
    if (SK && !act) { const float NEG = -__builtin_inff();
#pragma unroll
        for (int r = 0; r < 16; ++r) { p0[r] = NEG; p1[r] = NEG; } return; }
    { const f32x4 c0 = *(const f32x4*)(bl), c1 = *(const f32x4*)(bl + 32), c2 = *(const f32x4*)(bl + 64), c3 = *(const f32x4*)(bl + 96);
      const f32x4 e0 = *(const f32x4*)(bl + 128), e1 = *(const f32x4*)(bl + 160), e2 = *(const f32x4*)(bl + 192), e3 = *(const f32x4*)(bl + 224);
      p0 = (f32x16){c0[0], c0[1], c0[2], c0[3], c1[0], c1[1], c1[2], c1[3], c2[0], c2[1], c2[2], c2[3], c3[0], c3[1], c3[2], c3[3]};
      p1 = (f32x16){e0[0], e0[1], e0[2], e0[3], e1[0], e1[1], e1[2], e1[3], e2[0], e2[1], e2[2], e2[3], e3[0], e3[1], e3[2], e3[3]}; }
    const char* kb[4];
#pragma unroll
    for (int dd = 0; dd < 4; ++dd) kb[dd] = K_lds + KB * SHM_K + KSWZ(r32, (dd * 16 + hi * 8) * 2);
#pragma unroll
    for (int d0 = 0; d0 < 8; ++d0) { const char* a = kb[d0 & 3] + (d0 >> 2) * 128;
        bf16x8 b0 = *reinterpret_cast<const bf16x8*>(a);
        bf16x8 b1 = *reinterpret_cast<const bf16x8*>(a + 32 * 256);
        p0 = __builtin_amdgcn_mfma_f32_32x32x16_bf16(b0, qr[d0], p0, 0, 0, 0);
        p1 = __builtin_amdgcn_mfma_f32_32x32x16_bf16(b1, qr[d0], p1, 0, 0, 0); }
}
template <int VB, bool SK>
__device__ __forceinline__ void pv_tile(f32x16* o, int vb0, bf16x8 pa0, bf16x8 pa1, bf16x8 pa2, bf16x8 pa3, bool act) {
    if (SK && !act) return;
#define TRRD(dst, off) asm volatile("ds_read_b64_tr_b16 %0, %1 offset:%2" : "=&v"(dst) : "v"(vb0), "i"(off) : "memory")
#define PV_D0(d0) do { s16x4 l0, l1, l2, l3, h0, h1, h2, h3; constexpr int b_ = VB * SHM_V + v_rd_off(d0, 0, 0);     \
        TRRD(l0, b_); TRRD(h0, b_ + 2048); TRRD(l1, b_ + 4096); TRRD(h1, b_ + 6144); TRRD(l2, b_ + 8192); TRRD(h2, b_ + 10240); TRRD(l3, b_ + 12288); TRRD(h3, b_ + 14336); \
        asm volatile("s_waitcnt lgkmcnt(0)" ::: "memory"); SBAR();                 \
        o[d0] = __builtin_amdgcn_mfma_f32_32x32x16_bf16(pa0, (bf16x8){l0[0], l0[1], l0[2], l0[3], h0[0], h0[1], h0[2], h0[3]}, o[d0], 0, 0, 0);   \
        o[d0] = __builtin_amdgcn_mfma_f32_32x32x16_bf16(pa1, (bf16x8){l1[0], l1[1], l1[2], l1[3], h1[0], h1[1], h1[2], h1[3]}, o[d0], 0, 0, 0);   \
        o[d0] = __builtin_amdgcn_mfma_f32_32x32x16_bf16(pa2, (bf16x8){l2[0], l2[1], l2[2], l2[3], h2[0], h2[1], h2[2], h2[3]}, o[d0], 0, 0, 0);   \
        o[d0] = __builtin_amdgcn_mfma_f32_32x32x16_bf16(pa3, (bf16x8){l3[0], l3[1], l3[2], l3[3], h3[0], h3[1], h3[2], h3[3]}, o[d0], 0, 0, 0); } while (0)
    PV_D0(0); PV_D0(1); PV_D0(2); PV_D0(3);
#undef PV_D0
#undef TRRD
}

template <class TIn, class TOut> struct BlockRef { const TIn* Q; const TIn* K; const TIn* V; TOut* O; const TOut* Z; const float* C; int P0; };
template <class TIn> struct Seam {
    bf16x8 qr[8];
    bf16x8 st_v0, st_v1, st_k0, st_k1; f32x4 sf0, sf1, sf2, sf3;
    f32x4 tq[16];
};
__device__ __forceinline__ int swa_jlo(int P0, int W) { const int lowk = P0 - W + 1; return lowk > 0 ? lowk / KVBLK : 0; }
#define ROW(p, k0, rr) ((p) + (size_t)((k0) + (rr)) * D + sc)
#define VMW() asm volatile("s_waitcnt vmcnt(0)" ::: "memory")
#define VMWN(n) asm volatile("s_waitcnt vmcnt(%0)" :: "i"(n) : "memory")
#define SLOAD_H(Kp, Vp, k0) do { S.st_v0 = load8<TIn>(ROW(Vp, k0, sr)); S.st_v1 = load8<TIn>(ROW(Vp, k0, 32 + sr));              \
                         S.st_k0 = load8<TIn>(ROW(Kp, k0, sr)); S.st_k1 = load8<TIn>(ROW(Kp, k0, 32 + sr)); } while (0)
#define SWRITE_HK(bf) do { *(bf16x8*)(K_lds + (bf) * SHM_K + kws) = S.st_k0; *(bf16x8*)(K_lds + (bf) * SHM_K + kws + 32 * 256) = S.st_k1; } while (0)
#define SWRITE_HV(bf) do { *(bf16x8*)(V_lds + (bf) * SHM_V + vst0) = S.st_v0; *(bf16x8*)(V_lds + (bf) * SHM_V + vst1) = S.st_v1; } while (0)
#define SWRITE_H(bf) do { SWRITE_HV(bf); SWRITE_HK(bf); } while (0)
#define SLOAD_F(p, k0) do { S.sf0 = *(const f32x4*)ROW(p, k0, sr); S.sf1 = *(const f32x4*)(ROW(p, k0, sr) + 4);                \
                            S.sf2 = *(const f32x4*)ROW(p, k0, 32 + sr); S.sf3 = *(const f32x4*)(ROW(p, k0, 32 + sr) + 4); } while (0)
#define SWRITE_KF(bf) do { *(bf16x8*)(K_lds + (bf) * SHM_K + kws) = pack8(S.sf0, S.sf1); *(bf16x8*)(K_lds + (bf) * SHM_K + kws + 32 * 256) = pack8(S.sf2, S.sf3); } while (0)
#define SWRITE_VF(bf) do { *(bf16x8*)(V_lds + (bf) * SHM_V + vst0) = pack8(S.sf0, S.sf1); *(bf16x8*)(V_lds + (bf) * SHM_V + vst1) = pack8(S.sf2, S.sf3); } while (0)
template <class TIn, class TOut>
__device__ __forceinline__ void causal_swa_prime(const BlockRef<TIn, TOut>& cur, int W, char* lds, Seam<TIn>& S, int wave_s) {
    constexpr bool F32 = same_t<TIn, float>::v;
    const int tid = fresh_tid(wave_s), wid = __builtin_amdgcn_readfirstlane(tid >> 6), lane = tid & 63, r32 = lane & 31, hi = lane >> 5;
    const int sr = tid >> 4, sc = (tid & 15) * 8, kws = KSWZ(sr, sc * 2); char* K_lds = lds + 2 * SHM_V;
    const int kb0 = cur.P0 + QB - KVBLK;
    for (int d0 = 0; d0 < 8; ++d0) S.qr[d0] = load8<TIn>(cur.Q + (size_t)(wid * QBLK + r32) * D + d0 * 16 + hi * 8);
    if constexpr (F32) { SLOAD_F((const float*)cur.K, kb0); VMW(); SWRITE_KF(0); SBAR(); SLOAD_F((const float*)cur.V, kb0); }
    else { SLOAD_H(cur.K, cur.V, kb0); VMW(); SWRITE_HK(0); }
    __syncthreads();
}
template <class TIn, class TOut>
__device__ __forceinline__ void causal_swa_block(const BlockRef<TIn, TOut>& cur, const BlockRef<TIn, TOut>& nxt, int skv, int W, char* lds, Seam<TIn>& S, float TH, float TH2, int wave_s) {
    constexpr bool F32 = same_t<TIn, float>::v;
    const int tid = fresh_tid(wave_s), wid = __builtin_amdgcn_readfirstlane(tid >> 6), lane = tid & 63, r32 = lane & 31, hi = lane >> 5;
    int j_lo;
    int tq_ = tid; asm volatile("" : "+v"(tq_));
    { const int ntb = cur.P0 / KVBLK; const float ref = cur.C[cur.P0]; const int t0 = tq_ & 63, t1 = (tq_ & 63) + 64;
      const float v0 = t0 < ntb ? cur.C[t0 * KVBLK + KVBLK - 1] : ref, v1 = t1 < ntb ? cur.C[t1 * KVBLK + KVBLK - 1] : ref;
      j_lo = __builtin_amdgcn_readfirstlane((int)(__popcll(__ballot(ref - v0 > TH)) + __popcll(__ballot(ref - v1 > TH)))); }
    int j_hi = (cur.P0 + QB - 1) / KVBLK + 1; if (j_hi > skv / KVBLK) j_hi = skv / KVBLK;
    int NT = j_hi - j_lo;
    const int kbn = nxt.P0 + QB - KVBLK;
    const int qlo = cur.P0 + wid * QBLK, qm = qlo + r32 - 4 * hi;
    char* V_lds = lds; char* K_lds = lds + 2 * SHM_V;
    float* ws = (float*)(lds + 2 * SHM_V + 2 * SHM_K) + wid * 64; float* li_l = ws, * al_l = ws + 32;
    float m_reg = -1e30f, l_reg = 0; f32x16 o[4] = {};
    const int sr = tid >> 4, sc = (tid & 15) * 8, vst0 = v_st(sr, sc), vst1 = v_st(32 + sr, sc), kws = KSWZ(sr, sc * 2);
    const int vb0 = (int)(uintptr_t)V_lds + v_rd_base(lane);
    const TIn* Kh = cur.K; const TIn* Vh = cur.V;
    const char* bias0 = lds + BIAS_OFF + 16 * hi;
    { const int n4 = (cur.P0 + QB) >> 2; f32x4* bdst = (f32x4*)(lds + BIAS_OFF); const f32x4* bsrc = (const f32x4*)cur.C;
      for (int i = j_lo * (KVBLK / 4) + tq_; i < n4; i += 64 * NW) bdst[i] = bsrc[i];
      __syncthreads(); }
#define BIASP(t) (bias0 + KBASE(t) * 4)
#define RESC(a) do { if (__any((a) < 1.f)) { if (hi == 0) al_l[r32] = (a); asm volatile("s_waitcnt lgkmcnt(0)" ::: "memory");              \
                     for (int d_ = 0; d_ < 4; ++d_) for (int r = 0; r < 16; ++r) o[d_][r] *= al_l[crow(r, hi)]; } } while (0)
#define KBASE(t) ((j_hi - 1 - (t)) * KVBLK)
#define ACT(t) (KBASE(t) <= qlo + QBLK - 1 && KBASE(t) + KVBLK - 1 >= qlo - W + 1)
#define MASKT(P0_, P1_, t) do { const int kb_ = KBASE(t); if ((!SK || ACT(t)) && (kb_ + KVBLK - 1 > qlo || kb_ <= qlo + QBLK - 1 - W)) mask_tile(P0_, P1_, qm - kb_, (unsigned)W); } while (0)
    constexpr int NQL = F32 ? 16 : 8;
    constexpr bool SK = WSKIP && !F32;
#define SEAM_K0() do { VMWN(NQL); if constexpr (F32) { SWRITE_KF(0); SBAR(); SLOAD_F((const float*)nxt.V, kbn); } else { SWRITE_HK(0); } SBAR(); } while (0)
    f32x16 pA0, pA1, pB0, pB1; float mnA, mnB, alA, alB; bf16x8 pa0, pa1, pa2, pa3;
    if constexpr (F32) { VMW(); SWRITE_VF(0); SBAR(); } else { SWRITE_HV(0); SBAR(); }
    if (NT > 1) { if constexpr (F32) SLOAD_F((const float*)Kh, KBASE(1)); else SLOAD_H(Kh, Vh, KBASE(1)); }
    SBAR(); qkt<0, SK>(pA0, pA1, K_lds, r32, hi, S.qr, ACT(0), BIASP(0));
    if constexpr (F32) { if (NT > 1) { VMW(); SWRITE_KF(1); SBAR(); SLOAD_F((const float*)Vh, KBASE(1)); } }
    MASKT(pA0, pA1, 0); partialSM(pA0, pA1, m_reg, mnA, alA);
    if (NT > 1) { VMW(); if constexpr (F32) { SWRITE_VF(1); SBAR(); if (NT > 2) SLOAD_F((const float*)Kh, KBASE(2)); } else SWRITE_H(1); }
    __syncthreads();
#define HALF_STEP(PX0, PX1, mnX, alX, PY0, PY1, alY, t, KB, VB, SB) do {                                                      \
        SBAR(); qkt<KB, SK>(PX0, PX1, K_lds, r32, hi, S.qr, ACT(t), BIASP(t));                                             \
        finishSM(PY0, PY1, alY, l_reg, pa0, pa1, pa2, pa3); SBAR();                                                           \
        if ((t) + 1 < NT) { if constexpr (F32) { VMW(); SWRITE_KF(SB); SBAR(); SLOAD_F((const float*)Vh, KBASE((t) + 1)); }  \
                            else { SLOAD_H(Kh, Vh, KBASE((t) + 1)); } SBAR(); }                                               \
        pv_tile<VB, SK>(o, vb0, pa0, pa1, pa2, pa3, ACT((t) - 1)); MASKT(PX0, PX1, (t)); partialSM(PX0, PX1, m_reg, mnX, alX);                                        \
        __syncthreads();                                                                                                      \
        if ((t) + 1 < NT) { VMW(); if constexpr (F32) { SWRITE_VF(SB); SBAR(); if ((t) + 2 < NT) SLOAD_F((const float*)Kh, KBASE((t) + 2)); } \
                            else { SWRITE_H(SB); } }                                                                          \
        RESC(alX); __syncthreads(); } while (0)
    for (int t = 1; t + 1 < NT; t += 2) {
        HALF_STEP(pB0, pB1, mnB, alB, pA0, pA1, alA, t, 1, 0, 0);
        HALF_STEP(pA0, pA1, mnA, alA, pB0, pB1, alB, t + 1, 0, 1, 1);
        if (t == 3) {
            float mm = m_reg;
#pragma unroll
            for (int o_ = 1; o_ < 64; o_ <<= 1) mm = fminf(mm, __shfl_xor(mm, o_));
            float* mmw = (float*)(lds + BIAS_OFF - 1024);
            if (lane == 0) mmw[wid] = mm;
            __syncthreads();
            float bm = fminf(fminf(fminf(mmw[0], mmw[1]), fminf(mmw[2], mmw[3])), fminf(fminf(mmw[4], mmw[5]), fminf(mmw[6], mmw[7]))) - TH2;
            const int ntb = cur.P0 / KVBLK, t0 = j_lo + lane, t1 = j_lo + lane + 64;
            const float b0_ = t0 < ntb ? *(const float*)(lds + BIAS_OFF + (t0 * KVBLK + KVBLK - 1) * 4) : bm, b1_ = t1 < ntb ? *(const float*)(lds + BIAS_OFF + (t1 * KVBLK + KVBLK - 1) * 4) : bm;
            const int skip = __builtin_amdgcn_readfirstlane((int)(__popcll(__ballot(b0_ < bm)) + __popcll(__ballot(b1_ < bm))));
            int nt2 = NT - skip; if (nt2 < 5) nt2 = 5;
            if (nt2 < NT) NT = nt2;
        }
    }
    const bool even = (NT & 1) == 0;
    if (even) { SBAR(); qkt<1, SK>(pB0, pB1, K_lds, r32, hi, S.qr, ACT(NT - 1), BIASP(NT - 1)); SBAR(); }
#define QROW(e) (nxt.Q + (size_t)(wid * QBLK + r32) * D + ((e) >> 1) * 16 + hi * 8 + ((e) & 1) * 4)
    if constexpr (F32) { SLOAD_F((const float*)nxt.K, kbn); SBAR();
#pragma unroll
        for (int e = 0; e < 8; ++e) S.tq[e] = *(const f32x4*)QROW(e); }
    else { SLOAD_H(nxt.K, nxt.V, kbn); SBAR();
#pragma unroll
        for (int d0 = 0; d0 < 8; ++d0) S.qr[d0] = load8<TIn>(nxt.Q + (size_t)(wid * QBLK + r32) * D + d0 * 16 + hi * 8); }
    SBAR();
    finishSM(pA0, pA1, alA, l_reg, pa0, pa1, pa2, pa3); SBAR();
    if constexpr (F32) {
#pragma unroll
        for (int e = 8; e < 16; ++e) S.tq[e] = *(const f32x4*)QROW(e); SBAR(); }
#undef QROW
    pv_tile<0, SK>(o, vb0, pa0, pa1, pa2, pa3, ACT(even ? NT - 2 : NT - 1));
    if (even) { MASKT(pB0, pB1, NT - 1); partialSM(pB0, pB1, m_reg, mnB, alB); __syncthreads(); RESC(alB);
        finishSM(pB0, pB1, alB, l_reg, pa0, pa1, pa2, pa3); SBAR(); pv_tile<1, SK>(o, vb0, pa0, pa1, pa2, pa3, ACT(NT - 1)); }
    SBAR(); SEAM_K0();
    if (hi == 0) li_l[r32] = l_reg; asm volatile("s_waitcnt lgkmcnt(0)" ::: "memory");
    float rli[16];
#pragma unroll
    for (int r = 0; r < 16; ++r) rli[r] = __builtin_amdgcn_rcpf(li_l[crow(r, hi)]);
    int eo = (wid * QBLK + 4 * hi) * OSTR + r32; asm volatile("" : "+v"(eo));
    TOut* Ow = cur.O + eo; const TOut* Zw = cur.Z + eo;
#pragma unroll
    for (int r = 0; r < 16; ++r) { const int orow = ((r & 3) + 8 * (r >> 2)) * OSTR;
#pragma unroll
        for (int d0 = 0; d0 < 4; ++d0) { const float v = o[d0][r] * rli[r] * __bfloat162float(Zw[orow + d0 * 32]);
            if constexpr (same_t<TOut, float>::v) { Ow[orow + d0 * 32] = v; }
            else { const float vn = __shfl_xor(v, 1);
                   if ((r32 & 1) == 0) *(unsigned*)(Ow + orow + d0 * 32) = cvtpk(v, vn); } } }
    if constexpr (F32) {
#pragma unroll
        for (int d0 = 0; d0 < 8; ++d0) S.qr[d0] = pack8(S.tq[2 * d0], S.tq[2 * d0 + 1]); }
    __syncthreads();
#undef RESC
#undef BIASP
#undef KBASE
#undef ACT
#undef MASKT
#undef SEAM_K0
#undef HALF_STEP
}
#undef ROW
#undef VMW
#undef VMWN
#undef SLOAD_H
#undef SWRITE_HK
#undef SWRITE_HV
#undef SWRITE_H
#undef SLOAD_F
#undef SWRITE_KF
#undef SWRITE_VF

__host__ __device__ inline int swa_nramp(int nqb, int W, int qoff) { const int t = W - 1 - qoff; const int n = t < 0 ? 0 : t / QB + 1; return n > nqb ? nqb : n; }
__host__ __device__ inline int swa_nx(int nqb, int nramp, int order) { return (order & ORDER_PAIRED) ? (nramp + 1) / 2 + (nqb - nramp) : nqb; }
struct SwaItem { int bh, qb0, qb1; };
__device__ __forceinline__ SwaItem swa_decode(int L, int nb, int nh, int nhkv, int nqb, int nx, int nramp, int order) {
    const int G = nh / nhkv; SwaItem it; int x;
    if ((order & ORDER_XCD) && (nb * nhkv) % 8 == 0) { const int xcd = L & 7, k = L >> 3, per = G * nx, gi = k / per, r = k - gi * per;
        it.bh = (gi * 8 + xcd) * G + r / nx; x = r % nx; }
    else { it.bh = L / nx; x = L - it.bh * nx; }
    if (order & ORDER_PAIRED) { const int ns = nqb - nramp;
        if (x < ns) { it.qb0 = it.qb1 = nqb - 1 - x; } else { it.qb0 = x - ns; it.qb1 = nramp - 1 - it.qb0; } }
    else { it.qb0 = it.qb1 = ((order & 3) == ORDER_REVERSED) ? nqb - 1 - x : x; }
    return it;
}
template <class TIn, class TOut>
__device__ __forceinline__ BlockRef<TIn, TOut> mk_ref(const SwaItem& it, int pass, const TIn* Qb, const TIn* Kb, const TIn* Vb, TOut* Ob, const TOut* Zb, const float* Cb, int seq) {
    const int qb = pass ? it.qb1 : it.qb0, bb = it.bh >> 4, hh = it.bh & 15; BlockRef<TIn, TOut> r;
    r.Q = Qb + ((size_t)it.bh * seq + (size_t)qb * QB) * D; r.K = Kb + (size_t)it.bh * seq * D; r.V = Vb + (size_t)it.bh * seq * D;
    r.O = Ob + ((size_t)bb * seq + (size_t)qb * QB) * OSTR + hh * D; r.Z = Zb + ((size_t)bb * seq + (size_t)qb * QB) * OSTR + hh * D;
    r.C = Cb + (size_t)it.bh * seq; r.P0 = qb * QB; return r;
}
}

#define LAS __attribute__((address_space(3)))
typedef unsigned short bf16r;
typedef float f32x4 __attribute__((ext_vector_type(4)));
typedef float f32x2 __attribute__((ext_vector_type(2)));
typedef unsigned u32x4 __attribute__((ext_vector_type(4)));
typedef unsigned u32x2 __attribute__((ext_vector_type(2)));
typedef short bf16x8 __attribute__((ext_vector_type(8)));
constexpr int BATCH = 4, SEQ = 8192, DM = 2048, M = BATCH * SEQ, NH = 16, PLE = 256;
constexpr int NFOX = 4 * DM + NH, NFOXP = 8448;
constexpr float EPS = 1e-6f;
constexpr size_t MiB = (size_t)1 << 20;
constexpr size_t WS_GBUF = 65536, WS_NEGC = 1 * MiB, WS_LOGF = 3 * MiB, WS_SS = 5 * MiB, WS_RSTD = 9 * MiB;
constexpr size_t WS_WFOX = 16 * MiB, WS_WOF = 49 * MiB, WS_WHG = 57 * MiB, WS_WOH = 89 * MiB, WS_WPE = 97 * MiB, WS_WPG = 99 * MiB, WS_PB = 116 * MiB;
constexpr size_t WS_A = 148 * MiB, WS_B = 276 * MiB, WS_C = 404 * MiB, WS_D = 532 * MiB, WS_E = 660 * MiB, WS_F = 788 * MiB, WS_END = 916 * MiB;
constexpr int NTHR = 512, NWAVES = 8;
constexpr int LDS_BYTES = 147456;

#define LDS_WAIT() asm volatile("s_waitcnt lgkmcnt(0)" ::: "memory")
#define HBAR() do { asm volatile("s_waitcnt lgkmcnt(0)" ::: "memory"); __builtin_amdgcn_s_barrier(); asm volatile("" ::: "memory"); } while (0)

__device__ __forceinline__ float wave_sum(float v) {
#pragma unroll
    for (int o = 1; o < 64; o <<= 1) v += __shfl_xor(v, o);
    return v;
}
__device__ __forceinline__ u32x4 pack8(const f32x4 a, const f32x4 b) { u32x4 w; w.x = cvtpk_s(a[0], a[1]); w.y = cvtpk_s(a[2], a[3]); w.z = cvtpk_s(b[0], b[1]); w.w = cvtpk_s(b[2], b[3]); return w; }

__device__ __forceinline__ void transpose_item(const float* W, int ldw, int K, int nblk, bf16r* WT, const float* kscale, LAS float* scr, int item, int lane) {
    const int kb = item / nblk, nb = item - kb * nblk, k0 = 64 * kb, n0 = 32 * nb;
#pragma unroll 8
    for (int i = 0; i < 32; ++i) { const int kk = 2 * i + (lane >> 5); float v = W[(size_t)(k0 + kk) * ldw + n0 + (lane & 31)]; if (kscale) v *= kscale[k0 + kk]; scr[kk * 33 + (lane & 31)] = v; }
    LDS_WAIT(); asm volatile("" ::: "memory");
    const int c = lane & 7;
#pragma unroll
    for (int j = 0; j < 4; ++j) { const int n = (lane >> 3) + 8 * j; const LAS float* s = scr + (8 * c) * 33 + n;
        u32x4 o; o.x = cvtpk_s(s[0 * 33], s[1 * 33]); o.y = cvtpk_s(s[2 * 33], s[3 * 33]); o.z = cvtpk_s(s[4 * 33], s[5 * 33]); o.w = cvtpk_s(s[6 * 33], s[7 * 33]);
        *(u32x4*)(WT + (size_t)(n0 + n) * K + k0 + 8 * c) = o; }
    LDS_WAIT(); asm volatile("" ::: "memory");
}

#define XB_TMO      128
#define XB_XCNT(j)  (256  + 64 * (j))
#define XB_XSUB(j)  (1280 + 64 * (j))
#define XB_XGEN(j)  (2304 + 64 * (j))
#define XB_TOP      3328
#define XB_TOPGEN   3392
#define XCD_BAR_WORDS 3456
#define XB_SPIN_CAP (1u << 18)

__device__ __forceinline__ unsigned xb_ld(unsigned* p)              { return __hip_atomic_load(p, __ATOMIC_RELAXED, __HIP_MEMORY_SCOPE_AGENT); }
__device__ __forceinline__ unsigned xb_add(unsigned* p, unsigned v) { return __hip_atomic_fetch_add(p, v, __ATOMIC_RELAXED, __HIP_MEMORY_SCOPE_AGENT); }
__device__ __forceinline__ unsigned xb_xcc_id() { return (unsigned)__builtin_amdgcn_s_getreg((3 << 11) | 20) & 0xFu; }
#define XB_SPIN(cond, bar) do { unsigned _sp = 0; while (cond) { __builtin_amdgcn_s_sleep(1); \
    if ((++_sp & 255u) == 0u) { if (xb_ld(&(bar)[XB_TMO])) break; if (_sp > XB_SPIN_CAP) { atomicAdd(&(bar)[XB_TMO], 1u); break; } } } } while (0)

struct XcdBarrier {
    unsigned* bar; unsigned x; int wv;
    volatile LAS unsigned* st;
};

__device__ __forceinline__ XcdBarrier xcd_barrier_post(unsigned* bar, volatile LAS unsigned* st, int wave_s) {
    XcdBarrier b; b.bar = bar; b.x = xb_xcc_id(); b.st = st; b.wv = wave_s;
    if (fresh_tid(wave_s) == 0) (void)xb_add(&bar[XB_XCNT(b.x)], 1u);
    return b;
}
__device__ __forceinline__ void xcd_barrier_complete(unsigned* bar, unsigned x, unsigned& nloc, unsigned& nx) {
    const unsigned G = gridDim.x * gridDim.y * gridDim.z;
    unsigned sum, cnt, mine, sp = 0u;
    for (;;) {
        sum = 0u; cnt = 0u; mine = 0u;
#pragma unroll
        for (unsigned j = 0; j < 16; ++j) { const unsigned c = xb_ld(&bar[XB_XCNT(j)]); sum += c; cnt += (c > 0u) ? 1u : 0u; mine = (j == x) ? c : mine; }
        if (sum == G) break;
        __builtin_amdgcn_s_sleep(1);
        if ((++sp & 255u) == 0u) { if (xb_ld(&bar[XB_TMO])) break; if (sp > XB_SPIN_CAP) { atomicAdd(&bar[XB_TMO], 1u); break; } }
    }
    nloc = mine > 0u ? mine : 1u; nx = cnt > 0u ? cnt : 1u;
}

__device__ __forceinline__ void xcd_barrier(const XcdBarrier& b) {
    asm volatile("s_waitcnt vmcnt(0)" ::: "memory");
    __syncthreads();
    if (fresh_tid(b.wv) == 0) {
        unsigned* bar = b.bar;
        __builtin_amdgcn_s_waitcnt(0);
        unsigned nloc = b.st[0], nx = b.st[1];
        if (nloc == 0u) { xcd_barrier_complete(bar, b.x, nloc, nx); b.st[0] = nloc; b.st[1] = nx; }
        const unsigned old = xb_add(&bar[XB_XSUB(b.x)], 1u);
        const unsigned gen = old / nloc;
        if (old + 1u == (gen + 1u) * nloc) {
            __builtin_amdgcn_fence(__ATOMIC_RELEASE, "agent");
            asm volatile("s_waitcnt vmcnt(0)" ::: "memory");
            const unsigned og = xb_add(&bar[XB_TOP], 1u);
            const unsigned tg = og / nx;
            if (og + 1u == (tg + 1u) * nx) xb_add(&bar[XB_TOPGEN], 1u);
            else XB_SPIN(xb_ld(&bar[XB_TOPGEN]) == tg, bar);
            __builtin_amdgcn_fence(__ATOMIC_ACQUIRE, "agent");
            xb_add(&bar[XB_XGEN(b.x)], 1u);
            asm volatile("s_waitcnt vmcnt(0)" ::: "memory");
        } else {
            XB_SPIN(xb_ld(&bar[XB_XGEN(b.x)]) == gen, bar);
            __builtin_amdgcn_fence(__ATOMIC_ACQUIRE, "agent");
            asm volatile("s_waitcnt vmcnt(0)" ::: "memory");
        }
    }
    __syncthreads();
}

#ifndef REP
#define REP 0
#endif
#define PH_LOOP_ { int nrep_ = 2; asm volatile("" : "+s"(nrep_)); for (int rep_ = 0; rep_ < nrep_; ++rep_) {
#define PH_LOOPEND_ } }
#if (REP >> 0) & 1
#define PH_BEGIN_0 PH_LOOP_
#define PH_END_0 PH_LOOPEND_
#else
#define PH_BEGIN_0 {
#define PH_END_0 }
#endif
#if (REP >> 1) & 1
#define PH_BEGIN_1 PH_LOOP_
#define PH_END_1 PH_LOOPEND_
#else
#define PH_BEGIN_1 {
#define PH_END_1 }
#endif
#if (REP >> 2) & 1
#define PH_BEGIN_2 PH_LOOP_
#define PH_END_2 PH_LOOPEND_
#else
#define PH_BEGIN_2 {
#define PH_END_2 }
#endif
#if (REP >> 3) & 1
#define PH_BEGIN_3 PH_LOOP_
#define PH_END_3 PH_LOOPEND_
#else
#define PH_BEGIN_3 {
#define PH_END_3 }
#endif
#if (REP >> 4) & 1
#define PH_BEGIN_4 PH_LOOP_
#define PH_END_4 PH_LOOPEND_
#else
#define PH_BEGIN_4 {
#define PH_END_4 }
#endif
#if (REP >> 5) & 1
#define PH_BEGIN_5 PH_LOOP_
#define PH_END_5 PH_LOOPEND_
#else
#define PH_BEGIN_5 {
#define PH_END_5 }
#endif
#if (REP >> 6) & 1
#define PH_BEGIN_6 PH_LOOP_
#define PH_END_6 PH_LOOPEND_
#else
#define PH_BEGIN_6 {
#define PH_END_6 }
#endif
#if (REP >> 7) & 1
#define PH_BEGIN_7 PH_LOOP_
#define PH_END_7 PH_LOOPEND_
#else
#define PH_BEGIN_7 {
#define PH_END_7 }
#endif
struct Args { const float* in[15]; float* out; unsigned char* ws; };

namespace hg {
constexpr int QS = 272, TS = 144;
constexpr int SET_BYTES = 58368, OFF_Q = 0, OFF_K = 17408, OFF_KT = 34816, OFF_VT = 53248, OFF_DL = 57856;
constexpr int OFF_ST = 2 * SET_BYTES, ST_BYTES = 8704;
#define MFMA16(a, b, c) __builtin_amdgcn_mfma_f32_16x16x32_bf16((a), (b), (c), 0, 0, 0)
template <int SET> __device__ __forceinline__ void hgE(LAS unsigned char* lds, const f32x2 (&gv)[16], const unsigned (&qv)[16], int w, int lane) {
    LAS unsigned char* base = lds + SET * SET_BYTES;
    const int cp = lane & 15, rg = lane >> 4;
    float run0 = 1.f, run1 = 1.f;
#pragma unroll
    for (int j = 0; j < 16; ++j) { run0 *= gv[j].x; run1 *= gv[j].y; }
    float i0 = run0, i1 = run1;
    { const float a0 = __shfl_up(i0, 16), a1 = __shfl_up(i1, 16); if (rg >= 1) { i0 *= a0; i1 *= a1; } }
    { const float a0 = __shfl_up(i0, 32), a1 = __shfl_up(i1, 32); if (rg >= 2) { i0 *= a0; i1 *= a1; } }
    float pre0 = __shfl_up(i0, 16), pre1 = __shfl_up(i1, 16); if (rg == 0) { pre0 = 1.f; pre1 = 1.f; }
    const float all0 = __shfl(i0, cp + 48), all1 = __shfl(i1, cp + 48);
    unsigned kh0[8], kh1[8]; float kp0 = 0.f, kp1 = 0.f, ea = pre0, eb = pre1;
    LAS unsigned char* qw = base + OFF_Q + (16 * rg) * QS + (32 * w + 2 * cp) * 2;
#pragma unroll
    for (int j = 0; j < 16; ++j) {
        ea *= gv[j].x; eb *= gv[j].y;
        const float qa = bf_lo(qv[j]) * ea, qb = bf_hi(qv[j]) * eb;
        const float ka = (1.f - gv[j].x) * __builtin_amdgcn_rcpf(ea), kb = (1.f - gv[j].y) * __builtin_amdgcn_rcpf(eb);
        *(LAS unsigned*)(qw + j * QS) = cvtpk_s(qa, qb);
        *(LAS unsigned*)(qw + (OFF_K - OFF_Q) + j * QS) = cvtpk_s(ka, kb);
        const float ha = ka * all0, hb = kb * all1;
        if (j & 1) { kh0[j >> 1] = cvtpk_s(kp0, ha); kh1[j >> 1] = cvtpk_s(kp1, hb); } else { kp0 = ha; kp1 = hb; }
    }
    LAS unsigned char* kw = base + OFF_KT + (32 * w + 2 * cp) * TS + rg * 32;
    *(LAS u32x4*)(kw) = (u32x4){kh0[0], kh0[1], kh0[2], kh0[3]}; *(LAS u32x4*)(kw + 16) = (u32x4){kh0[4], kh0[5], kh0[6], kh0[7]};
    *(LAS u32x4*)(kw + TS) = (u32x4){kh1[0], kh1[1], kh1[2], kh1[3]}; *(LAS u32x4*)(kw + TS + 16) = (u32x4){kh1[4], kh1[5], kh1[6], kh1[7]};
    if (rg == 0) *(LAS f32x2*)(base + OFF_DL + (32 * w + 2 * cp) * 4) = (f32x2){all0, all1};
}
template <int SET, int VAR = 0> __device__ __forceinline__ void hgM(LAS unsigned char* lds, f32x4 (&st)[2][2], int ti, int lane, char* ob, unsigned ol) {
    const int l16 = lane & 15, kq = lane >> 4;
    const LAS unsigned char* base = lds + SET * SET_BYTES;
    bf16x8 qf[4], kf[4][4], sb[2][4], kt[2][2], vv[2][2]; u32x2 va[2][2], vb2[2][2]; f32x4 dl[2];
    const LAS unsigned char* qrow = base + OFF_Q + (16 * ti + l16) * QS + kq * 16;
    const LAS unsigned char* krow = base + OFF_K + l16 * QS + kq * 16;
    const LAS unsigned char* srow = lds + OFF_ST + SET * ST_BYTES + l16 * QS + kq * 16;
    const LAS unsigned char* vrow = base + OFF_VT + l16 * TS;
#pragma unroll
    for (int kk = 0; kk < 4; ++kk) { qf[kk] = *(const LAS bf16x8*)(qrow + kk * 64); sb[0][kk] = *(const LAS bf16x8*)(srow + kk * 64); sb[1][kk] = *(const LAS bf16x8*)(srow + 16 * QS + kk * 64); }
#pragma unroll
    for (int si = 0; si < 4; ++si)
#pragma unroll
        for (int kk = 0; kk < 4; ++kk) kf[si][kk] = *(const LAS bf16x8*)(krow + si * 16 * QS + kk * 64);
#pragma unroll
    for (int vh = 0; vh < 2; ++vh)
#pragma unroll
        for (int p = 0; p < 2; ++p) { va[vh][p] = *(const LAS u32x2*)(vrow + vh * 16 * TS + kq * 8 + p * 64); vb2[vh][p] = *(const LAS u32x2*)(vrow + vh * 16 * TS + kq * 8 + p * 64 + 32); }
#pragma unroll
    for (int kk = 0; kk < 2; ++kk) { vv[0][kk] = *(const LAS bf16x8*)(vrow + kk * 64 + kq * 16); vv[1][kk] = *(const LAS bf16x8*)(vrow + 16 * TS + kk * 64 + kq * 16);
        kt[0][kk] = *(const LAS bf16x8*)(base + OFF_KT + (32 * ti + l16) * TS + kk * 64 + kq * 16); kt[1][kk] = *(const LAS bf16x8*)(base + OFF_KT + (32 * ti + 16 + l16) * TS + kk * 64 + kq * 16); }
    dl[0] = *(const LAS f32x4*)(base + OFF_DL + (32 * ti + 4 * kq) * 4); dl[1] = *(const LAS f32x4*)(base + OFF_DL + (32 * ti + 16 + 4 * kq) * 4);
    __builtin_amdgcn_sched_barrier(0);
    f32x4 o[2], as[4];
    o[0] = (f32x4){0.f, 0.f, 0.f, 0.f}; o[1] = o[0];
#pragma unroll
    for (int si = 0; si < 4; ++si) as[si] = (f32x4){0.f, 0.f, 0.f, 0.f};
#pragma unroll
    for (int kk = 0; kk < 4; ++kk) { o[0] = MFMA16(qf[kk], sb[0][kk], o[0]); o[1] = MFMA16(qf[kk], sb[1][kk], o[1]);
#pragma unroll
        for (int si = 0; si < 4; ++si) as[si] = MFMA16(kf[si][kk], qf[kk], as[si]); }
#pragma unroll
    for (int ds = 0; ds < 2; ++ds)
#pragma unroll
        for (int vh = 0; vh < 2; ++vh) { st[ds][vh] = st[ds][vh] * dl[ds];
#pragma unroll
            for (int kk = 0; kk < 2; ++kk) st[ds][vh] = MFMA16(kt[ds][kk], vv[vh][kk], st[ds][vh]); }
    const int tq = 16 * ti + l16 - 4 * kq;
#pragma unroll
    for (int si = 0; si < 4; ++si)
#pragma unroll
        for (int j = 0; j < 4; ++j) if (16 * si + j > tq) as[si][j] = 0.f;
#pragma unroll
    for (int p = 0; p < 2; ++p) {
        u32x4 pw; pw.x = cvtpk_s(as[2 * p][0], as[2 * p][1]); pw.y = cvtpk_s(as[2 * p][2], as[2 * p][3]); pw.z = cvtpk_s(as[2 * p + 1][0], as[2 * p + 1][1]); pw.w = cvtpk_s(as[2 * p + 1][2], as[2 * p + 1][3]);
#pragma unroll
        for (int vh = 0; vh < 2; ++vh) { const u32x4 vw = {va[vh][p].x, va[vh][p].y, vb2[vh][p].x, vb2[vh][p].y};
            o[vh] = MFMA16(__builtin_bit_cast(bf16x8, pw), __builtin_bit_cast(bf16x8, vw), o[vh]); }
    }
    if ((VAR & 1) == 0 || o[0][0] == 12345.678f) {
#pragma unroll
    for (int vh = 0; vh < 2; ++vh)
#pragma unroll
        for (int j = 0; j < 4; ++j) *(bf16r*)(ob + (size_t)j * DM * 2 + vh * 32 + ol) = (bf16r)(cvtpk_s(o[vh][j], 0.f) & 0xffffu);
    }
#pragma unroll
    for (int ds = 0; ds < 2; ++ds)
#pragma unroll
        for (int vh = 0; vh < 2; ++vh)
            *(LAS u32x2*)(lds + OFF_ST + (SET ^ 1) * ST_BYTES + (16 * vh + l16) * QS + (32 * ti + 16 * ds + 4 * kq) * 2) = (u32x2){cvtpk_s(st[ds][vh][0], st[ds][vh][1]), cvtpk_s(st[ds][vh][2], st[ds][vh][3])};
}
template <int SET> __device__ __forceinline__ void hgV(LAS unsigned char* lds, const u32x4& v, int mt) {
    LAS bf16r* vt = (LAS bf16r*)(lds + SET * SET_BYTES + OFF_VT + (mt & 3) * 8 * TS + (mt >> 2) * 2);
    vt[0] = (bf16r)(v.x & 0xffffu); vt[TS / 2] = (bf16r)(v.x >> 16); vt[2 * (TS / 2)] = (bf16r)(v.y & 0xffffu); vt[3 * (TS / 2)] = (bf16r)(v.y >> 16);
    vt[4 * (TS / 2)] = (bf16r)(v.z & 0xffffu); vt[5 * (TS / 2)] = (bf16r)(v.z >> 16); vt[6 * (TS / 2)] = (bf16r)(v.w & 0xffffu); vt[7 * (TS / 2)] = (bf16r)(v.w >> 16);
}
template <int VAR = 0> __device__ __forceinline__ void hgrn_item(LAS unsigned char* lds, const bf16r* SQ, const float* G, const bf16r* V, bf16r* O, int item, int tid_in) {
    const int tid = tid_in, lane = tid & 63, w = __builtin_amdgcn_readfirstlane(tid >> 6);
    const int bh = item >> 2, vs = item & 3, b = bh >> 4, h = bh & 15;
    const size_t rowbase = (size_t)b * SEQ;
    constexpr int NC = SEQ / 64;
    if (w < 4) {
        const int cp = lane & 15, rg = lane >> 4;
        const float* gp = G + (rowbase + 16 * rg) * DM + h * 128 + 32 * w + 2 * cp;
        const bf16r* qp = SQ + (rowbase + 16 * rg) * DM + h * 128 + 32 * w + 2 * cp;
        f32x2 gvA[16], gvB[16]; unsigned qvA[16], qvB[16];
#define HG_LOADE(GV, QV, c_) do { const size_t adv_ = (size_t)(c_) * 64 * DM; _Pragma("unroll") for (int j = 0; j < 16; ++j) { GV[j] = *(const f32x2*)(gp + adv_ + (size_t)j * DM); QV[j] = *(const unsigned*)(qp + adv_ + (size_t)j * DM); } } while (0)
        HG_LOADE(gvA, qvA, 0); HG_LOADE(gvB, qvB, 1);
        hgE<0>(lds, gvA, qvA, w, lane); HG_LOADE(gvA, qvA, 2);
        HBAR();
        for (int c = 0; c < NC; c += 2) {
            if ((VAR & 8) == 0) hgE<1>(lds, gvB, qvB, w, lane); if ((VAR & 2) == 0) HG_LOADE(gvB, qvB, (c + 3 < NC ? c + 3 : NC - 1));
            HBAR();
            if ((VAR & 8) == 0) hgE<0>(lds, gvA, qvA, w, lane); if ((VAR & 2) == 0) HG_LOADE(gvA, qvA, (c + 4 < NC ? c + 4 : NC - 1));
            HBAR();
        }
#undef HG_LOADE
    } else {
        const int ti = w - 4, mt = tid - 256, l16 = lane & 15, kq = lane >> 4;
        const bf16r* vp = V + (rowbase + (mt >> 2)) * DM + h * 128 + vs * 32 + (mt & 3) * 8;
        char* ob = (char*)(O + (rowbase + 16 * ti) * DM + h * 128 + vs * 32);
        const unsigned ol = (4 * kq * DM + l16) * 2;
        for (int i = mt; i < ST_BYTES / 4; i += 256) ((LAS unsigned*)(lds + OFF_ST))[i] = 0u;
        f32x4 st[2][2];
#pragma unroll
        for (int ds = 0; ds < 2; ++ds) { st[ds][0] = (f32x4){0.f, 0.f, 0.f, 0.f}; st[ds][1] = st[ds][0]; }
        u32x4 vA = *(const u32x4*)vp, vB = *(const u32x4*)(vp + (size_t)64 * DM);
        hgV<0>(lds, vA, mt); vA = *(const u32x4*)(vp + (size_t)2 * 64 * DM);
        HBAR();
        for (int c = 0; c < NC; c += 2) {
            if ((VAR & 4) == 0) hgM<0, VAR>(lds, st, ti, lane, ob + (size_t)c * 64 * DM * 2, ol);
            hgV<1>(lds, vB, mt); vB = *(const u32x4*)(vp + (size_t)(c + 3 < NC ? c + 3 : NC - 1) * 64 * DM);
            HBAR();
            if ((VAR & 4) == 0) hgM<1, VAR>(lds, st, ti, lane, ob + (size_t)(c + 1) * 64 * DM * 2, ol);
            hgV<0>(lds, vA, mt); vA = *(const u32x4*)(vp + (size_t)(c + 4 < NC ? c + 4 : NC - 1) * 64 * DM);
            HBAR();
        }
    }
}
}

__global__ void __launch_bounds__(NTHR, 2) fwd_megakernel(Args args) {
    extern __shared__ __attribute__((aligned(16))) unsigned char lds_raw[];
    cg::grid_group grid = cg::this_grid();
    LAS unsigned char* lds = (LAS unsigned char*)lds_raw;
    const int G = gridDim.x, NGW = G * NWAVES, NGT = G * NTHR;
    const int wave_s = __builtin_amdgcn_readfirstlane((int)threadIdx.x >> 6);
    { const int t0_ = fresh_tid(wave_s); if (t0_ < 2) ((volatile LAS unsigned*)(lds + 147008))[t0_] = 0u; }
    __syncthreads();
    const XcdBarrier xbar = xcd_barrier_post((unsigned*)(args.ws + 4096), (volatile LAS unsigned*)(lds + 147008), wave_s);
#define GRID_BAR() xcd_barrier(xbar)
#define PHASE_IDS() const int tid = fresh_tid(wave_s); const int lane = tid & 63, wave = wave_s; \
    const int gw = blockIdx.x * NWAVES + wave, gt = blockIdx.x * NTHR + tid; (void)lane; (void)gw; (void)gt
    unsigned char* ws = args.ws;
    const float* x = args.in[0]; const float* p = args.in[1]; const float* w_in_fox = args.in[2]; const float* b_f = args.in[3];
    const float* g_q = args.in[4]; const float* g_k = args.in[5]; const float* w_out_fox = args.in[6]; const float* w_in_hg = args.in[7];
    const float* lbl = args.in[8]; const float* g_o = args.in[9]; const float* w_out_hg = args.in[10]; const float* pre_norm = args.in[11];
    const float* post_norm = args.in[12]; const float* w_pe = args.in[13]; const float* w_pg = args.in[14];
    float* out = args.out;
    float* negc = (float*)(ws + WS_NEGC); float* logf = (float*)(ws + WS_LOGF); float* ss = (float*)(ws + WS_SS); float* rstd1 = (float*)(ws + WS_RSTD); float* rstdY = rstd1 + M; float* gbuf = (float*)(ws + WS_GBUF);
    bf16r* WFOX = (bf16r*)(ws + WS_WFOX); bf16r* WOF = (bf16r*)(ws + WS_WOF); bf16r* WHG = (bf16r*)(ws + WS_WHG); bf16r* WOH = (bf16r*)(ws + WS_WOH);
    bf16r* WPE = (bf16r*)(ws + WS_WPE); bf16r* WPG = (bf16r*)(ws + WS_WPG); bf16r* PB = (bf16r*)(ws + WS_PB);
    bf16r* bA = (bf16r*)(ws + WS_A); bf16r* bB = (bf16r*)(ws + WS_B); bf16r* bC = (bf16r*)(ws + WS_C); bf16r* bD = (bf16r*)(ws + WS_D); bf16r* bE = (bf16r*)(ws + WS_E); bf16r* bF = (bf16r*)(ws + WS_F);

#define DEFERRED_CONVERT(gw_, ngw_, gt_, ngt_) do { \
        constexpr int I_SQ = 32 * 64, I_HG = 32 * 256, I_PE = 4 * 64, NITEMS = I_SQ + I_HG + I_SQ + 2 * I_PE + 2 * I_SQ; \
        for (int it = (gw_); it < NITEMS; it += (ngw_)) { int r = it; \
            if (r < I_SQ) { transpose_item(w_out_fox, DM, DM, 64, WOF, nullptr, scr, r, lane); continue; } r -= I_SQ; \
            if (r < I_HG) { transpose_item(w_in_hg, 4 * DM, DM, 256, WHG, pre_norm + DM, scr, r, lane); continue; } r -= I_HG; \
            if (r < I_SQ) { transpose_item(w_out_hg, DM, DM, 64, WOH, nullptr, scr, r, lane); continue; } r -= I_SQ; \
            if (r < I_PE) { transpose_item(w_pe, DM, PLE, 64, WPE, nullptr, scr, r, lane); continue; } r -= I_PE; \
            if (r < I_PE) { transpose_item(w_pe + (size_t)PLE * DM, DM, PLE, 64, WPE + (size_t)DM * PLE, nullptr, scr, r, lane); continue; } r -= I_PE; \
            if (r < I_SQ) { transpose_item(w_pg, DM, DM, 64, WPG, nullptr, scr, r, lane); continue; } r -= I_SQ; \
            transpose_item(w_pg + (size_t)DM * DM, DM, DM, 64, WPG + (size_t)DM * DM, nullptr, scr, r, lane); } \
        for (int i = (gt_); i < 2 * M * PLE / 8; i += (ngt_)) { const f32x4 a = *(const f32x4*)(p + (size_t)i * 8), b2 = *(const f32x4*)(p + (size_t)i * 8 + 4); *(u32x4*)(PB + (size_t)i * 8) = pack8(a, b2); } } while (0)

    PH_BEGIN_0
    {
        PHASE_IDS();
        LAS float* scr = (LAS float*)(lds + wave * 8448);
        for (int it = gw; it < 32 * 256; it += NGW) transpose_item(w_in_fox, NFOX, DM, 256, WFOX, nullptr, scr, it, lane);
        if (G != 256) { DEFERRED_CONVERT(gw, NGW, gt, NGT); }
        for (int i = gt; i < 4096 + 240 * 256; i += NGT) {
            if (i < 4096) { const int n = i & 15, kc = i >> 4; float v[8];
#pragma unroll
                for (int j = 0; j < 8; ++j) v[j] = w_in_fox[(size_t)(kc * 8 + j) * NFOX + 8192 + n];
                u32x4 o; o.x = cvtpk_s(v[0], v[1]); o.y = cvtpk_s(v[2], v[3]); o.z = cvtpk_s(v[4], v[5]); o.w = cvtpk_s(v[6], v[7]);
                *(u32x4*)(WFOX + (size_t)(8192 + n) * DM + kc * 8) = o; }
            else { const int r = i - 4096; *(u32x4*)(WFOX + (size_t)(8208 + (r >> 8)) * DM + (r & 255) * 8) = (u32x4){0u, 0u, 0u, 0u}; } }
        if (blockIdx.x == 0 && tid < 256) gbuf[tid] = tid < 128 ? g_q[tid] : g_k[tid - 128];
        for (int row = gw; row < M; row += 2 * NGW) { const int row2 = row + NGW;
            const bool has2 = row2 < M; const float* xr = x + (size_t)row * DM + lane * 4; const float* xr2 = x + (size_t)(has2 ? row2 : row) * DM + lane * 4;
            f32x4 v[8], u[8]; float s = 0.f, s2 = 0.f;
#pragma unroll
            for (int j = 0; j < 8; ++j) { v[j] = *(const f32x4*)(xr + j * 256); u[j] = *(const f32x4*)(xr2 + j * 256); }
#pragma unroll
            for (int j = 0; j < 8; ++j) { s += (v[j][0] * v[j][0] + v[j][1] * v[j][1]) + (v[j][2] * v[j][2] + v[j][3] * v[j][3]); s2 += (u[j][0] * u[j][0] + u[j][1] * u[j][1]) + (u[j][2] * u[j][2] + u[j][3] * u[j][3]); }
            const float r = rsqrtf(wave_sum(s) * (1.f / DM) + EPS), r2 = rsqrtf(wave_sum(s2) * (1.f / DM) + EPS);
#pragma unroll
            for (int j = 0; j < 8; ++j) { const f32x4 g = *(const f32x4*)(pre_norm + j * 256 + lane * 4); const f32x4 o = v[j] * r * g, o2 = u[j] * r2 * g;
                *(u32x2*)(bA + (size_t)row * DM + j * 256 + lane * 4) = (u32x2){cvtpk_s(o[0], o[1]), cvtpk_s(o[2], o[3])};
                if (has2) *(u32x2*)(bA + (size_t)row2 * DM + j * 256 + lane * 4) = (u32x2){cvtpk_s(o2[0], o2[1]), cvtpk_s(o2[2], o2[3])}; } }
    }
    GRID_BAR();
    if (args.ws == nullptr) grid.sync();
    PH_END_0

    PH_BEGIN_1
#if !defined(GMASK) || (GMASK & 1)
    { pg8::Gemm g{bA, WFOX, M, NFOXP, DM}; pg8::StaticOrder S; S.init(M, NFOXP, G, (int)blockIdx.x);
      pg8::EpiFoxIn E{bB, bE, (size_t)(WS_C - WS_B) / 2, logf, b_f, gbuf, (LAS float*)(lds + 131072)};
      pg8::gemm_phase<pg8::EpiFoxIn, pg8::StaticOrder, true, true>(lds, g, S, E, wave_s); }
#endif
    if (G == 256 && blockIdx.x >= 128) {
        PHASE_IDS(); __syncthreads(); LAS float* scr = (LAS float*)(lds + wave * 8448);
        DEFERRED_CONVERT(((int)blockIdx.x - 128) * NWAVES + wave, 128 * NWAVES, ((int)blockIdx.x - 128) * NTHR + tid, 128 * NTHR); }
    GRID_BAR();
    PH_END_1

    {
        PHASE_IDS();
        for (int seq = blockIdx.x; seq < BATCH * NH; seq += G) {
            const float* src = logf + (size_t)seq * SEQ + tid * 16; float v[16];
#pragma unroll
            for (int j = 0; j < 4; ++j) { const f32x4 t = *(const f32x4*)(src + 4 * j); v[4 * j] = t[0]; v[4 * j + 1] = t[1]; v[4 * j + 2] = t[2]; v[4 * j + 3] = t[3]; }
#pragma unroll
            for (int j = 1; j < 16; ++j) v[j] += v[j - 1];
            float incl = v[15];
#pragma unroll
            for (int o = 1; o < 64; o <<= 1) { const float t = __shfl_up(incl, o); if (lane >= o) incl += t; }
            LAS float* wt = (LAS float*)lds;
            __syncthreads();
            if (lane == 63) wt[wave] = incl;
            __syncthreads();
            float pre = incl - v[15];
            for (int ww = 0; ww < wave; ++ww) pre += wt[ww];
            float* dst = negc + (size_t)seq * SEQ + tid * 16;
#pragma unroll
            for (int j = 0; j < 4; ++j) { f32x4 t; t[0] = -(v[4 * j] + pre) * 11.313708498984761f; t[1] = -(v[4 * j + 1] + pre) * 11.313708498984761f; t[2] = -(v[4 * j + 2] + pre) * 11.313708498984761f; t[3] = -(v[4 * j + 3] + pre) * 11.313708498984761f; *(f32x4*)(dst + 4 * j) = t; }
        }
    }
    GRID_BAR();

    PH_BEGIN_2
#ifndef NO_ATT
    {
        using namespace att;
        typedef BlockRef<bf16, bf16> BR;
        constexpr int nqb = SEQ / QB, W = 1 << 20;
        char* ldsg = (char*)lds_raw;
        volatile LAS int* hord = (volatile LAS int*)(lds + 143360);
        constexpr float PRUNE_MARGIN = 27.f;
        float TH, TH2;
        {
            PHASE_IDS();
        float gqm = fmaxf(fabsf(gbuf[lane]), fabsf(gbuf[lane + 64])), gkm = fmaxf(fabsf(gbuf[128 + lane]), fabsf(gbuf[192 + lane]));
#pragma unroll
        for (int o = 1; o < 64; o <<= 1) { gqm = fmaxf(gqm, __shfl_xor(gqm, o)); gkm = fmaxf(gkm, __shfl_xor(gkm, o)); }
        TH = __uint_as_float(__builtin_amdgcn_readfirstlane(__float_as_uint((2.f * 11.313708f * gqm * gkm * 1.02f + PRUNE_MARGIN) * 11.313708f)));
        TH2 = __uint_as_float(__builtin_amdgcn_readfirstlane(__float_as_uint((11.313708f * gqm * gkm * 1.02f + PRUNE_MARGIN) * 11.313708f)));
        if (tid < 16) { const float mine = b_f[tid]; int rk = 0;
            for (int j = 0; j < 16; ++j) { const float o = b_f[j]; rk += (o > mine || (o == mine && j < tid)) ? 1 : 0; }
            hord[rk] = tid; }
        }
        __syncthreads();
        unsigned* qctr = (unsigned*)ws;
#define FETCH(Lout) do { __syncthreads(); if (fresh_tid(wave_s) == 0) { int q_ = (int)(xbar.x & 7u), got_ = -1; \
            for (int t_ = 0; t_ < 8; ++t_) { const unsigned i_ = atomicAdd(qctr + 64 * q_, 1u); if (i_ < 256u) { got_ = q_ * 256 + (int)i_; break; } q_ = (q_ + 1) & 7; } \
            hord[16] = got_; } __syncthreads(); Lout = __builtin_amdgcn_readfirstlane(hord[16]); } while (0)
#define DECODE(L_) SwaItem{((((L_) & 127) >> 5) * NH) + __builtin_amdgcn_readfirstlane(hord[(((L_) >> 7) & 1) ? 15 - ((L_) >> 8) : ((L_) >> 8)]), nqb - 1 - ((L_) & 31), nqb - 1 - ((L_) & 31)}
#define MKREF(it_, pass_) mk_ref<bf16, bf16>((it_), (pass_), (const bf16*)bB, (const bf16*)bC, (const bf16*)bD, (bf16*)bF, (const bf16*)bE, negc, SEQ)
        int L; FETCH(L);
        if (L >= 0) {
            SwaItem it = DECODE(L);
            BR cur = MKREF(it, 0);
            Seam<bf16> S;
            causal_swa_prime<bf16, bf16>(cur, W, ldsg, S, wave_s);
            for (;;) {
                int Ln; FETCH(Ln);
                const bool last = Ln < 0;
                const SwaItem itn = last ? it : DECODE(Ln);
                const BR nxt = last ? cur : MKREF(itn, 0);
                causal_swa_block<bf16, bf16>(cur, nxt, SEQ, W, ldsg, S, TH, TH2, wave_s);
                if (last) break;
                cur = nxt; it = itn; L = Ln;
            }
        }
    }
#endif
    GRID_BAR();
    PH_END_2

    PH_BEGIN_3
#if !defined(GMASK) || (GMASK & 2)
    { pg8::Gemm g{bF, WOF, M, DM, DM}; pg8::StaticOrder S; S.init(M, DM, G, (int)blockIdx.x);
      pg8::EpiOutSS E{bB, ss};
      pg8::gemm_phase<pg8::EpiOutSS, pg8::StaticOrder, true, true>(lds, g, S, E, wave_s); }
#endif
    __syncthreads();
#if !defined(GMASK) || (GMASK & 4)
    { int kpe = PLE; asm volatile("" : "+s"(kpe)); pg8::Gemm g{PB, WPE, M, DM, kpe}; pg8::StaticOrder S; S.init(M, DM, G, (int)blockIdx.x);
      pg8::EpiPlain E{bC};
      pg8::gemm_phase<pg8::EpiPlain, pg8::StaticOrder, true, true>(lds, g, S, E, wave_s); }
#endif
    GRID_BAR();
    PH_END_3

    PH_BEGIN_4
    { PHASE_IDS();
    for (int row = gw; row < M; row += NGW) { float s = lane < 32 ? ss[(size_t)row * 32 + lane] : 0.f; const float r = rsqrtf(wave_sum(s) * (1.f / DM) + EPS);
#pragma unroll
        for (int j = 0; j < 8; ++j) { const size_t idx = (size_t)row * DM + j * 256 + lane * 4; const f32x4 xr = *(const f32x4*)(x + idx); const u32x2 yv = *(const u32x2*)(bB + idx);
            const f32x4 g = *(const f32x4*)(post_norm + j * 256 + lane * 4); const f32x4 y = {bf_lo(yv.x), bf_hi(yv.x), bf_lo(yv.y), bf_hi(yv.y)};
            const f32x4 hv = xr + y * r * g; *(u32x2*)(bA + idx) = (u32x2){cvtpk_s(hv[0], hv[1]), cvtpk_s(hv[2], hv[3])}; }
        if (lane == 0) rstdY[row] = r; } }
    GRID_BAR();
    PH_END_4

#if !defined(GMASK) || (GMASK & 8)
    { pg8::Gemm g{bA, WPG, M, DM, DM}; pg8::StaticOrder S; S.init(M, DM, G, (int)blockIdx.x);
      pg8::EpiPG E{x, out, bB, rstdY, post_norm, bC, bF, ss};
      pg8::gemm_phase<pg8::EpiPG, pg8::StaticOrder, true, true>(lds, g, S, E, wave_s); }
#endif
    GRID_BAR();
    { PHASE_IDS();
    for (int row = gt; row < M; row += NGT) { float s = 0.f;
#pragma unroll
        for (int j = 0; j < 8; ++j) { const f32x4 t = *(const f32x4*)(ss + (size_t)row * 32 + 4 * j); s += (t[0] + t[1]) + (t[2] + t[3]); }
        rstd1[row] = rsqrtf(s * (1.f / DM) + EPS); } }
    GRID_BAR();

    PH_BEGIN_5
#if !defined(GMASK) || (GMASK & 16)
    { pg8::Gemm g{bF, WHG, M, 4 * DM, DM}; pg8::StaticOrder S; S.init(M, 4 * DM, G, (int)blockIdx.x);
      pg8::EpiHgIn E{bA, (size_t)(WS_B - WS_A) / 2, (float*)bB, rstd1, lbl};
      pg8::gemm_phase<pg8::EpiHgIn, pg8::StaticOrder, true, true>(lds, g, S, E, wave_s); }
#endif
    GRID_BAR();
    PH_END_5

    PH_BEGIN_6
#ifndef NO_HG
    { PHASE_IDS();
    for (int i = blockIdx.x; i < BATCH * NH * 4; i += G) {
        const int item = ((G & 31) == 0) ? (((i & 7) * (BATCH * NH / 8) + (i >> 5)) * 4 + ((i >> 3) & 3)) : i;
        hg::hgrn_item<0>(lds, bA, (const float*)bB, bD, bF, item, tid); } }
#endif
    GRID_BAR();
    PH_END_6

#ifdef HGPROBE
    { PHASE_IDS();
    for (int i = blockIdx.x; i < BATCH * NH * 4; i += G) {
        const int item = ((G & 31) == 0) ? (((i & 7) * (BATCH * NH / 8) + (i >> 5)) * 4 + ((i >> 3) & 3)) : i;
        hg::hgrn_item<HGPROBE>(lds, bA, (const float*)bB, bD, bF, item, tid); } }
    GRID_BAR();
#endif
    { PHASE_IDS();
    for (int it = gw; it < M * NH / 4; it += NGW) { const size_t off = ((size_t)it * 4 + (lane >> 4)) * 128 + (lane & 15) * 8;
        const u32x4 wv = *(const u32x4*)(bF + off), zv = *(const u32x4*)(bE + off);
        f32x4 a = {bf_lo(wv.x), bf_hi(wv.x), bf_lo(wv.y), bf_hi(wv.y)}, b2 = {bf_lo(wv.z), bf_hi(wv.z), bf_lo(wv.w), bf_hi(wv.w)};
        float s = (a[0] * a[0] + a[1] * a[1]) + (a[2] * a[2] + a[3] * a[3]) + (b2[0] * b2[0] + b2[1] * b2[1]) + (b2[2] * b2[2] + b2[3] * b2[3]);
        s += __shfl_xor(s, 1); s += __shfl_xor(s, 2); s += __shfl_xor(s, 4); s += __shfl_xor(s, 8);
        const float r = rsqrtf(s * (1.f / 128.f) + EPS); const float* gg = g_o + (lane & 15) * 8;
        const f32x4 z0 = {bf_lo(zv.x), bf_hi(zv.x), bf_lo(zv.y), bf_hi(zv.y)}, z1 = {bf_lo(zv.z), bf_hi(zv.z), bf_lo(zv.w), bf_hi(zv.w)};
        a = a * r * *(const f32x4*)gg * z0; b2 = b2 * r * *(const f32x4*)(gg + 4) * z1;
        *(u32x4*)(bF + off) = pack8(a, b2); } }
    GRID_BAR();

    PH_BEGIN_7
#if !defined(GMASK) || (GMASK & 32)
    { pg8::Gemm g{bF, WOH, M, DM, DM}; pg8::StaticOrder S; S.init(M, DM, G, (int)blockIdx.x);
      pg8::EpiOutSS E{bD, ss};
      pg8::gemm_phase<pg8::EpiOutSS, pg8::StaticOrder, true, true>(lds, g, S, E, wave_s); }
#endif
    __syncthreads();
#if !defined(GMASK) || (GMASK & 64)
    { int kpe = PLE; asm volatile("" : "+s"(kpe)); pg8::Gemm g{PB + (size_t)M * PLE, WPE + (size_t)DM * PLE, M, DM, kpe}; pg8::StaticOrder S; S.init(M, DM, G, (int)blockIdx.x);
      pg8::EpiPlain E{bE};
      pg8::gemm_phase<pg8::EpiPlain, pg8::StaticOrder, true, true>(lds, g, S, E, wave_s); }
#endif
    GRID_BAR();
    PH_END_7

    { PHASE_IDS();
    for (int row = gw; row < M; row += NGW) { float s = lane < 32 ? ss[(size_t)row * 32 + lane] : 0.f; const float r = rsqrtf(wave_sum(s) * (1.f / DM) + EPS);
#pragma unroll
        for (int j = 0; j < 8; ++j) { const size_t idx = (size_t)row * DM + j * 256 + lane * 4; const f32x4 xr = *(const f32x4*)(out + idx); const u32x2 yv = *(const u32x2*)(bD + idx);
            const f32x4 g = *(const f32x4*)(post_norm + DM + j * 256 + lane * 4); const f32x4 y = {bf_lo(yv.x), bf_hi(yv.x), bf_lo(yv.y), bf_hi(yv.y)};
            const f32x4 hv = xr + y * r * g; *(u32x2*)(bA + idx) = (u32x2){cvtpk_s(hv[0], hv[1]), cvtpk_s(hv[2], hv[3])}; }
        if (lane == 0) rstdY[row] = r; } }
    GRID_BAR();

#if !defined(GMASK) || (GMASK & 128)
    { pg8::Gemm g{bA, WPG + (size_t)DM * DM, M, DM, DM}; pg8::StaticOrder S; S.init(M, DM, G, (int)blockIdx.x);
      pg8::EpiPG E{out, out, bD, rstdY, post_norm + DM, bE, nullptr, nullptr};
      pg8::gemm_phase<pg8::EpiPG, pg8::StaticOrder, true, true>(lds, g, S, E, wave_s); }
#endif
}

extern "C" void kernel_launch(void* const* d_in, const int* in_sizes, int n_in, void* d_out, int out_size, void* d_ws, size_t ws_size, hipStream_t stream) {
    static int grid = 0;
    if (grid == 0) {
        if (n_in != 15 || out_size != M * DM || ws_size < WS_END) { fprintf(stderr, "kernel_launch: unexpected shapes (n_in %d out %d ws %zu)\n", n_in, out_size, ws_size); grid = -1; return; }
        int dev = 0, cus = 0, per_cu = 0;
        (void)hipGetDevice(&dev); (void)hipDeviceGetAttribute(&cus, hipDeviceAttributeMultiprocessorCount, dev);
        if (hipFuncSetAttribute((const void*)fwd_megakernel, hipFuncAttributeMaxDynamicSharedMemorySize, LDS_BYTES) != hipSuccess) fprintf(stderr, "kernel_launch: hipFuncSetAttribute failed\n");
        if (hipOccupancyMaxActiveBlocksPerMultiprocessor(&per_cu, (const void*)fwd_megakernel, NTHR, LDS_BYTES) != hipSuccess || per_cu < 1) { fprintf(stderr, "kernel_launch: occupancy query says %d\n", per_cu); per_cu = 1; }
        (void)hipGetLastError();
        if (cus <= 0) cus = 256;
        grid = cus * 1;
    }
    if (grid < 0) return;
    if (hipMemsetAsync(d_ws, 0, 65536, stream) != hipSuccess) { fprintf(stderr, "kernel_launch: hipMemsetAsync failed\n"); return; }
    Args a{};
    for (int i = 0; i < 15; ++i) a.in[i] = (const float*)d_in[i];
    a.out = (float*)d_out; a.ws = (unsigned char*)d_ws;
    void* kargs[] = {&a};
    hipError_t e = hipLaunchCooperativeKernel((const void*)fwd_megakernel, dim3(grid), dim3(NTHR), kargs, LDS_BYTES, stream);
    if (e != hipSuccess) fprintf(stderr, "cooperative launch failed: %s (grid %d)\n", hipGetErrorString(e), grid);
}
```

```cpp
#include <hip/hip_runtime.h>
#include <hip/hip_bf16.h>
#include <hip/hip_cooperative_groups.h>
#include <cstdio>
#include <cstdint>
namespace cg = cooperative_groups;

typedef __bf16 bf16x2_t __attribute__((ext_vector_type(2)));
typedef float f32x2_t __attribute__((ext_vector_type(2)));
__device__ __forceinline__ unsigned cvtpk_s(float lo, float hi) { f32x2_t v = {lo, hi}; bf16x2_t b = __builtin_convertvector(v, bf16x2_t); return __builtin_bit_cast(unsigned, b); }
__device__ __forceinline__ float bf_lo(unsigned w) { return __uint_as_float(w << 16); }
__device__ __forceinline__ float bf_hi(unsigned w) { return __uint_as_float(w & 0xffff0000u); }
__device__ __forceinline__ float sigmoidf_(float x) { return __builtin_amdgcn_rcpf(1.0f + __expf(-x)); }
__device__ __forceinline__ float siluf_(float x) { return x * __builtin_amdgcn_rcpf(1.0f + __expf(-x)); }

__device__ __forceinline__ int fresh_tid(int wave_s) { int l; asm volatile("v_mbcnt_lo_u32_b32 %0, -1, 0\n\tv_mbcnt_hi_u32_b32 %0, -1, %0" : "=v"(l)); return wave_s * 64 + l; }

namespace pg8 {
#define PG8_LAS __attribute__((address_space(3)))
typedef unsigned short bf16_t;
typedef short bf16x8 __attribute__((ext_vector_type(8)));
typedef float f32x4 __attribute__((ext_vector_type(4)));
typedef unsigned u32x4 __attribute__((ext_vector_type(4)));
constexpr int BM = 256, BK = 64, HALF = 128, HTB = HALF * BK * 2  , STAGE_BYTES = 8 * HTB, NXCD = 8, WGM = 8;

__host__ __device__ __forceinline__ int lds_byte(int r, int c) { const int st = (r >> 4) * 2 + (c >> 5), rr = r & 15, cc = c & 31, ob = rr * 64 + cc * 2; return st * 1024 + (ob ^ (((ob >> 9) & 1) << 5)); }
__host__ __device__ __forceinline__ void stage_rc(int b, int& R, int& C) { const int st = b / 1024, sb = b % 1024, swz = sb ^ (((sb >> 9) & 1) << 5); R = (st >> 1) * 16 + swz / 64; C = (st & 1) * 32 + (swz % 64) / 2; }
__host__ __device__ __forceinline__ int perm32(int rho) { const int n = rho >> 4, i = rho & 15; return 8 * (i >> 2) + 4 * n + (i & 3); }

struct Unit { int pm, pn; };
struct Gemm { const bf16_t* A; const bf16_t* Bt; int M, N, K; };

struct StaticOrder {
    int nM, nN, nwg, G, c;
    __host__ __device__ void init(int M, int N, int G_, int c_) { nM = M / BM; nN = N / BM; nwg = nM * nN; G = G_; c = c_; }
    __host__ __device__ bool next(int i, Unit& u) const {
        const long L = (long)i * G + c; if (L >= nwg) return false;
        int wgid = (int)L; { const int q = nwg / NXCD, r = nwg % NXCD, xcd = wgid % NXCD, off = wgid / NXCD; wgid = (xcd < r ? xcd * (q + 1) : r * (q + 1) + (xcd - r) * q) + off; }
        const int nig = WGM * nN, gid = wgid / nig, fm = gid * WGM, gsz = (nM - fm) < WGM ? (nM - fm) : WGM;
        u.pm = fm + ((wgid % nig) % gsz); u.pn = (wgid % nig) / gsz; return true;
    }
    __device__ __forceinline__ void a_ready(const Unit&) const {}
    __device__ __forceinline__ void done(const Unit&) const {}
};


__device__ __forceinline__ u32x4 pack8bf(const f32x4 a, const f32x4 b) { u32x4 w; w.x = cvtpk_s(a[0], a[1]); w.y = cvtpk_s(a[2], a[3]); w.z = cvtpk_s(b[0], b[1]); w.w = cvtpk_s(b[2], b[3]); return w; }
__device__ __forceinline__ f32x4 silu4(const f32x4 v) { return (f32x4){siluf_(v[0]), siluf_(v[1]), siluf_(v[2]), siluf_(v[3])}; }
__device__ __forceinline__ float logsigmoidf_(float x) { return fminf(x, 0.f) - __logf(1.0f + __expf(-fabsf(x))); }

struct EpiFoxIn {
    static constexpr bool PERM = true, AFTER_DRAIN = false;
    bf16_t *Q, *SZ; size_t qkv_stride; float* logf; const float* b_f; const float* gains; PG8_LAS float* xs;
    __device__ __forceinline__ void operator()(const f32x4 (&acc)[2][2][4][2], const Unit& u, int wr, int wc, int fr, int fq) const {
        const int sec = u.pn >> 3, row0 = u.pm * BM + wr * 64 + fr;
        if (sec < 2) {
            bf16_t* base = Q + (size_t)sec * qkv_stride;
#pragma unroll
            for (int ai = 0; ai < 2; ++ai)
#pragma unroll
                for (int m = 0; m < 4; ++m)
#pragma unroll
                    for (int bj = 0; bj < 2; ++bj) { const f32x4 a = acc[ai][bj][m][0], b = acc[ai][bj][m][1];
                        float s = (a[0] * a[0] + a[1] * a[1]) + (a[2] * a[2] + a[3] * a[3]) + (b[0] * b[0] + b[1] * b[1]) + (b[2] * b[2] + b[3] * b[3]);
                        s += __shfl_xor(s, 16); s += __shfl_xor(s, 32);
                        if (fq == 0) xs[(ai * HALF + wr * 64 + m * 16 + fr) * 8 + bj * 4 + wc] = s; }
            asm volatile("s_waitcnt lgkmcnt(0)" ::: "memory"); __builtin_amdgcn_s_barrier(); asm volatile("" ::: "memory");
            int go_ = wc * 32 + 8 * fq; asm volatile("" : "+v"(go_));
            const float* gp = gains + sec * 128 + go_; const f32x4 g0 = *(const f32x4*)gp, g1 = *(const f32x4*)(gp + 4);
#pragma unroll
            for (int ai = 0; ai < 2; ++ai)
#pragma unroll
                for (int m = 0; m < 4; ++m) { const int row = row0 + ai * HALF + m * 16, b = row >> 13, s = row & 8191;
#pragma unroll
                    for (int bj = 0; bj < 2; ++bj) { const int h = (u.pn & 7) * 2 + bj;
                        const f32x4 pp = *(const PG8_LAS f32x4*)(xs + (ai * HALF + wr * 64 + m * 16 + fr) * 8 + bj * 4);
                        const float r = rsqrtf(((pp[0] + pp[1]) + (pp[2] + pp[3])) * (1.f / 128.f) + 1e-6f);
                        *(u32x4*)(base + ((size_t)(b * 16 + h) * 8192 + s) * 128 + wc * 32 + 8 * fq) = pack8bf(acc[ai][bj][m][0] * r * g0, acc[ai][bj][m][1] * r * g1); }
                    asm volatile("" ::: "memory"); }
        } else if (sec == 2) {
            bf16_t* base = Q + (size_t)sec * qkv_stride;
#pragma unroll
            for (int ai = 0; ai < 2; ++ai)
#pragma unroll
                for (int m = 0; m < 4; ++m) { const int row = row0 + ai * HALF + m * 16, b = row >> 13, s = row & 8191;
#pragma unroll
                    for (int bj = 0; bj < 2; ++bj) { const int h = (u.pn & 7) * 2 + bj;
                        *(u32x4*)(base + ((size_t)(b * 16 + h) * 8192 + s) * 128 + wc * 32 + 8 * fq) = pack8bf(acc[ai][bj][m][0], acc[ai][bj][m][1]); }
                    asm volatile("" ::: "memory"); }
        } else if (sec == 3) {
#pragma unroll
            for (int ai = 0; ai < 2; ++ai)
#pragma unroll
                for (int m = 0; m < 4; ++m) { const int row = row0 + ai * HALF + m * 16;
#pragma unroll
                    for (int bj = 0; bj < 2; ++bj)
                        *(u32x4*)(SZ + (size_t)row * 2048 + (u.pn & 7) * 256 + bj * HALF + wc * 32 + 8 * fq) = pack8bf(silu4(acc[ai][bj][m][0]), silu4(acc[ai][bj][m][1]));
                    asm volatile("" ::: "memory"); }
        } else {
            if (wc == 0 && fq < 2) {
#pragma unroll
                for (int ai = 0; ai < 2; ++ai)
#pragma unroll
                    for (int m = 0; m < 4; ++m) { const int row = row0 + ai * HALF + m * 16, b = row >> 13, s = row & 8191;
#pragma unroll
                        for (int n = 0; n < 2; ++n)
#pragma unroll
                            for (int j = 0; j < 4; ++j) { const int h = 8 * fq + 4 * n + j;
                                logf[(size_t)(b * 16 + h) * 8192 + s] = logsigmoidf_(acc[ai][0][m][n][j] + b_f[h]); }
                        asm volatile("" ::: "memory"); }
            }
        }
    }
};
struct EpiOutSS {
    static constexpr bool PERM = true, AFTER_DRAIN = false;
    bf16_t* Y; float* ss;
    __device__ __forceinline__ void operator()(const f32x4 (&acc)[2][2][4][2], const Unit& u, int wr, int wc, int fr, int fq) const {
        const int row0 = u.pm * BM + wr * 64 + fr, col0 = u.pn * BM + wc * 32 + 8 * fq;
#pragma unroll
        for (int ai = 0; ai < 2; ++ai)
#pragma unroll
            for (int m = 0; m < 4; ++m) { const int row = row0 + ai * HALF + m * 16; float s = 0.f;
#pragma unroll
                for (int bj = 0; bj < 2; ++bj) { const f32x4 a = acc[ai][bj][m][0], b = acc[ai][bj][m][1];
                    s += (a[0] * a[0] + a[1] * a[1]) + (a[2] * a[2] + a[3] * a[3]) + (b[0] * b[0] + b[1] * b[1]) + (b[2] * b[2] + b[3] * b[3]);
                    *(u32x4*)(Y + (size_t)row * 2048 + col0 + bj * HALF) = pack8bf(a, b); }
                s += __shfl_xor(s, 16); s += __shfl_xor(s, 32);
                if (fq == 0) ss[(size_t)row * 32 + u.pn * 4 + wc] = s; asm volatile("" ::: "memory"); }
    }
};
struct EpiPlain {
    static constexpr bool PERM = true, AFTER_DRAIN = false;
    bf16_t* Y;
    __device__ __forceinline__ void operator()(const f32x4 (&acc)[2][2][4][2], const Unit& u, int wr, int wc, int fr, int fq) const {
        const int row0 = u.pm * BM + wr * 64 + fr, col0 = u.pn * BM + wc * 32 + 8 * fq;
#pragma unroll
        for (int ai = 0; ai < 2; ++ai)
#pragma unroll
            for (int m = 0; m < 4; ++m) { const int row = row0 + ai * HALF + m * 16;
#pragma unroll
                for (int bj = 0; bj < 2; ++bj) *(u32x4*)(Y + (size_t)row * 2048 + col0 + bj * HALF) = pack8bf(acc[ai][bj][m][0], acc[ai][bj][m][1]); }
    }
};
struct EpiPG {
    static constexpr bool PERM = true, AFTER_DRAIN = false;
    const float* R; float* H; const bf16_t* Y; const float* rstdY; const float* gpost; const bf16_t* PE; bf16_t* HB; float* ss;
    __device__ __forceinline__ void operator()(const f32x4 (&acc)[2][2][4][2], const Unit& u, int wr, int wc, int fr, int fq) const {
        const int row0 = u.pm * BM + wr * 64 + fr, col0 = u.pn * BM + wc * 32 + 8 * fq;
        float rs[2][4]; f32x4 g[2][2];
#pragma unroll
        for (int ai = 0; ai < 2; ++ai)
#pragma unroll
            for (int m = 0; m < 4; ++m) rs[ai][m] = rstdY[row0 + ai * HALF + m * 16];
#pragma unroll
        for (int bj = 0; bj < 2; ++bj) { g[bj][0] = *(const f32x4*)(gpost + col0 + bj * HALF); g[bj][1] = *(const f32x4*)(gpost + col0 + bj * HALF + 4); }
#pragma unroll
        for (int ai = 0; ai < 2; ++ai)
#pragma unroll
            for (int m = 0; m < 4; ++m) { const int row = row0 + ai * HALF + m * 16; const float r = rs[ai][m]; float s = 0.f;
#pragma unroll
                for (int bj = 0; bj < 2; ++bj) { const size_t idx = (size_t)row * 2048 + col0 + bj * HALF;
                    const f32x4 r0 = *(const f32x4*)(R + idx), r1 = *(const f32x4*)(R + idx + 4); const u32x4 yv = *(const u32x4*)(Y + idx), pe = *(const u32x4*)(PE + idx);
                    const f32x4 y0 = {bf_lo(yv.x), bf_hi(yv.x), bf_lo(yv.y), bf_hi(yv.y)}, y1 = {bf_lo(yv.z), bf_hi(yv.z), bf_lo(yv.w), bf_hi(yv.w)};
                    const f32x4 h0 = r0 + y0 * r * g[bj][0], h1 = r1 + y1 * r * g[bj][1];
                    const f32x4 a = acc[ai][bj][m][0], b = acc[ai][bj][m][1];
                    f32x4 o0, o1;
                    o0[0] = h0[0] + bf_lo(pe.x) * sigmoidf_(a[0]); o0[1] = h0[1] + bf_hi(pe.x) * sigmoidf_(a[1]); o0[2] = h0[2] + bf_lo(pe.y) * sigmoidf_(a[2]); o0[3] = h0[3] + bf_hi(pe.y) * sigmoidf_(a[3]);
                    o1[0] = h1[0] + bf_lo(pe.z) * sigmoidf_(b[0]); o1[1] = h1[1] + bf_hi(pe.z) * sigmoidf_(b[1]); o1[2] = h1[2] + bf_lo(pe.w) * sigmoidf_(b[2]); o1[3] = h1[3] + bf_hi(pe.w) * sigmoidf_(b[3]);
                    *(f32x4*)(H + idx) = o0; *(f32x4*)(H + idx + 4) = o1;
                    if (HB) { *(u32x4*)(HB + idx) = pack8bf(o0, o1);
                        s += (o0[0] * o0[0] + o0[1] * o0[1]) + (o0[2] * o0[2] + o0[3] * o0[3]) + (o1[0] * o1[0] + o1[1] * o1[1]) + (o1[2] * o1[2] + o1[3] * o1[3]); } }
                if (HB) { s += __shfl_xor(s, 16); s += __shfl_xor(s, 32); if (fq == 0) ss[(size_t)row * 32 + u.pn * 4 + wc] = s; }
                asm volatile("" ::: "memory"); }
    }
};
struct EpiHgIn {
    static constexpr bool PERM = true, AFTER_DRAIN = false;
    bf16_t *SQ; size_t buf_stride; bf16_t* G; const float* rstd; const float* lbl;
    __device__ __forceinline__ void operator()(const f32x4 (&acc)[2][2][4][2], const Unit& u, int wr, int wc, int fr, int fq) const {
        const int sec = u.pn >> 3, row0 = u.pm * BM + wr * 64 + fr, col0 = (u.pn & 7) * BM + wc * 32 + 8 * fq;
        float rs[2][4];
#pragma unroll
        for (int ai = 0; ai < 2; ++ai)
#pragma unroll
            for (int m = 0; m < 4; ++m) rs[ai][m] = rstd[row0 + ai * HALF + m * 16];
        if (sec == 1) {
            float lb[2][8];
#pragma unroll
            for (int bj = 0; bj < 2; ++bj)
#pragma unroll
                for (int j = 0; j < 8; ++j) { const int c = col0 + bj * HALF + j; lb[bj][j] = 1.0f / (1.0f + __expf(lbl[c] - lbl[2048 + c])); }
#pragma unroll
            for (int ai = 0; ai < 2; ++ai)
#pragma unroll
                for (int m = 0; m < 4; ++m) { const int row = row0 + ai * HALF + m * 16; const float r = rs[ai][m];
#pragma unroll
                    for (int bj = 0; bj < 2; ++bj) { f32x4 o0, o1;
#pragma unroll
                        for (int j = 0; j < 4; ++j) { o0[j] = lb[bj][j] + (1.f - lb[bj][j]) * sigmoidf_(acc[ai][bj][m][0][j] * r); o1[j] = lb[bj][4 + j] + (1.f - lb[bj][4 + j]) * sigmoidf_(acc[ai][bj][m][1][j] * r); }
                        typedef _Float16 f16x8_t __attribute__((ext_vector_type(8)));
                        const f16x8_t hv = {(_Float16)o0[0], (_Float16)o0[1], (_Float16)o0[2], (_Float16)o0[3], (_Float16)o1[0], (_Float16)o1[1], (_Float16)o1[2], (_Float16)o1[3]};
                        *(f16x8_t*)(G + (size_t)row * 2048 + col0 + bj * HALF) = hv; }
                    asm volatile("" ::: "memory"); }
        } else {
            bf16_t* base = SQ + (size_t)(sec ? sec + 1 : 0) * buf_stride;
#pragma unroll
            for (int ai = 0; ai < 2; ++ai)
#pragma unroll
                for (int m = 0; m < 4; ++m) { const int row = row0 + ai * HALF + m * 16; const float r = rs[ai][m];
#pragma unroll
                    for (int bj = 0; bj < 2; ++bj) { f32x4 a = acc[ai][bj][m][0] * r, b = acc[ai][bj][m][1] * r;
                        if (sec != 2) { a = silu4(a); b = silu4(b); }
                        *(u32x4*)(base + (size_t)row * 2048 + col0 + bj * HALF) = pack8bf(a, b); }
                    asm volatile("" ::: "memory"); }
        }
    }
};

template <class Epi, class Sched, bool ALIGN_EPI = false, bool SP2 = false>
__device__ __forceinline__ void gemm_phase(PG8_LAS unsigned char* lds, const Gemm g, const Sched& S, const Epi& E, int wave_s) {
    const int tid = fresh_tid(wave_s), wid = __builtin_amdgcn_readfirstlane(tid >> 6), lane = tid & 63, wr = wid >> 2, wc = wid & 3, fr = lane & 15, fq = lane >> 4;
    const int K = g.K, nt = K / BK;
    unsigned voffA[2], voffB[2];
#pragma unroll
    for (int i = 0; i < 2; ++i) { int R, C; stage_rc(tid * 16 + i * 8192, R, C); const int Rb = Epi::PERM ? ((R & ~31) + perm32(R & 31)) : R;
        voffA[i] = (unsigned)(R * K + C) * 2u; voffB[i] = (unsigned)(Rb * K + C) * 2u; }
    const size_t kstep = (size_t)(BK * 2);
    const size_t hstep = (size_t)HALF * K * 2;
    const size_t tstep = 2 * hstep;
    const unsigned ldsw = (unsigned)wid * 1024u;
    const int aoff = lds_byte(wr * 64 + fr, fq * 8), boff = lds_byte(wc * 32 + fr, fq * 8);
#define PG8_SA(b, h) (((b) * 2 + (h)) * HTB)
#define PG8_SB(b, h) ((4 + (b) * 2 + (h)) * HTB)
#define PG8_STAGE(bufoff, gbase, voff) do { _Pragma("unroll") for (int _i = 0; _i < 2; ++_i) \
        __builtin_amdgcn_global_load_lds((const unsigned*)((const char*)(gbase) + (voff)[_i]), (PG8_LAS unsigned*)(lds + (bufoff) + ldsw + _i * 8192), 16, 0, 0); } while (0)
#define PG8_LDA(dst, b, h) do { _Pragma("unroll") for (int m = 0; m < 4; ++m) _Pragma("unroll") for (int k = 0; k < 2; ++k) dst[m][k] = *(const PG8_LAS bf16x8*)(lds + PG8_SA(b, h) + aoff + m * 2048 + k * 1024); } while (0)
#define PG8_LDB(dst, b, h) do { _Pragma("unroll") for (int n = 0; n < 2; ++n) _Pragma("unroll") for (int k = 0; k < 2; ++k) dst[n][k] = *(const PG8_LAS bf16x8*)(lds + PG8_SB(b, h) + boff + n * 2048 + k * 1024); } while (0)
#define PG8_MMA(ai, bj, At, Bt) do { __builtin_amdgcn_s_setprio(1); _Pragma("unroll") for (int m = 0; m < 4; ++m) _Pragma("unroll") for (int n = 0; n < 2; ++n) _Pragma("unroll") for (int k = 0; k < 2; ++k) \
        acc[ai][bj][m][n] = __builtin_amdgcn_mfma_f32_16x16x32_bf16(Bt[n][k], At[m][k], acc[ai][bj][m][n], 0, 0, 0); __builtin_amdgcn_s_setprio(0); } while (0)
#define PG8_WAIT_V(n) asm volatile("s_waitcnt vmcnt(" #n ")" ::: "memory")
#define PG8_WAIT_L(n) asm volatile("s_waitcnt lgkmcnt(" #n ")" ::: "memory")
#define PG8_BAR __builtin_amdgcn_s_barrier()
#define PG8_SCHED __builtin_amdgcn_sched_barrier(0)
    Unit cur, nxt; int ui = 0;
    if (!S.next(0, cur)) return;
    f32x4 acc[2][2][4][2];
#pragma unroll
    for (int a = 0; a < 2; ++a)
#pragma unroll
        for (int b = 0; b < 2; ++b)
#pragma unroll
            for (int m = 0; m < 4; ++m)
#pragma unroll
                for (int n = 0; n < 2; ++n) acc[a][b][m][n] = (f32x4){0.f, 0.f, 0.f, 0.f};
    bf16x8 At[4][2], B0[2][2], B1[2][2];
    const char* cA = (const char*)g.A + (size_t)cur.pm * tstep; const char* cB = (const char*)g.Bt + (size_t)cur.pn * tstep;
    S.a_ready(cur);
    if constexpr (SP2) {
        PG8_STAGE(PG8_SB(0, 0), cB, voffB); PG8_STAGE(PG8_SB(0, 1), cB + hstep, voffB); PG8_STAGE(PG8_SA(0, 0), cA, voffA); PG8_STAGE(PG8_SA(0, 1), cA + hstep, voffA);
        if (wr == 1) PG8_BAR;
        PG8_WAIT_V(2); PG8_BAR;
        PG8_STAGE(PG8_SB(1, 0), cB + kstep, voffB); PG8_STAGE(PG8_SA(1, 0), cA + kstep, voffA); PG8_STAGE(PG8_SB(1, 1), cB + hstep + kstep, voffB);
        PG8_WAIT_V(6); PG8_BAR;
    } else {
        PG8_STAGE(PG8_SB(0, 0), cB, voffB); PG8_STAGE(PG8_SA(0, 0), cA, voffA); PG8_STAGE(PG8_SB(0, 1), cB + hstep, voffB); PG8_STAGE(PG8_SA(0, 1), cA + hstep, voffA);
        if (wr == 1) PG8_BAR;
        PG8_WAIT_V(4); PG8_BAR;
        PG8_STAGE(PG8_SB(1, 0), cB + kstep, voffB); PG8_STAGE(PG8_SA(1, 0), cA + kstep, voffA); PG8_STAGE(PG8_SB(1, 1), cB + hstep + kstep, voffB);
        PG8_WAIT_V(6); PG8_BAR;
    }
    for (;;) {
        const bool has_next = S.next(ui + 1, nxt);
        const char* nA = has_next ? (const char*)g.A + (size_t)nxt.pm * tstep : cA; const char* nB = has_next ? (const char*)g.Bt + (size_t)nxt.pn * tstep : cB;
        for (int t = 0; t < nt; t += 2) {
            const bool last = (t == nt - 2);
            const char* a1 = cA + (size_t)(t + 1) * kstep;
            const char* a2 = last ? nA : cA + (size_t)(t + 2) * kstep; const char* b2 = last ? nB : cB + (size_t)(t + 2) * kstep;
            const char* a3 = a2 + kstep; const char* b3 = b2 + kstep;
            if (last && has_next) S.a_ready(nxt);
            if constexpr (SP2) {
            PG8_LDB(B0, 0, 0); PG8_LDB(B1, 0, 1); PG8_SCHED; PG8_LDA(At, 0, 0); PG8_STAGE(PG8_SA(1, 1), a1 + hstep, voffA);
            PG8_WAIT_V(8); PG8_WAIT_L(0); PG8_BAR; PG8_MMA(0, 0, At, B0); PG8_MMA(0, 1, At, B1); PG8_BAR; PG8_SCHED;
            PG8_LDA(At, 0, 1); PG8_STAGE(PG8_SB(0, 0), b2, voffB); PG8_STAGE(PG8_SB(0, 1), b2 + hstep, voffB); PG8_STAGE(PG8_SA(0, 0), a2, voffA);
            PG8_WAIT_V(8); PG8_WAIT_L(0); PG8_BAR; PG8_MMA(1, 0, At, B0); PG8_MMA(1, 1, At, B1); PG8_BAR; PG8_SCHED;
            PG8_LDB(B0, 1, 0); PG8_LDB(B1, 1, 1); PG8_SCHED; PG8_LDA(At, 1, 0); PG8_STAGE(PG8_SA(0, 1), a2 + hstep, voffA);
            PG8_WAIT_V(8); PG8_WAIT_L(0); PG8_BAR; PG8_MMA(0, 0, At, B0); PG8_MMA(0, 1, At, B1); PG8_BAR; PG8_SCHED;
            PG8_LDA(At, 1, 1); PG8_STAGE(PG8_SB(1, 0), b3, voffB); PG8_STAGE(PG8_SB(1, 1), b3 + hstep, voffB); PG8_STAGE(PG8_SA(1, 0), a3, voffA);
            PG8_WAIT_V(8); PG8_WAIT_L(0); PG8_BAR; PG8_MMA(1, 0, At, B0); PG8_MMA(1, 1, At, B1); PG8_BAR; PG8_SCHED;
            } else {
            PG8_LDB(B0, 0, 0); PG8_SCHED; PG8_LDA(At, 0, 0); PG8_STAGE(PG8_SA(1, 1), a1 + hstep, voffA);
            PG8_WAIT_L(8); PG8_BAR; PG8_WAIT_L(0); PG8_MMA(0, 0, At, B0); PG8_BAR; PG8_SCHED;
            PG8_LDB(B1, 0, 1); PG8_STAGE(PG8_SB(0, 0), b2, voffB);
            PG8_BAR; PG8_WAIT_L(0); PG8_MMA(0, 1, At, B1); PG8_BAR;
            PG8_LDA(At, 0, 1); PG8_STAGE(PG8_SA(0, 0), a2, voffA);
            PG8_BAR; PG8_WAIT_L(0); PG8_MMA(1, 0, At, B0); PG8_BAR; PG8_SCHED;
            PG8_STAGE(PG8_SB(0, 1), b2 + hstep, voffB);
            PG8_WAIT_V(6); PG8_BAR; PG8_MMA(1, 1, At, B1); PG8_BAR;
            PG8_LDB(B0, 1, 0); PG8_SCHED; PG8_LDA(At, 1, 0); PG8_STAGE(PG8_SA(0, 1), a2 + hstep, voffA);
            PG8_WAIT_L(8); PG8_BAR; PG8_WAIT_L(0); PG8_MMA(0, 0, At, B0); PG8_BAR; PG8_SCHED;
            PG8_LDB(B1, 1, 1); PG8_STAGE(PG8_SB(1, 0), b3, voffB);
            PG8_BAR; PG8_WAIT_L(0); PG8_MMA(0, 1, At, B1); PG8_BAR;
            PG8_LDA(At, 1, 1); PG8_STAGE(PG8_SA(1, 0), a3, voffA);
            PG8_BAR; PG8_WAIT_L(0); PG8_MMA(1, 0, At, B0); PG8_BAR; PG8_SCHED;
            PG8_STAGE(PG8_SB(1, 1), b3 + hstep, voffB);
            PG8_WAIT_V(6); PG8_BAR; PG8_MMA(1, 1, At, B1); PG8_BAR;
            }
        }
        if constexpr (ALIGN_EPI) { if (wr == 0) PG8_BAR; }
        if constexpr (!Epi::AFTER_DRAIN) { E(acc, cur, wr, wc, fr, fq); S.done(cur); }
        if (!has_next) break;
#pragma unroll
        for (int a = 0; a < 2; ++a)
#pragma unroll
            for (int b = 0; b < 2; ++b)
#pragma unroll
                for (int m = 0; m < 4; ++m)
#pragma unroll
                    for (int n = 0; n < 2; ++n) acc[a][b][m][n] = (f32x4){0.f, 0.f, 0.f, 0.f};
        cur = nxt; cA = nA; cB = nB; ++ui;
        if constexpr (ALIGN_EPI) { if (wr == 1) PG8_BAR; }
    }
    PG8_WAIT_V(0);
    if constexpr (!ALIGN_EPI) { if (wr == 0) PG8_BAR; }
    PG8_BAR;
    if constexpr (Epi::AFTER_DRAIN) { E.fused(acc, cur, wr, wc, fr, fq, lds, wid, lane); S.done(cur); }
#undef PG8_SA
#undef PG8_SB
#undef PG8_STAGE
#undef PG8_LDA
#undef PG8_LDB
#undef PG8_MMA
#undef PG8_WAIT_V
#undef PG8_WAIT_L
#undef PG8_BAR
#undef PG8_SCHED
}
}
namespace att {
enum { ORDER_NATURAL = 0, ORDER_REVERSED = 1, ORDER_PAIRED = 2, ORDER_XCD = 4 };
constexpr int D = 128, OSTR = 2048, BIAS_OFF = 69632;
constexpr float THR = 8.f;
constexpr bool WSKIP = false;
constexpr float SCALE = 0.08838834764831845f;
constexpr int NW = 8, QBLK = 32, KVBLK = 64, QB = NW * QBLK;
constexpr int SHM_V = KVBLK * D * 2, SHM_K = KVBLK * D * 2;
constexpr int LDS_BYTES = 2 * SHM_V + 2 * SHM_K + NW * 64 * 4;

using bf16 = __hip_bfloat16;
typedef short bf16x8 __attribute__((ext_vector_type(8)));
typedef short s16x4 __attribute__((ext_vector_type(4)));
typedef float f32x16 __attribute__((ext_vector_type(16)));
typedef float f32x4 __attribute__((ext_vector_type(4)));
typedef unsigned u32x4 __attribute__((ext_vector_type(4)));
template <class A, class Bt> struct same_t { static constexpr bool v = false; };
template <class A> struct same_t<A, A> { static constexpr bool v = true; };

#define KSWZ(row, colB) ((row) * 256 + ((colB) ^ (((row) & 7) << 4)))
#define SBAR() __builtin_amdgcn_sched_barrier(0)
__device__ __forceinline__ int v_st(int k, int c) { const int kk = (k & ~0xC) | ((k & 4) << 1) | ((k & 8) >> 1); return ((kk >> 3) * 4 + (c >> 5)) * 512 + ((kk & 7) * 32 + (c & 31)) * 2; }
__device__ __forceinline__ int v_rd_base(int lane) { return ((lane & 3) << 3) | (((lane >> 2) & 3) << 6) | (((lane >> 4) & 1) << 5) | (((lane >> 5) & 1) << 8); }
constexpr int v_rd_off(int d0, int ks, int half) { return d0 * 512 + ks * 4096 + half * 2048; }
__device__ __forceinline__ int crow(int r, int hi) { return (r & 3) + 8 * (r >> 2) + 4 * hi; }
__device__ __forceinline__ unsigned cvtpk(float lo, float hi) {
    unsigned r; asm volatile("v_cvt_pk_bf16_f32 %0, %1, %2" : "=v"(r) : "v"(lo), "v"(hi)); return r;
}
__device__ __forceinline__ bf16x8 pack8(f32x4 a, f32x4 b) {
    u32x4 w = {cvtpk(a[0], a[1]), cvtpk(a[2], a[3]), cvtpk(b[0], b[1]), cvtpk(b[2], b[3])};
    return *reinterpret_cast<bf16x8*>(&w);
}
template <class T> __device__ __forceinline__ bf16x8 load8(const T* p) {
    if constexpr (same_t<T, float>::v) { return pack8(*(const f32x4*)p, *(const f32x4*)(p + 4)); }
    else { return *reinterpret_cast<const bf16x8*>(p); }
}
__device__ __forceinline__ void mask_tile(f32x16& p0, f32x16& p1, int dq, unsigned W) {
    const float NEG = -__builtin_inff();
#pragma unroll
    for (int r = 0; r < 16; ++r) {
        const int c = (r & 3) + 8 * (r >> 2);
        if ((unsigned)(dq - c) >= W) p0[r] = NEG;
        if ((unsigned)(dq - c - 32) >= W) p1[r] = NEG;
    }
}
__device__ __forceinline__ void partialSM(f32x16& p0, f32x16& p1, float& m_reg, float& mn, float& alpha) {
    float pmax = p0[0]; for (int r = 1; r < 16; ++r) pmax = fmaxf(pmax, p0[r]); for (int r = 0; r < 16; ++r) pmax = fmaxf(pmax, p1[r]);
    { auto rr = __builtin_amdgcn_permlane32_swap(__float_as_uint(pmax), __float_as_uint(pmax), false, false);
      pmax = fmaxf(__uint_as_float(rr[0]), __uint_as_float(rr[1])); }
    constexpr float C2 = 1.4426950408889634f * SCALE;
    if (__builtin_expect(__all((pmax - m_reg) * SCALE <= THR), 1)) { mn = m_reg; alpha = 1.f; }
    else { mn = fmaxf(m_reg, pmax); alpha = __builtin_amdgcn_exp2f((m_reg - mn) * C2); m_reg = mn; }
    const float mnL = -mn * C2;
    for (int r = 0; r < 16; ++r) p0[r] = fmaf(p0[r], C2, mnL); for (int r = 0; r < 16; ++r) p1[r] = fmaf(p1[r], C2, mnL);
    for (int r = 0; r < 16; ++r) p0[r] = __builtin_amdgcn_exp2f(p0[r]);
}
__device__ __forceinline__ void finishSM(f32x16& p0, f32x16& p1, float alpha, float& l_reg, bf16x8& pa0, bf16x8& pa1, bf16x8& pa2, bf16x8& pa3) {
    for (int r = 0; r < 16; ++r) p1[r] = __builtin_amdgcn_exp2f(p1[r]);
    float ps = 0; for (int r = 0; r < 16; ++r) ps += p0[r]; for (int r = 0; r < 16; ++r) ps += p1[r];
    { auto rr = __builtin_amdgcn_permlane32_swap(__float_as_uint(ps), __float_as_uint(ps), false, false);
      ps = __uint_as_float(rr[0]) + __uint_as_float(rr[1]); }
    l_reg = l_reg * alpha + ps;
#define PK4(P, B_, OUT) do { unsigned a0 = cvtpk(P[B_+0], P[B_+1]), a1 = cvtpk(P[B_+2], P[B_+3]);                          \
        unsigned b0 = cvtpk(P[B_+4], P[B_+5]), b1 = cvtpk(P[B_+6], P[B_+7]);                                             \
        auto r0 = __builtin_amdgcn_permlane32_swap(a0, b0, false, false); auto r1 = __builtin_amdgcn_permlane32_swap(a1, b1, false, false); \
        u32x4 w = {r0[0], r1[0], r0[1], r1[1]}; OUT = *reinterpret_cast<bf16x8*>(&w); } while (0)
    PK4(p0, 0, pa0); PK4(p0, 8, pa1); PK4(p1, 0, pa2); PK4(p1, 8, pa3);
#undef PK4
}
template <int KB, bool SK>
__device__ __forceinline__ void qkt(f32x16& p0, f32x16& p1, const char* K_lds, int r32, int hi, const bf16x8* qr, bool act, const char* bl) {
    if (SK && !act) { const float NEG = -__builtin_inff();
#pragma unroll
        for (int r = 0; r < 16; ++r) { p0[r] = NEG; p1[r] = NEG; } return; }
    { const f32x4 c0 = *(const f32x4*)(bl), c1 = *(const f32x4*)(bl + 32), c2 = *(const f32x4*)(bl + 64), c3 = *(const f32x4*)(bl + 96);
      const f32x4 e0 = *(const f32x4*)(bl + 128), e1 = *(const f32x4*)(bl + 160), e2 = *(const f32x4*)(bl + 192), e3 = *(const f32x4*)(bl + 224);
      p0 = (f32x16){c0[0], c0[1], c0[2], c0[3], c1[0], c1[1], c1[2], c1[3], c2[0], c2[1], c2[2], c2[3], c3[0], c3[1], c3[2], c3[3]};
      p1 = (f32x16){e0[0], e0[1], e0[2], e0[3], e1[0], e1[1], e1[2], e1[3], e2[0], e2[1], e2[2], e2[3], e3[0], e3[1], e3[2], e3[3]}; }
    const char* kb[4];
#pragma unroll
    for (int dd = 0; dd < 4; ++dd) kb[dd] = K_lds + KB * SHM_K + KSWZ(r32, (dd * 16 + hi * 8) * 2);
#pragma unroll
    for (int d0 = 0; d0 < 8; ++d0) { const char* a = kb[d0 & 3] + (d0 >> 2) * 128;
        bf16x8 b0 = *reinterpret_cast<const bf16x8*>(a);
        bf16x8 b1 = *reinterpret_cast<const bf16x8*>(a + 32 * 256);
        p0 = __builtin_amdgcn_mfma_f32_32x32x16_bf16(b0, qr[d0], p0, 0, 0, 0);
        p1 = __builtin_amdgcn_mfma_f32_32x32x16_bf16(b1, qr[d0], p1, 0, 0, 0); }
}
template <int VB, bool SK>
__device__ __forceinline__ void pv_tile(f32x16* o, int vb0, bf16x8 pa0, bf16x8 pa1, bf16x8 pa2, bf16x8 pa3, bool act) {
    if (SK && !act) return;
#define TRRD(dst, off) asm volatile("ds_read_b64_tr_b16 %0, %1 offset:%2" : "=&v"(dst) : "v"(vb0), "i"(off) : "memory")
#define PV_D0(d0) do { s16x4 l0, l1, l2, l3, h0, h1, h2, h3; constexpr int b_ = VB * SHM_V + v_rd_off(d0, 0, 0);     \
        TRRD(l0, b_); TRRD(h0, b_ + 2048); TRRD(l1, b_ + 4096); TRRD(h1, b_ + 6144); TRRD(l2, b_ + 8192); TRRD(h2, b_ + 10240); TRRD(l3, b_ + 12288); TRRD(h3, b_ + 14336); \
        asm volatile("s_waitcnt lgkmcnt(0)" ::: "memory"); SBAR();                 \
        o[d0] = __builtin_amdgcn_mfma_f32_32x32x16_bf16(pa0, (bf16x8){l0[0], l0[1], l0[2], l0[3], h0[0], h0[1], h0[2], h0[3]}, o[d0], 0, 0, 0);   \
        o[d0] = __builtin_amdgcn_mfma_f32_32x32x16_bf16(pa1, (bf16x8){l1[0], l1[1], l1[2], l1[3], h1[0], h1[1], h1[2], h1[3]}, o[d0], 0, 0, 0);   \
        o[d0] = __builtin_amdgcn_mfma_f32_32x32x16_bf16(pa2, (bf16x8){l2[0], l2[1], l2[2], l2[3], h2[0], h2[1], h2[2], h2[3]}, o[d0], 0, 0, 0);   \
        o[d0] = __builtin_amdgcn_mfma_f32_32x32x16_bf16(pa3, (bf16x8){l3[0], l3[1], l3[2], l3[3], h3[0], h3[1], h3[2], h3[3]}, o[d0], 0, 0, 0); } while (0)
    PV_D0(0); PV_D0(1); PV_D0(2); PV_D0(3);
#undef PV_D0
#undef TRRD
}

template <class TIn, class TOut> struct BlockRef { const TIn* Q; const TIn* K; const TIn* V; TOut* O; const TOut* Z; const float* C; int P0; };
template <class TIn> struct Seam {
    bf16x8 qr[8];
    bf16x8 st_v0, st_v1, st_k0, st_k1; f32x4 sf0, sf1, sf2, sf3;
    f32x4 tq[16];
};
__device__ __forceinline__ int swa_jlo(int P0, int W) { const int lowk = P0 - W + 1; return lowk > 0 ? lowk / KVBLK : 0; }
#define ROW(p, k0, rr) ((p) + (size_t)((k0) + (rr)) * D + sc)
#define VMW() asm volatile("s_waitcnt vmcnt(0)" ::: "memory")
#define VMWN(n) asm volatile("s_waitcnt vmcnt(%0)" :: "i"(n) : "memory")
#define SLOAD_H(Kp, Vp, k0) do { S.st_v0 = load8<TIn>(ROW(Vp, k0, sr)); S.st_v1 = load8<TIn>(ROW(Vp, k0, 32 + sr));              \
                         S.st_k0 = load8<TIn>(ROW(Kp, k0, sr)); S.st_k1 = load8<TIn>(ROW(Kp, k0, 32 + sr)); } while (0)
#define SWRITE_HK(bf) do { *(bf16x8*)(K_lds + (bf) * SHM_K + kws) = S.st_k0; *(bf16x8*)(K_lds + (bf) * SHM_K + kws + 32 * 256) = S.st_k1; } while (0)
#define SWRITE_HV(bf) do { *(bf16x8*)(V_lds + (bf) * SHM_V + vst0) = S.st_v0; *(bf16x8*)(V_lds + (bf) * SHM_V + vst1) = S.st_v1; } while (0)
#define SWRITE_H(bf) do { SWRITE_HV(bf); SWRITE_HK(bf); } while (0)
#define SLOAD_F(p, k0) do { S.sf0 = *(const f32x4*)ROW(p, k0, sr); S.sf1 = *(const f32x4*)(ROW(p, k0, sr) + 4);                \
                            S.sf2 = *(const f32x4*)ROW(p, k0, 32 + sr); S.sf3 = *(const f32x4*)(ROW(p, k0, 32 + sr) + 4); } while (0)
#define SWRITE_KF(bf) do { *(bf16x8*)(K_lds + (bf) * SHM_K + kws) = pack8(S.sf0, S.sf1); *(bf16x8*)(K_lds + (bf) * SHM_K + kws + 32 * 256) = pack8(S.sf2, S.sf3); } while (0)
#define SWRITE_VF(bf) do { *(bf16x8*)(V_lds + (bf) * SHM_V + vst0) = pack8(S.sf0, S.sf1); *(bf16x8*)(V_lds + (bf) * SHM_V + vst1) = pack8(S.sf2, S.sf3); } while (0)
template <class TIn, class TOut>
__device__ __forceinline__ void causal_swa_prime(const BlockRef<TIn, TOut>& cur, int W, char* lds, Seam<TIn>& S, int wave_s) {
    constexpr bool F32 = same_t<TIn, float>::v;
    const int tid = fresh_tid(wave_s), wid = __builtin_amdgcn_readfirstlane(tid >> 6), lane = tid & 63, r32 = lane & 31, hi = lane >> 5;
    const int sr = tid >> 4, sc = (tid & 15) * 8, kws = KSWZ(sr, sc * 2); char* K_lds = lds + 2 * SHM_V;
    const int kb0 = cur.P0 + QB - KVBLK;
    for (int d0 = 0; d0 < 8; ++d0) S.qr[d0] = load8<TIn>(cur.Q + (size_t)(wid * QBLK + r32) * D + d0 * 16 + hi * 8);
    if constexpr (F32) { SLOAD_F((const float*)cur.K, kb0); VMW(); SWRITE_KF(0); SBAR(); SLOAD_F((const float*)cur.V, kb0); }
    else { SLOAD_H(cur.K, cur.V, kb0); VMW(); SWRITE_HK(0); }
    __syncthreads();
}
template <class TIn, class TOut>
__device__ __forceinline__ void causal_swa_block(const BlockRef<TIn, TOut>& cur, const BlockRef<TIn, TOut>& nxt, int skv, int W, char* lds, Seam<TIn>& S, float TH, float TH2, int wave_s) {
    constexpr bool F32 = same_t<TIn, float>::v;
    const int tid = fresh_tid(wave_s), wid = __builtin_amdgcn_readfirstlane(tid >> 6), lane = tid & 63, r32 = lane & 31, hi = lane >> 5;
    int j_lo;
    int tq_ = tid; asm volatile("" : "+v"(tq_));
    { const int ntb = cur.P0 / KVBLK; const float ref = cur.C[cur.P0]; const int t0 = tq_ & 63, t1 = (tq_ & 63) + 64;
      const float v0 = t0 < ntb ? cur.C[t0 * KVBLK + KVBLK - 1] : ref, v1 = t1 < ntb ? cur.C[t1 * KVBLK + KVBLK - 1] : ref;
      j_lo = __builtin_amdgcn_readfirstlane((int)(__popcll(__ballot(ref - v0 > TH)) + __popcll(__ballot(ref - v1 > TH)))); }
    int j_hi = (cur.P0 + QB - 1) / KVBLK + 1; if (j_hi > skv / KVBLK) j_hi = skv / KVBLK;
    int NT = j_hi - j_lo;
    const int kbn = nxt.P0 + QB - KVBLK;
    const int qlo = cur.P0 + wid * QBLK, qm = qlo + r32 - 4 * hi;
    char* V_lds = lds; char* K_lds = lds + 2 * SHM_V;
    float* ws = (float*)(lds + 2 * SHM_V + 2 * SHM_K) + wid * 64; float* li_l = ws, * al_l = ws + 32;
    float m_reg = -1e30f, l_reg = 0; f32x16 o[4] = {};
    const int sr = tid >> 4, sc = (tid & 15) * 8, vst0 = v_st(sr, sc), vst1 = v_st(32 + sr, sc), kws = KSWZ(sr, sc * 2);
    const int vb0 = (int)(uintptr_t)V_lds + v_rd_base(lane);
    const TIn* Kh = cur.K; const TIn* Vh = cur.V;
    const char* bias0 = lds + BIAS_OFF + 16 * hi;
    { const int n4 = (cur.P0 + QB) >> 2; f32x4* bdst = (f32x4*)(lds + BIAS_OFF); const f32x4* bsrc = (const f32x4*)cur.C;
      for (int i = j_lo * (KVBLK / 4) + tq_; i < n4; i += 64 * NW) bdst[i] = bsrc[i];
      __syncthreads(); }
#define BIASP(t) (bias0 + KBASE(t) * 4)
#define RESC(a) do { if (__any((a) < 1.f)) { if (hi == 0) al_l[r32] = (a); asm volatile("s_waitcnt lgkmcnt(0)" ::: "memory");              \
                     for (int d_ = 0; d_ < 4; ++d_) for (int r = 0; r < 16; ++r) o[d_][r] *= al_l[crow(r, hi)]; } } while (0)
#define KBASE(t) ((j_hi - 1 - (t)) * KVBLK)
#define ACT(t) (KBASE(t) <= qlo + QBLK - 1 && KBASE(t) + KVBLK - 1 >= qlo - W + 1)
#define MASKT(P0_, P1_, t) do { const int kb_ = KBASE(t); if ((!SK || ACT(t)) && (kb_ + KVBLK - 1 > qlo || kb_ <= qlo + QBLK - 1 - W)) mask_tile(P0_, P1_, qm - kb_, (unsigned)W); } while (0)
    constexpr int NQL = F32 ? 16 : 8;
    constexpr bool SK = WSKIP && !F32;
#define SEAM_K0() do { VMWN(NQL); if constexpr (F32) { SWRITE_KF(0); SBAR(); SLOAD_F((const float*)nxt.V, kbn); } else { SWRITE_HK(0); } SBAR(); } while (0)
    f32x16 pA0, pA1, pB0, pB1; float mnA, mnB, alA, alB; bf16x8 pa0, pa1, pa2, pa3;
    if constexpr (F32) { VMW(); SWRITE_VF(0); SBAR(); } else { SWRITE_HV(0); SBAR(); }
    if (NT > 1) { if constexpr (F32) SLOAD_F((const float*)Kh, KBASE(1)); else SLOAD_H(Kh, Vh, KBASE(1)); }
    SBAR(); qkt<0, SK>(pA0, pA1, K_lds, r32, hi, S.qr, ACT(0), BIASP(0));
    if constexpr (F32) { if (NT > 1) { VMW(); SWRITE_KF(1); SBAR(); SLOAD_F((const float*)Vh, KBASE(1)); } }
    MASKT(pA0, pA1, 0); partialSM(pA0, pA1, m_reg, mnA, alA);
    if (NT > 1) { VMW(); if constexpr (F32) { SWRITE_VF(1); SBAR(); if (NT > 2) SLOAD_F((const float*)Kh, KBASE(2)); } else SWRITE_H(1); }
    __syncthreads();
#define HALF_STEP(PX0, PX1, mnX, alX, PY0, PY1, alY, t, KB, VB, SB) do {                                                      \
        SBAR(); qkt<KB, SK>(PX0, PX1, K_lds, r32, hi, S.qr, ACT(t), BIASP(t));                                             \
        finishSM(PY0, PY1, alY, l_reg, pa0, pa1, pa2, pa3); SBAR();                                                           \
        if ((t) + 1 < NT) { if constexpr (F32) { VMW(); SWRITE_KF(SB); SBAR(); SLOAD_F((const float*)Vh, KBASE((t) + 1)); }  \
                            else { SLOAD_H(Kh, Vh, KBASE((t) + 1)); } SBAR(); }                                               \
        pv_tile<VB, SK>(o, vb0, pa0, pa1, pa2, pa3, ACT((t) - 1)); MASKT(PX0, PX1, (t)); partialSM(PX0, PX1, m_reg, mnX, alX);                                        \
        __syncthreads();                                                                                                      \
        if ((t) + 1 < NT) { VMW(); if constexpr (F32) { SWRITE_VF(SB); SBAR(); if ((t) + 2 < NT) SLOAD_F((const float*)Kh, KBASE((t) + 2)); } \
                            else { SWRITE_H(SB); } }                                                                          \
        RESC(alX); __syncthreads(); } while (0)
    for (int t = 1; t + 1 < NT; t += 2) {
        HALF_STEP(pB0, pB1, mnB, alB, pA0, pA1, alA, t, 1, 0, 0);
        HALF_STEP(pA0, pA1, mnA, alA, pB0, pB1, alB, t + 1, 0, 1, 1);
        if (t == 3) {
            float mm = m_reg;
#pragma unroll
            for (int o_ = 1; o_ < 64; o_ <<= 1) mm = fminf(mm, __shfl_xor(mm, o_));
            float* mmw = (float*)(lds + BIAS_OFF - 1024);
            if (lane == 0) mmw[wid] = mm;
            __syncthreads();
            float bm = fminf(fminf(fminf(mmw[0], mmw[1]), fminf(mmw[2], mmw[3])), fminf(fminf(mmw[4], mmw[5]), fminf(mmw[6], mmw[7]))) - TH2;
            const int ntb = cur.P0 / KVBLK, t0 = j_lo + lane, t1 = j_lo + lane + 64;
            const float b0_ = t0 < ntb ? *(const float*)(lds + BIAS_OFF + (t0 * KVBLK + KVBLK - 1) * 4) : bm, b1_ = t1 < ntb ? *(const float*)(lds + BIAS_OFF + (t1 * KVBLK + KVBLK - 1) * 4) : bm;
            const int skip = __builtin_amdgcn_readfirstlane((int)(__popcll(__ballot(b0_ < bm)) + __popcll(__ballot(b1_ < bm))));
            int nt2 = NT - skip; if (nt2 < 5) nt2 = 5;
            if (nt2 < NT) NT = nt2;
        }
    }
    const bool even = (NT & 1) == 0;
    if (even) { SBAR(); qkt<1, SK>(pB0, pB1, K_lds, r32, hi, S.qr, ACT(NT - 1), BIASP(NT - 1)); SBAR(); }
#define QROW(e) (nxt.Q + (size_t)(wid * QBLK + r32) * D + ((e) >> 1) * 16 + hi * 8 + ((e) & 1) * 4)
    if constexpr (F32) { SLOAD_F((const float*)nxt.K, kbn); SBAR();
#pragma unroll
        for (int e = 0; e < 8; ++e) S.tq[e] = *(const f32x4*)QROW(e); }
    else { SLOAD_H(nxt.K, nxt.V, kbn); SBAR();
#pragma unroll
        for (int d0 = 0; d0 < 8; ++d0) S.qr[d0] = load8<TIn>(nxt.Q + (size_t)(wid * QBLK + r32) * D + d0 * 16 + hi * 8); }
    SBAR();
    finishSM(pA0, pA1, alA, l_reg, pa0, pa1, pa2, pa3); SBAR();
    if constexpr (F32) {
#pragma unroll
        for (int e = 8; e < 16; ++e) S.tq[e] = *(const f32x4*)QROW(e); SBAR(); }
#undef QROW
    pv_tile<0, SK>(o, vb0, pa0, pa1, pa2, pa3, ACT(even ? NT - 2 : NT - 1));
    if (even) { MASKT(pB0, pB1, NT - 1); partialSM(pB0, pB1, m_reg, mnB, alB); __syncthreads(); RESC(alB);
        finishSM(pB0, pB1, alB, l_reg, pa0, pa1, pa2, pa3); SBAR(); pv_tile<1, SK>(o, vb0, pa0, pa1, pa2, pa3, ACT(NT - 1)); }
    SBAR(); SEAM_K0();
    if (hi == 0) li_l[r32] = l_reg; asm volatile("s_waitcnt lgkmcnt(0)" ::: "memory");
    float rli[16];
#pragma unroll
    for (int r = 0; r < 16; ++r) rli[r] = __builtin_amdgcn_rcpf(li_l[crow(r, hi)]);
    int eo = (wid * QBLK + 4 * hi) * OSTR + r32; asm volatile("" : "+v"(eo));
    TOut* Ow = cur.O + eo; const TOut* Zw = cur.Z + eo;
#pragma unroll
    for (int r = 0; r < 16; ++r) { const int orow = ((r & 3) + 8 * (r >> 2)) * OSTR;
#pragma unroll
        for (int d0 = 0; d0 < 4; ++d0) { const float v = o[d0][r] * rli[r] * __bfloat162float(Zw[orow + d0 * 32]);
            if constexpr (same_t<TOut, float>::v) { Ow[orow + d0 * 32] = v; }
            else { const float vn = __shfl_xor(v, 1);
                   if ((r32 & 1) == 0) *(unsigned*)(Ow + orow + d0 * 32) = cvtpk(v, vn); } } }
    if constexpr (F32) {
#pragma unroll
        for (int d0 = 0; d0 < 8; ++d0) S.qr[d0] = pack8(S.tq[2 * d0], S.tq[2 * d0 + 1]); }
    __syncthreads();
#undef RESC
#undef BIASP
#undef KBASE
#undef ACT
#undef MASKT
#undef SEAM_K0
#undef HALF_STEP
}
#undef ROW
#undef VMW
#undef VMWN
#undef SLOAD_H
#undef SWRITE_HK
#undef SWRITE_HV
#undef SWRITE_H
#undef SLOAD_F
#undef SWRITE_KF
#undef SWRITE_VF

__host__ __device__ inline int swa_nramp(int nqb, int W, int qoff) { const int t = W - 1 - qoff; const int n = t < 0 ? 0 : t / QB + 1; return n > nqb ? nqb : n; }
__host__ __device__ inline int swa_nx(int nqb, int nramp, int order) { return (order & ORDER_PAIRED) ? (nramp + 1) / 2 + (nqb - nramp) : nqb; }
struct SwaItem { int bh, qb0, qb1; };
__device__ __forceinline__ SwaItem swa_decode(int L, int nb, int nh, int nhkv, int nqb, int nx, int nramp, int order) {
    const int G = nh / nhkv; SwaItem it; int x;
    if ((order & ORDER_XCD) && (nb * nhkv) % 8 == 0) { const int xcd = L & 7, k = L >> 3, per = G * nx, gi = k / per, r = k - gi * per;
        it.bh = (gi * 8 + xcd) * G + r / nx; x = r % nx; }
    else { it.bh = L / nx; x = L - it.bh * nx; }
    if (order & ORDER_PAIRED) { const int ns = nqb - nramp;
        if (x < ns) { it.qb0 = it.qb1 = nqb - 1 - x; } else { it.qb0 = x - ns; it.qb1 = nramp - 1 - it.qb0; } }
    else { it.qb0 = it.qb1 = ((order & 3) == ORDER_REVERSED) ? nqb - 1 - x : x; }
    return it;
}
template <class TIn, class TOut>
__device__ __forceinline__ BlockRef<TIn, TOut> mk_ref(const SwaItem& it, int pass, const TIn* Qb, const TIn* Kb, const TIn* Vb, TOut* Ob, const TOut* Zb, const float* Cb, int seq) {
    const int qb = pass ? it.qb1 : it.qb0, bb = it.bh >> 4, hh = it.bh & 15; BlockRef<TIn, TOut> r;
    r.Q = Qb + ((size_t)it.bh * seq + (size_t)qb * QB) * D; r.K = Kb + (size_t)it.bh * seq * D; r.V = Vb + (size_t)it.bh * seq * D;
    r.O = Ob + ((size_t)bb * seq + (size_t)qb * QB) * OSTR + hh * D; r.Z = Zb + ((size_t)bb * seq + (size_t)qb * QB) * OSTR + hh * D;
    r.C = Cb + (size_t)it.bh * seq; r.P0 = qb * QB; return r;
}
}

#define LAS __attribute__((address_space(3)))
typedef unsigned short bf16r;
typedef float f32x4 __attribute__((ext_vector_type(4)));
typedef float f32x2 __attribute__((ext_vector_type(2)));
typedef unsigned u32x4 __attribute__((ext_vector_type(4)));
typedef unsigned u32x2 __attribute__((ext_vector_type(2)));
typedef short bf16x8 __attribute__((ext_vector_type(8)));
constexpr int BATCH = 4, SEQ = 8192, DM = 2048, M = BATCH * SEQ, NH = 16, PLE = 256;
constexpr int NFOX = 4 * DM + NH, NFOXP = 8448;
constexpr float EPS = 1e-6f;
constexpr size_t MiB = (size_t)1 << 20;
constexpr size_t WS_GBUF = 65536, WS_NEGC = 1 * MiB, WS_LOGF = 3 * MiB, WS_SS = 5 * MiB, WS_RSTD = 9 * MiB;
constexpr size_t WS_WFOX = 16 * MiB, WS_WOF = 49 * MiB, WS_WHG = 57 * MiB, WS_WOH = 89 * MiB, WS_WPE = 97 * MiB, WS_WPG = 99 * MiB, WS_PB = 116 * MiB;
constexpr size_t WS_A = 148 * MiB, WS_B = 276 * MiB, WS_C = 404 * MiB, WS_D = 532 * MiB, WS_E = 660 * MiB, WS_F = 788 * MiB, WS_END = 916 * MiB;
constexpr int NTHR = 512, NWAVES = 8;
constexpr int LDS_BYTES = 147456;

#define LDS_WAIT() asm volatile("s_waitcnt lgkmcnt(0)" ::: "memory")
#define HBAR() do { asm volatile("s_waitcnt lgkmcnt(0)" ::: "memory"); __builtin_amdgcn_s_barrier(); asm volatile("" ::: "memory"); } while (0)

__device__ __forceinline__ float wave_sum(float v) {
#pragma unroll
    for (int o = 1; o < 64; o <<= 1) v += __shfl_xor(v, o);
    return v;
}
__device__ __forceinline__ u32x4 pack8(const f32x4 a, const f32x4 b) { u32x4 w; w.x = cvtpk_s(a[0], a[1]); w.y = cvtpk_s(a[2], a[3]); w.z = cvtpk_s(b[0], b[1]); w.w = cvtpk_s(b[2], b[3]); return w; }

__device__ __forceinline__ void transpose_item(const float* W, int ldw, int K, int nblk, bf16r* WT, const float* kscale, LAS float* scr, int item, int lane) {
    const int kb = item / nblk, nb = item - kb * nblk, k0 = 64 * kb, n0 = 32 * nb;
#pragma unroll 8
    for (int i = 0; i < 32; ++i) { const int kk = 2 * i + (lane >> 5); float v = W[(size_t)(k0 + kk) * ldw + n0 + (lane & 31)]; if (kscale) v *= kscale[k0 + kk]; scr[kk * 33 + (lane & 31)] = v; }
    LDS_WAIT(); asm volatile("" ::: "memory");
    const int c = lane & 7;
#pragma unroll
    for (int j = 0; j < 4; ++j) { const int n = (lane >> 3) + 8 * j; const LAS float* s = scr + (8 * c) * 33 + n;
        u32x4 o; o.x = cvtpk_s(s[0 * 33], s[1 * 33]); o.y = cvtpk_s(s[2 * 33], s[3 * 33]); o.z = cvtpk_s(s[4 * 33], s[5 * 33]); o.w = cvtpk_s(s[6 * 33], s[7 * 33]);
        *(u32x4*)(WT + (size_t)(n0 + n) * K + k0 + 8 * c) = o; }
    LDS_WAIT(); asm volatile("" ::: "memory");
}

#define XB_TMO      128
#define XB_XCNT(j)  (256  + 64 * (j))
#define XB_XSUB(j)  (1280 + 64 * (j))
#define XB_XGEN(j)  (2304 + 64 * (j))
#define XB_TOP      3328
#define XB_TOPGEN   3392
#define XCD_BAR_WORDS 3456
#define XB_SPIN_CAP (1u << 18)

__device__ __forceinline__ unsigned xb_ld(unsigned* p)              { return __hip_atomic_load(p, __ATOMIC_RELAXED, __HIP_MEMORY_SCOPE_AGENT); }
__device__ __forceinline__ unsigned xb_add(unsigned* p, unsigned v) { return __hip_atomic_fetch_add(p, v, __ATOMIC_RELAXED, __HIP_MEMORY_SCOPE_AGENT); }
__device__ __forceinline__ unsigned xb_xcc_id() { return (unsigned)__builtin_amdgcn_s_getreg((3 << 11) | 20) & 0xFu; }
#define XB_SPIN(cond, bar) do { unsigned _sp = 0; while (cond) { __builtin_amdgcn_s_sleep(1); \
    if ((++_sp & 255u) == 0u) { if (xb_ld(&(bar)[XB_TMO])) break; if (_sp > XB_SPIN_CAP) { atomicAdd(&(bar)[XB_TMO], 1u); break; } } } } while (0)

struct XcdBarrier {
    unsigned* bar; unsigned x; int wv;
    volatile LAS unsigned* st;
};

__device__ __forceinline__ XcdBarrier xcd_barrier_post(unsigned* bar, volatile LAS unsigned* st, int wave_s) {
    XcdBarrier b; b.bar = bar; b.x = xb_xcc_id(); b.st = st; b.wv = wave_s;
    if (fresh_tid(wave_s) == 0) (void)xb_add(&bar[XB_XCNT(b.x)], 1u);
    return b;
}
__device__ __forceinline__ void xcd_barrier_complete(unsigned* bar, unsigned x, unsigned& nloc, unsigned& nx) {
    const unsigned G = gridDim.x * gridDim.y * gridDim.z;
    unsigned sum, cnt, mine, sp = 0u;
    for (;;) {
        sum = 0u; cnt = 0u; mine = 0u;
#pragma unroll
        for (unsigned j = 0; j < 16; ++j) { const unsigned c = xb_ld(&bar[XB_XCNT(j)]); sum += c; cnt += (c > 0u) ? 1u : 0u; mine = (j == x) ? c : mine; }
        if (sum == G) break;
        __builtin_amdgcn_s_sleep(1);
        if ((++sp & 255u) == 0u) { if (xb_ld(&bar[XB_TMO])) break; if (sp > XB_SPIN_CAP) { atomicAdd(&bar[XB_TMO], 1u); break; } }
    }
    nloc = mine > 0u ? mine : 1u; nx = cnt > 0u ? cnt : 1u;
}

__device__ __forceinline__ void xcd_barrier(const XcdBarrier& b) {
    asm volatile("s_waitcnt vmcnt(0)" ::: "memory");
    __syncthreads();
    if (fresh_tid(b.wv) == 0) {
        unsigned* bar = b.bar;
        __builtin_amdgcn_s_waitcnt(0);
        unsigned nloc = b.st[0], nx = b.st[1];
        if (nloc == 0u) { xcd_barrier_complete(bar, b.x, nloc, nx); b.st[0] = nloc; b.st[1] = nx; }
        const unsigned old = xb_add(&bar[XB_XSUB(b.x)], 1u);
        const unsigned gen = old / nloc;
        if (old + 1u == (gen + 1u) * nloc) {
            __builtin_amdgcn_fence(__ATOMIC_RELEASE, "agent");
            asm volatile("s_waitcnt vmcnt(0)" ::: "memory");
            const unsigned og = xb_add(&bar[XB_TOP], 1u);
            const unsigned tg = og / nx;
            if (og + 1u == (tg + 1u) * nx) xb_add(&bar[XB_TOPGEN], 1u);
            else XB_SPIN(xb_ld(&bar[XB_TOPGEN]) == tg, bar);
            __builtin_amdgcn_fence(__ATOMIC_ACQUIRE, "agent");
            xb_add(&bar[XB_XGEN(b.x)], 1u);
            asm volatile("s_waitcnt vmcnt(0)" ::: "memory");
        } else {
            XB_SPIN(xb_ld(&bar[XB_XGEN(b.x)]) == gen, bar);
            __builtin_amdgcn_fence(__ATOMIC_ACQUIRE, "agent");
            asm volatile("s_waitcnt vmcnt(0)" ::: "memory");
        }
    }
    __syncthreads();
}

#ifndef REP
#define REP 0
#endif
#define PH_LOOP_ { int nrep_ = 2; asm volatile("" : "+s"(nrep_)); for (int rep_ = 0; rep_ < nrep_; ++rep_) {
#define PH_LOOPEND_ } }
#if (REP >> 0) & 1
#define PH_BEGIN_0 PH_LOOP_
#define PH_END_0 PH_LOOPEND_
#else
#define PH_BEGIN_0 {
#define PH_END_0 }
#endif
#if (REP >> 1) & 1
#define PH_BEGIN_1 PH_LOOP_
#define PH_END_1 PH_LOOPEND_
#else
#define PH_BEGIN_1 {
#define PH_END_1 }
#endif
#if (REP >> 2) & 1
#define PH_BEGIN_2 PH_LOOP_
#define PH_END_2 PH_LOOPEND_
#else
#define PH_BEGIN_2 {
#define PH_END_2 }
#endif
#if (REP >> 3) & 1
#define PH_BEGIN_3 PH_LOOP_
#define PH_END_3 PH_LOOPEND_
#else
#define PH_BEGIN_3 {
#define PH_END_3 }
#endif
#if (REP >> 4) & 1
#define PH_BEGIN_4 PH_LOOP_
#define PH_END_4 PH_LOOPEND_
#else
#define PH_BEGIN_4 {
#define PH_END_4 }
#endif
#if (REP >> 5) & 1
#define PH_BEGIN_5 PH_LOOP_
#define PH_END_5 PH_LOOPEND_
#else
#define PH_BEGIN_5 {
#define PH_END_5 }
#endif
#if (REP >> 6) & 1
#define PH_BEGIN_6 PH_LOOP_
#define PH_END_6 PH_LOOPEND_
#else
#define PH_BEGIN_6 {
#define PH_END_6 }
#endif
#if (REP >> 7) & 1
#define PH_BEGIN_7 PH_LOOP_
#define PH_END_7 PH_LOOPEND_
#else
#define PH_BEGIN_7 {
#define PH_END_7 }
#endif
struct Args { const float* in[15]; float* out; unsigned char* ws; };

namespace hg {
constexpr int QS = 272, TS = 144;
constexpr int SET_BYTES = 58368, OFF_Q = 0, OFF_K = 17408, OFF_KT = 34816, OFF_VT = 53248, OFF_DL = 57856;
constexpr int OFF_ST = 2 * SET_BYTES, ST_BYTES = 8704;
#define MFMA16(a, b, c) __builtin_amdgcn_mfma_f32_16x16x32_bf16((a), (b), (c), 0, 0, 0)
template <int SET> __device__ __forceinline__ void hgE(LAS unsigned char* lds, const unsigned (&gh)[16], const unsigned (&qv)[16], int w, int lane) {
    LAS unsigned char* base = lds + SET * SET_BYTES;
    typedef _Float16 f16x2_t __attribute__((ext_vector_type(2)));
    f32x2 gv[16];
#pragma unroll
    for (int j = 0; j < 16; ++j) { const f16x2_t t = __builtin_bit_cast(f16x2_t, gh[j]); gv[j] = (f32x2){(float)t.x, (float)t.y}; }
    const int cp = lane & 15, rg = lane >> 4;
    float run0 = 1.f, run1 = 1.f;
#pragma unroll
    for (int j = 0; j < 16; ++j) { run0 *= gv[j].x; run1 *= gv[j].y; }
    float i0 = run0, i1 = run1;
    { const float a0 = __shfl_up(i0, 16), a1 = __shfl_up(i1, 16); if (rg >= 1) { i0 *= a0; i1 *= a1; } }
    { const float a0 = __shfl_up(i0, 32), a1 = __shfl_up(i1, 32); if (rg >= 2) { i0 *= a0; i1 *= a1; } }
    float pre0 = __shfl_up(i0, 16), pre1 = __shfl_up(i1, 16); if (rg == 0) { pre0 = 1.f; pre1 = 1.f; }
    const float all0 = __shfl(i0, cp + 48), all1 = __shfl(i1, cp + 48);
    unsigned kh0[8], kh1[8]; float kp0 = 0.f, kp1 = 0.f, ea = pre0, eb = pre1;
    LAS unsigned char* qw = base + OFF_Q + (16 * rg) * QS + (32 * w + 2 * cp) * 2;
#pragma unroll
    for (int j = 0; j < 16; ++j) {
        ea *= gv[j].x; eb *= gv[j].y;
        const float qa = bf_lo(qv[j]) * ea, qb = bf_hi(qv[j]) * eb;
        const float ka = (1.f - gv[j].x) * __builtin_amdgcn_rcpf(ea), kb = (1.f - gv[j].y) * __builtin_amdgcn_rcpf(eb);
        *(LAS unsigned*)(qw + j * QS) = cvtpk_s(qa, qb);
        *(LAS unsigned*)(qw + (OFF_K - OFF_Q) + j * QS) = cvtpk_s(ka, kb);
        const float ha = ka * all0, hb = kb * all1;
        if (j & 1) { kh0[j >> 1] = cvtpk_s(kp0, ha); kh1[j >> 1] = cvtpk_s(kp1, hb); } else { kp0 = ha; kp1 = hb; }
    }
    LAS unsigned char* kw = base + OFF_KT + (32 * w + 2 * cp) * TS + rg * 32;
    *(LAS u32x4*)(kw) = (u32x4){kh0[0], kh0[1], kh0[2], kh0[3]}; *(LAS u32x4*)(kw + 16) = (u32x4){kh0[4], kh0[5], kh0[6], kh0[7]};
    *(LAS u32x4*)(kw + TS) = (u32x4){kh1[0], kh1[1], kh1[2], kh1[3]}; *(LAS u32x4*)(kw + TS + 16) = (u32x4){kh1[4], kh1[5], kh1[6], kh1[7]};
    if (rg == 0) *(LAS f32x2*)(base + OFF_DL + (32 * w + 2 * cp) * 4) = (f32x2){all0, all1};
}
template <int SET, int VAR = 0> __device__ __forceinline__ void hgM(LAS unsigned char* lds, f32x4 (&st)[2][2], int ti, int lane, char* ob, unsigned ol) {
    const int l16 = lane & 15, kq = lane >> 4;
    const LAS unsigned char* base = lds + SET * SET_BYTES;
    bf16x8 qf[4], kf[4][4], sb[2][4], kt[2][2], vv[2][2]; u32x2 va[2][2], vb2[2][2]; f32x4 dl[2];
    const LAS unsigned char* qrow = base + OFF_Q + (16 * ti + l16) * QS + kq * 16;
    const LAS unsigned char* krow = base + OFF_K + l16 * QS + kq * 16;
    const LAS unsigned char* srow = lds + OFF_ST + SET * ST_BYTES + l16 * QS + kq * 16;
    const LAS unsigned char* vrow = base + OFF_VT + l16 * TS;
#pragma unroll
    for (int kk = 0; kk < 4; ++kk) { qf[kk] = *(const LAS bf16x8*)(qrow + kk * 64); sb[0][kk] = *(const LAS bf16x8*)(srow + kk * 64); sb[1][kk] = *(const LAS bf16x8*)(srow + 16 * QS + kk * 64); }
#pragma unroll
    for (int si = 0; si < 4; ++si)
#pragma unroll
        for (int kk = 0; kk < 4; ++kk) kf[si][kk] = *(const LAS bf16x8*)(krow + si * 16 * QS + kk * 64);
#pragma unroll
    for (int vh = 0; vh < 2; ++vh)
#pragma unroll
        for (int p = 0; p < 2; ++p) { va[vh][p] = *(const LAS u32x2*)(vrow + vh * 16 * TS + kq * 8 + p * 64); vb2[vh][p] = *(const LAS u32x2*)(vrow + vh * 16 * TS + kq * 8 + p * 64 + 32); }
#pragma unroll
    for (int kk = 0; kk < 2; ++kk) { vv[0][kk] = *(const LAS bf16x8*)(vrow + kk * 64 + kq * 16); vv[1][kk] = *(const LAS bf16x8*)(vrow + 16 * TS + kk * 64 + kq * 16);
        kt[0][kk] = *(const LAS bf16x8*)(base + OFF_KT + (32 * ti + l16) * TS + kk * 64 + kq * 16); kt[1][kk] = *(const LAS bf16x8*)(base + OFF_KT + (32 * ti + 16 + l16) * TS + kk * 64 + kq * 16); }
    dl[0] = *(const LAS f32x4*)(base + OFF_DL + (32 * ti + 4 * kq) * 4); dl[1] = *(const LAS f32x4*)(base + OFF_DL + (32 * ti + 16 + 4 * kq) * 4);
    __builtin_amdgcn_sched_barrier(0);
    f32x4 o[2], as[4];
    o[0] = (f32x4){0.f, 0.f, 0.f, 0.f}; o[1] = o[0];
#pragma unroll
    for (int si = 0; si < 4; ++si) as[si] = (f32x4){0.f, 0.f, 0.f, 0.f};
#pragma unroll
    for (int kk = 0; kk < 4; ++kk) { o[0] = MFMA16(qf[kk], sb[0][kk], o[0]); o[1] = MFMA16(qf[kk], sb[1][kk], o[1]);
#pragma unroll
        for (int si = 0; si < 4; ++si) as[si] = MFMA16(kf[si][kk], qf[kk], as[si]); }
#pragma unroll
    for (int ds = 0; ds < 2; ++ds)
#pragma unroll
        for (int vh = 0; vh < 2; ++vh) { st[ds][vh] = st[ds][vh] * dl[ds];
#pragma unroll
            for (int kk = 0; kk < 2; ++kk) st[ds][vh] = MFMA16(kt[ds][kk], vv[vh][kk], st[ds][vh]); }
    const int tq = 16 * ti + l16 - 4 * kq;
#pragma unroll
    for (int si = 0; si < 4; ++si)
#pragma unroll
        for (int j = 0; j < 4; ++j) if (16 * si + j > tq) as[si][j] = 0.f;
#pragma unroll
    for (int p = 0; p < 2; ++p) {
        u32x4 pw; pw.x = cvtpk_s(as[2 * p][0], as[2 * p][1]); pw.y = cvtpk_s(as[2 * p][2], as[2 * p][3]); pw.z = cvtpk_s(as[2 * p + 1][0], as[2 * p + 1][1]); pw.w = cvtpk_s(as[2 * p + 1][2], as[2 * p + 1][3]);
#pragma unroll
        for (int vh = 0; vh < 2; ++vh) { const u32x4 vw = {va[vh][p].x, va[vh][p].y, vb2[vh][p].x, vb2[vh][p].y};
            o[vh] = MFMA16(__builtin_bit_cast(bf16x8, pw), __builtin_bit_cast(bf16x8, vw), o[vh]); }
    }
    if ((VAR & 1) == 0 || o[0][0] == 12345.678f) {
#pragma unroll
    for (int vh = 0; vh < 2; ++vh)
#pragma unroll
        for (int j = 0; j < 4; ++j) *(bf16r*)(ob + (size_t)j * DM * 2 + vh * 32 + ol) = (bf16r)(cvtpk_s(o[vh][j], 0.f) & 0xffffu);
    }
#pragma unroll
    for (int ds = 0; ds < 2; ++ds)
#pragma unroll
        for (int vh = 0; vh < 2; ++vh)
            *(LAS u32x2*)(lds + OFF_ST + (SET ^ 1) * ST_BYTES + (16 * vh + l16) * QS + (32 * ti + 16 * ds + 4 * kq) * 2) = (u32x2){cvtpk_s(st[ds][vh][0], st[ds][vh][1]), cvtpk_s(st[ds][vh][2], st[ds][vh][3])};
}
template <int SET> __device__ __forceinline__ void hgV(LAS unsigned char* lds, const u32x4& v, int mt) {
    LAS bf16r* vt = (LAS bf16r*)(lds + SET * SET_BYTES + OFF_VT + (mt & 3) * 8 * TS + (mt >> 2) * 2);
    vt[0] = (bf16r)(v.x & 0xffffu); vt[TS / 2] = (bf16r)(v.x >> 16); vt[2 * (TS / 2)] = (bf16r)(v.y & 0xffffu); vt[3 * (TS / 2)] = (bf16r)(v.y >> 16);
    vt[4 * (TS / 2)] = (bf16r)(v.z & 0xffffu); vt[5 * (TS / 2)] = (bf16r)(v.z >> 16); vt[6 * (TS / 2)] = (bf16r)(v.w & 0xffffu); vt[7 * (TS / 2)] = (bf16r)(v.w >> 16);
}
template <int VAR = 0> __device__ __forceinline__ void hgrn_item(LAS unsigned char* lds, const bf16r* SQ, const bf16r* G, const bf16r* V, bf16r* O, int item, int tid_in) {
    const int tid = tid_in, lane = tid & 63, w = __builtin_amdgcn_readfirstlane(tid >> 6);
    const int bh = item >> 2, vs = item & 3, b = bh >> 4, h = bh & 15;
    const size_t rowbase = (size_t)b * SEQ;
    constexpr int NC = SEQ / 64;
    if (w < 4) {
        const int cp = lane & 15, rg = lane >> 4;
        const bf16r* gp = G + (rowbase + 16 * rg) * DM + h * 128 + 32 * w + 2 * cp;
        const bf16r* qp = SQ + (rowbase + 16 * rg) * DM + h * 128 + 32 * w + 2 * cp;
        unsigned gvA[16], gvB[16]; unsigned qvA[16], qvB[16];
#define HG_LOADE(GV, QV, c_) do { const size_t adv_ = (size_t)(c_) * 64 * DM; _Pragma("unroll") for (int j = 0; j < 16; ++j) { GV[j] = *(const unsigned*)(gp + adv_ + (size_t)j * DM); QV[j] = *(const unsigned*)(qp + adv_ + (size_t)j * DM); } } while (0)
        HG_LOADE(gvA, qvA, 0); HG_LOADE(gvB, qvB, 1);
        hgE<0>(lds, gvA, qvA, w, lane); HG_LOADE(gvA, qvA, 2);
        HBAR();
        for (int c = 0; c < NC; c += 2) {
            if ((VAR & 8) == 0) hgE<1>(lds, gvB, qvB, w, lane); if ((VAR & 2) == 0) HG_LOADE(gvB, qvB, (c + 3 < NC ? c + 3 : NC - 1));
            HBAR();
            if ((VAR & 8) == 0) hgE<0>(lds, gvA, qvA, w, lane); if ((VAR & 2) == 0) HG_LOADE(gvA, qvA, (c + 4 < NC ? c + 4 : NC - 1));
            HBAR();
        }
#undef HG_LOADE
    } else {
        const int ti = w - 4, mt = tid - 256, l16 = lane & 15, kq = lane >> 4;
        const bf16r* vp = V + (rowbase + (mt >> 2)) * DM + h * 128 + vs * 32 + (mt & 3) * 8;
        char* ob = (char*)(O + (rowbase + 16 * ti) * DM + h * 128 + vs * 32);
        const unsigned ol = (4 * kq * DM + l16) * 2;
        for (int i = mt; i < ST_BYTES / 4; i += 256) ((LAS unsigned*)(lds + OFF_ST))[i] = 0u;
        f32x4 st[2][2];
#pragma unroll
        for (int ds = 0; ds < 2; ++ds) { st[ds][0] = (f32x4){0.f, 0.f, 0.f, 0.f}; st[ds][1] = st[ds][0]; }
        u32x4 vA = *(const u32x4*)vp, vB = *(const u32x4*)(vp + (size_t)64 * DM);
        hgV<0>(lds, vA, mt); vA = *(const u32x4*)(vp + (size_t)2 * 64 * DM);
        HBAR();
        for (int c = 0; c < NC; c += 2) {
            if ((VAR & 4) == 0) hgM<0, VAR>(lds, st, ti, lane, ob + (size_t)c * 64 * DM * 2, ol);
            hgV<1>(lds, vB, mt); vB = *(const u32x4*)(vp + (size_t)(c + 3 < NC ? c + 3 : NC - 1) * 64 * DM);
            HBAR();
            if ((VAR & 4) == 0) hgM<1, VAR>(lds, st, ti, lane, ob + (size_t)(c + 1) * 64 * DM * 2, ol);
            hgV<0>(lds, vA, mt); vA = *(const u32x4*)(vp + (size_t)(c + 4 < NC ? c + 4 : NC - 1) * 64 * DM);
            HBAR();
        }
    }
}
}

__global__ void __launch_bounds__(NTHR, 2) fwd_megakernel(Args args) {
    extern __shared__ __attribute__((aligned(16))) unsigned char lds_raw[];
    cg::grid_group grid = cg::this_grid();
    LAS unsigned char* lds = (LAS unsigned char*)lds_raw;
    const int G = gridDim.x, NGW = G * NWAVES, NGT = G * NTHR;
    const int wave_s = __builtin_amdgcn_readfirstlane((int)threadIdx.x >> 6);
    { const int t0_ = fresh_tid(wave_s); if (t0_ < 2) ((volatile LAS unsigned*)(lds + 147008))[t0_] = 0u; }
    __syncthreads();
    const XcdBarrier xbar = xcd_barrier_post((unsigned*)(args.ws + 4096), (volatile LAS unsigned*)(lds + 147008), wave_s);
#define GRID_BAR() xcd_barrier(xbar)
#define PHASE_IDS() const int tid = fresh_tid(wave_s); const int lane = tid & 63, wave = wave_s; \
    const int gw = blockIdx.x * NWAVES + wave, gt = blockIdx.x * NTHR + tid; (void)lane; (void)gw; (void)gt
    unsigned char* ws = args.ws;
    const float* x = args.in[0]; const float* p = args.in[1]; const float* w_in_fox = args.in[2]; const float* b_f = args.in[3];
    const float* g_q = args.in[4]; const float* g_k = args.in[5]; const float* w_out_fox = args.in[6]; const float* w_in_hg = args.in[7];
    const float* lbl = args.in[8]; const float* g_o = args.in[9]; const float* w_out_hg = args.in[10]; const float* pre_norm = args.in[11];
    const float* post_norm = args.in[12]; const float* w_pe = args.in[13]; const float* w_pg = args.in[14];
    float* out = args.out;
    float* negc = (float*)(ws + WS_NEGC); float* logf = (float*)(ws + WS_LOGF); float* ss = (float*)(ws + WS_SS); float* rstd1 = (float*)(ws + WS_RSTD); float* rstdY = rstd1 + M; float* gbuf = (float*)(ws + WS_GBUF);
    bf16r* WFOX = (bf16r*)(ws + WS_WFOX); bf16r* WOF = (bf16r*)(ws + WS_WOF); bf16r* WHG = (bf16r*)(ws + WS_WHG); bf16r* WOH = (bf16r*)(ws + WS_WOH);
    bf16r* WPE = (bf16r*)(ws + WS_WPE); bf16r* WPG = (bf16r*)(ws + WS_WPG); bf16r* PB = (bf16r*)(ws + WS_PB);
    bf16r* bA = (bf16r*)(ws + WS_A); bf16r* bB = (bf16r*)(ws + WS_B); bf16r* bC = (bf16r*)(ws + WS_C); bf16r* bD = (bf16r*)(ws + WS_D); bf16r* bE = (bf16r*)(ws + WS_E); bf16r* bF = (bf16r*)(ws + WS_F);

#define DEFERRED_CONVERT(gw_, ngw_, gt_, ngt_) do { \
        constexpr int I_SQ = 32 * 64, I_HG = 32 * 256, I_PE = 4 * 64, NITEMS = I_SQ + I_HG + I_SQ + 2 * I_PE + 2 * I_SQ; \
        for (int it = (gw_); it < NITEMS; it += (ngw_)) { int r = it; \
            if (r < I_SQ) { transpose_item(w_out_fox, DM, DM, 64, WOF, nullptr, scr, r, lane); continue; } r -= I_SQ; \
            if (r < I_HG) { transpose_item(w_in_hg, 4 * DM, DM, 256, WHG, pre_norm + DM, scr, r, lane); continue; } r -= I_HG; \
            if (r < I_SQ) { transpose_item(w_out_hg, DM, DM, 64, WOH, nullptr, scr, r, lane); continue; } r -= I_SQ; \
            if (r < I_PE) { transpose_item(w_pe, DM, PLE, 64, WPE, nullptr, scr, r, lane); continue; } r -= I_PE; \
            if (r < I_PE) { transpose_item(w_pe + (size_t)PLE * DM, DM, PLE, 64, WPE + (size_t)DM * PLE, nullptr, scr, r, lane); continue; } r -= I_PE; \
            if (r < I_SQ) { transpose_item(w_pg, DM, DM, 64, WPG, nullptr, scr, r, lane); continue; } r -= I_SQ; \
            transpose_item(w_pg + (size_t)DM * DM, DM, DM, 64, WPG + (size_t)DM * DM, nullptr, scr, r, lane); } \
        for (int i = (gt_); i < 2 * M * PLE / 8; i += (ngt_)) { const f32x4 a = *(const f32x4*)(p + (size_t)i * 8), b2 = *(const f32x4*)(p + (size_t)i * 8 + 4); *(u32x4*)(PB + (size_t)i * 8) = pack8(a, b2); } } while (0)

    PH_BEGIN_0
    {
        PHASE_IDS();
        LAS float* scr = (LAS float*)(lds + wave * 8448);
        for (int it = gw; it < 32 * 256; it += NGW) transpose_item(w_in_fox, NFOX, DM, 256, WFOX, nullptr, scr, it, lane);
        if (G != 256) { DEFERRED_CONVERT(gw, NGW, gt, NGT); }
        for (int i = gt; i < 4096 + 240 * 256; i += NGT) {
            if (i < 4096) { const int n = i & 15, kc = i >> 4; float v[8];
#pragma unroll
                for (int j = 0; j < 8; ++j) v[j] = w_in_fox[(size_t)(kc * 8 + j) * NFOX + 8192 + n];
                u32x4 o; o.x = cvtpk_s(v[0], v[1]); o.y = cvtpk_s(v[2], v[3]); o.z = cvtpk_s(v[4], v[5]); o.w = cvtpk_s(v[6], v[7]);
                *(u32x4*)(WFOX + (size_t)(8192 + n) * DM + kc * 8) = o; }
            else { const int r = i - 4096; *(u32x4*)(WFOX + (size_t)(8208 + (r >> 8)) * DM + (r & 255) * 8) = (u32x4){0u, 0u, 0u, 0u}; } }
        if (blockIdx.x == 0 && tid < 256) gbuf[tid] = tid < 128 ? g_q[tid] : g_k[tid - 128];
        for (int row = gw; row < M; row += 2 * NGW) { const int row2 = row + NGW;
            const bool has2 = row2 < M; const float* xr = x + (size_t)row * DM + lane * 4; const float* xr2 = x + (size_t)(has2 ? row2 : row) * DM + lane * 4;
            f32x4 v[8], u[8]; float s = 0.f, s2 = 0.f;
#pragma unroll
            for (int j = 0; j < 8; ++j) { v[j] = *(const f32x4*)(xr + j * 256); u[j] = *(const f32x4*)(xr2 + j * 256); }
#pragma unroll
            for (int j = 0; j < 8; ++j) { s += (v[j][0] * v[j][0] + v[j][1] * v[j][1]) + (v[j][2] * v[j][2] + v[j][3] * v[j][3]); s2 += (u[j][0] * u[j][0] + u[j][1] * u[j][1]) + (u[j][2] * u[j][2] + u[j][3] * u[j][3]); }
            const float r = rsqrtf(wave_sum(s) * (1.f / DM) + EPS), r2 = rsqrtf(wave_sum(s2) * (1.f / DM) + EPS);
#pragma unroll
            for (int j = 0; j < 8; ++j) { const f32x4 g = *(const f32x4*)(pre_norm + j * 256 + lane * 4); const f32x4 o = v[j] * r * g, o2 = u[j] * r2 * g;
                *(u32x2*)(bA + (size_t)row * DM + j * 256 + lane * 4) = (u32x2){cvtpk_s(o[0], o[1]), cvtpk_s(o[2], o[3])};
                if (has2) *(u32x2*)(bA + (size_t)row2 * DM + j * 256 + lane * 4) = (u32x2){cvtpk_s(o2[0], o2[1]), cvtpk_s(o2[2], o2[3])}; } }
    }
    GRID_BAR();
    if (args.ws == nullptr) grid.sync();
    PH_END_0

    PH_BEGIN_1
#if !defined(GMASK) || (GMASK & 1)
    { pg8::Gemm g{bA, WFOX, M, NFOXP, DM}; pg8::StaticOrder S; S.init(M, NFOXP, G, (int)blockIdx.x);
      pg8::EpiFoxIn E{bB, bE, (size_t)(WS_C - WS_B) / 2, logf, b_f, gbuf, (LAS float*)(lds + 131072)};
      pg8::gemm_phase<pg8::EpiFoxIn, pg8::StaticOrder, true, true>(lds, g, S, E, wave_s); }
#endif
    if (G == 256 && blockIdx.x >= 128) {
        PHASE_IDS(); __syncthreads(); LAS float* scr = (LAS float*)(lds + wave * 8448);
        DEFERRED_CONVERT(((int)blockIdx.x - 128) * NWAVES + wave, 128 * NWAVES, ((int)blockIdx.x - 128) * NTHR + tid, 128 * NTHR); }
    GRID_BAR();
    PH_END_1

    {
        PHASE_IDS();
        for (int seq = blockIdx.x; seq < BATCH * NH; seq += G) {
            const float* src = logf + (size_t)seq * SEQ + tid * 16; float v[16];
#pragma unroll
            for (int j = 0; j < 4; ++j) { const f32x4 t = *(const f32x4*)(src + 4 * j); v[4 * j] = t[0]; v[4 * j + 1] = t[1]; v[4 * j + 2] = t[2]; v[4 * j + 3] = t[3]; }
#pragma unroll
            for (int j = 1; j < 16; ++j) v[j] += v[j - 1];
            float incl = v[15];
#pragma unroll
            for (int o = 1; o < 64; o <<= 1) { const float t = __shfl_up(incl, o); if (lane >= o) incl += t; }
            LAS float* wt = (LAS float*)lds;
            __syncthreads();
            if (lane == 63) wt[wave] = incl;
            __syncthreads();
            float pre = incl - v[15];
            for (int ww = 0; ww < wave; ++ww) pre += wt[ww];
            float* dst = negc + (size_t)seq * SEQ + tid * 16;
#pragma unroll
            for (int j = 0; j < 4; ++j) { f32x4 t; t[0] = -(v[4 * j] + pre) * 11.313708498984761f; t[1] = -(v[4 * j + 1] + pre) * 11.313708498984761f; t[2] = -(v[4 * j + 2] + pre) * 11.313708498984761f; t[3] = -(v[4 * j + 3] + pre) * 11.313708498984761f; *(f32x4*)(dst + 4 * j) = t; }
        }
    }
    GRID_BAR();

    PH_BEGIN_2
#ifndef NO_ATT
    {
        using namespace att;
        typedef BlockRef<bf16, bf16> BR;
        constexpr int nqb = SEQ / QB, W = 1 << 20;
        char* ldsg = (char*)lds_raw;
        volatile LAS int* hord = (volatile LAS int*)(lds + 143360);
        constexpr float PRUNE_MARGIN = 27.f;
        float TH, TH2;
        {
            PHASE_IDS();
        float gqm = fmaxf(fabsf(gbuf[lane]), fabsf(gbuf[lane + 64])), gkm = fmaxf(fabsf(gbuf[128 + lane]), fabsf(gbuf[192 + lane]));
#pragma unroll
        for (int o = 1; o < 64; o <<= 1) { gqm = fmaxf(gqm, __shfl_xor(gqm, o)); gkm = fmaxf(gkm, __shfl_xor(gkm, o)); }
        TH = __uint_as_float(__builtin_amdgcn_readfirstlane(__float_as_uint((2.f * 11.313708f * gqm * gkm * 1.02f + PRUNE_MARGIN) * 11.313708f)));
        TH2 = __uint_as_float(__builtin_amdgcn_readfirstlane(__float_as_uint((11.313708f * gqm * gkm * 1.02f + PRUNE_MARGIN) * 11.313708f)));
        if (tid < 16) { const float mine = b_f[tid]; int rk = 0;
            for (int j = 0; j < 16; ++j) { const float o = b_f[j]; rk += (o > mine || (o == mine && j < tid)) ? 1 : 0; }
            hord[rk] = tid; }
        }
        __syncthreads();
        unsigned* qctr = (unsigned*)ws;
#define FETCH(Lout) do { __syncthreads(); if (fresh_tid(wave_s) == 0) { int q_ = (int)(xbar.x & 7u), got_ = -1; \
            for (int t_ = 0; t_ < 8; ++t_) { const unsigned i_ = atomicAdd(qctr + 64 * q_, 1u); if (i_ < 256u) { got_ = q_ * 256 + (int)i_; break; } q_ = (q_ + 1) & 7; } \
            hord[16] = got_; } __syncthreads(); Lout = __builtin_amdgcn_readfirstlane(hord[16]); } while (0)
#define DECODE(L_) SwaItem{((((L_) & 127) >> 5) * NH) + __builtin_amdgcn_readfirstlane(hord[(((L_) >> 7) & 1) ? 15 - ((L_) >> 8) : ((L_) >> 8)]), nqb - 1 - ((L_) & 31), nqb - 1 - ((L_) & 31)}
#define MKREF(it_, pass_) mk_ref<bf16, bf16>((it_), (pass_), (const bf16*)bB, (const bf16*)bC, (const bf16*)bD, (bf16*)bF, (const bf16*)bE, negc, SEQ)
        int L; FETCH(L);
        if (L >= 0) {
            SwaItem it = DECODE(L);
            BR cur = MKREF(it, 0);
            Seam<bf16> S;
            causal_swa_prime<bf16, bf16>(cur, W, ldsg, S, wave_s);
            for (;;) {
                int Ln; FETCH(Ln);
                const bool last = Ln < 0;
                const SwaItem itn = last ? it : DECODE(Ln);
                const BR nxt = last ? cur : MKREF(itn, 0);
                causal_swa_block<bf16, bf16>(cur, nxt, SEQ, W, ldsg, S, TH, TH2, wave_s);
                if (last) break;
                cur = nxt; it = itn; L = Ln;
            }
        }
    }
#endif
    GRID_BAR();
    PH_END_2

    PH_BEGIN_3
#if !defined(GMASK) || (GMASK & 2)
    { pg8::Gemm g{bF, WOF, M, DM, DM}; pg8::StaticOrder S; S.init(M, DM, G, (int)blockIdx.x);
      pg8::EpiOutSS E{bB, ss};
      pg8::gemm_phase<pg8::EpiOutSS, pg8::StaticOrder, true, true>(lds, g, S, E, wave_s); }
#endif
    __syncthreads();
#if !defined(GMASK) || (GMASK & 4)
    { int kpe = PLE; asm volatile("" : "+s"(kpe)); pg8::Gemm g{PB, WPE, M, DM, kpe}; pg8::StaticOrder S; S.init(M, DM, G, (int)blockIdx.x);
      pg8::EpiPlain E{bC};
      pg8::gemm_phase<pg8::EpiPlain, pg8::StaticOrder, true, true>(lds, g, S, E, wave_s); }
#endif
    GRID_BAR();
    PH_END_3

    PH_BEGIN_4
    { PHASE_IDS();
    for (int row = gw; row < M; row += NGW) { float s = lane < 32 ? ss[(size_t)row * 32 + lane] : 0.f; const float r = rsqrtf(wave_sum(s) * (1.f / DM) + EPS);
#pragma unroll
        for (int j = 0; j < 8; ++j) { const size_t idx = (size_t)row * DM + j * 256 + lane * 4; const f32x4 xr = *(const f32x4*)(x + idx); const u32x2 yv = *(const u32x2*)(bB + idx);
            const f32x4 g = *(const f32x4*)(post_norm + j * 256 + lane * 4); const f32x4 y = {bf_lo(yv.x), bf_hi(yv.x), bf_lo(yv.y), bf_hi(yv.y)};
            const f32x4 hv = xr + y * r * g; *(u32x2*)(bA + idx) = (u32x2){cvtpk_s(hv[0], hv[1]), cvtpk_s(hv[2], hv[3])}; }
        if (lane == 0) rstdY[row] = r; } }
    GRID_BAR();
    PH_END_4

#if !defined(GMASK) || (GMASK & 8)
    { pg8::Gemm g{bA, WPG, M, DM, DM}; pg8::StaticOrder S; S.init(M, DM, G, (int)blockIdx.x);
      pg8::EpiPG E{x, out, bB, rstdY, post_norm, bC, bF, ss};
      pg8::gemm_phase<pg8::EpiPG, pg8::StaticOrder, true, true>(lds, g, S, E, wave_s); }
#endif
    GRID_BAR();
    { PHASE_IDS();
    for (int row = gt; row < M; row += NGT) { float s = 0.f;
#pragma unroll
        for (int j = 0; j < 8; ++j) { const f32x4 t = *(const f32x4*)(ss + (size_t)row * 32 + 4 * j); s += (t[0] + t[1]) + (t[2] + t[3]); }
        rstd1[row] = rsqrtf(s * (1.f / DM) + EPS); } }
    GRID_BAR();

    PH_BEGIN_5
#if !defined(GMASK) || (GMASK & 16)
    { pg8::Gemm g{bF, WHG, M, 4 * DM, DM}; pg8::StaticOrder S; S.init(M, 4 * DM, G, (int)blockIdx.x);
      pg8::EpiHgIn E{bA, (size_t)(WS_B - WS_A) / 2, bB, rstd1, lbl};
      pg8::gemm_phase<pg8::EpiHgIn, pg8::StaticOrder, true, true>(lds, g, S, E, wave_s); }
#endif
    GRID_BAR();
    PH_END_5

    PH_BEGIN_6
#ifndef NO_HG
    { PHASE_IDS();
    for (int i = blockIdx.x; i < BATCH * NH * 4; i += G) {
        const int item = ((G & 31) == 0) ? (((i & 7) * (BATCH * NH / 8) + (i >> 5)) * 4 + ((i >> 3) & 3)) : i;
        hg::hgrn_item<0>(lds, bA, bB, bD, bF, item, tid); } }
#endif
    GRID_BAR();
    PH_END_6

#ifdef HGPROBE
    { PHASE_IDS();
    for (int i = blockIdx.x; i < BATCH * NH * 4; i += G) {
        const int item = ((G & 31) == 0) ? (((i & 7) * (BATCH * NH / 8) + (i >> 5)) * 4 + ((i >> 3) & 3)) : i;
        hg::hgrn_item<HGPROBE>(lds, bA, bB, bD, bF, item, tid); } }
    GRID_BAR();
#endif
    { PHASE_IDS();
    for (int it = gw; it < M * NH / 4; it += NGW) { const size_t off = ((size_t)it * 4 + (lane >> 4)) * 128 + (lane & 15) * 8;
        const u32x4 wv = *(const u32x4*)(bF + off), zv = *(const u32x4*)(bE + off);
        f32x4 a = {bf_lo(wv.x), bf_hi(wv.x), bf_lo(wv.y), bf_hi(wv.y)}, b2 = {bf_lo(wv.z), bf_hi(wv.z), bf_lo(wv.w), bf_hi(wv.w)};
        float s = (a[0] * a[0] + a[1] * a[1]) + (a[2] * a[2] + a[3] * a[3]) + (b2[0] * b2[0] + b2[1] * b2[1]) + (b2[2] * b2[2] + b2[3] * b2[3]);
        s += __shfl_xor(s, 1); s += __shfl_xor(s, 2); s += __shfl_xor(s, 4); s += __shfl_xor(s, 8);
        const float r = rsqrtf(s * (1.f / 128.f) + EPS); const float* gg = g_o + (lane & 15) * 8;
        const f32x4 z0 = {bf_lo(zv.x), bf_hi(zv.x), bf_lo(zv.y), bf_hi(zv.y)}, z1 = {bf_lo(zv.z), bf_hi(zv.z), bf_lo(zv.w), bf_hi(zv.w)};
        a = a * r * *(const f32x4*)gg * z0; b2 = b2 * r * *(const f32x4*)(gg + 4) * z1;
        *(u32x4*)(bF + off) = pack8(a, b2); } }
    GRID_BAR();

    PH_BEGIN_7
#if !defined(GMASK) || (GMASK & 32)
    { pg8::Gemm g{bF, WOH, M, DM, DM}; pg8::StaticOrder S; S.init(M, DM, G, (int)blockIdx.x);
      pg8::EpiOutSS E{bD, ss};
      pg8::gemm_phase<pg8::EpiOutSS, pg8::StaticOrder, true, true>(lds, g, S, E, wave_s); }
#endif
    __syncthreads();
#if !defined(GMASK) || (GMASK & 64)
    { int kpe = PLE; asm volatile("" : "+s"(kpe)); pg8::Gemm g{PB + (size_t)M * PLE, WPE + (size_t)DM * PLE, M, DM, kpe}; pg8::StaticOrder S; S.init(M, DM, G, (int)blockIdx.x);
      pg8::EpiPlain E{bE};
      pg8::gemm_phase<pg8::EpiPlain, pg8::StaticOrder, true, true>(lds, g, S, E, wave_s); }
#endif
    GRID_BAR();
    PH_END_7

    { PHASE_IDS();
    for (int row = gw; row < M; row += NGW) { float s = lane < 32 ? ss[(size_t)row * 32 + lane] : 0.f; const float r = rsqrtf(wave_sum(s) * (1.f / DM) + EPS);
#pragma unroll
        for (int j = 0; j < 8; ++j) { const size_t idx = (size_t)row * DM + j * 256 + lane * 4; const f32x4 xr = *(const f32x4*)(out + idx); const u32x2 yv = *(const u32x2*)(bD + idx);
            const f32x4 g = *(const f32x4*)(post_norm + DM + j * 256 + lane * 4); const f32x4 y = {bf_lo(yv.x), bf_hi(yv.x), bf_lo(yv.y), bf_hi(yv.y)};
            const f32x4 hv = xr + y * r * g; *(u32x2*)(bA + idx) = (u32x2){cvtpk_s(hv[0], hv[1]), cvtpk_s(hv[2], hv[3])}; }
        if (lane == 0) rstdY[row] = r; } }
    GRID_BAR();

#if !defined(GMASK) || (GMASK & 128)
    { pg8::Gemm g{bA, WPG + (size_t)DM * DM, M, DM, DM}; pg8::StaticOrder S; S.init(M, DM, G, (int)blockIdx.x);
      pg8::EpiPG E{out, out, bD, rstdY, post_norm + DM, bE, nullptr, nullptr};
      pg8::gemm_phase<pg8::EpiPG, pg8::StaticOrder, true, true>(lds, g, S, E, wave_s); }
#endif
}

extern "C" void kernel_launch(void* const* d_in, const int* in_sizes, int n_in, void* d_out, int out_size, void* d_ws, size_t ws_size, hipStream_t stream) {
    static int grid = 0;
    if (grid == 0) {
        if (n_in != 15 || out_size != M * DM || ws_size < WS_END) { fprintf(stderr, "kernel_launch: unexpected shapes (n_in %d out %d ws %zu)\n", n_in, out_size, ws_size); grid = -1; return; }
        int dev = 0, cus = 0, per_cu = 0;
        (void)hipGetDevice(&dev); (void)hipDeviceGetAttribute(&cus, hipDeviceAttributeMultiprocessorCount, dev);
        if (hipFuncSetAttribute((const void*)fwd_megakernel, hipFuncAttributeMaxDynamicSharedMemorySize, LDS_BYTES) != hipSuccess) fprintf(stderr, "kernel_launch: hipFuncSetAttribute failed\n");
        if (hipOccupancyMaxActiveBlocksPerMultiprocessor(&per_cu, (const void*)fwd_megakernel, NTHR, LDS_BYTES) != hipSuccess || per_cu < 1) { fprintf(stderr, "kernel_launch: occupancy query says %d\n", per_cu); per_cu = 1; }
        (void)hipGetLastError();
        if (cus <= 0) cus = 256;
        grid = cus * 1;
    }
    if (grid < 0) return;
    if (hipMemsetAsync(d_ws, 0, 65536, stream) != hipSuccess) { fprintf(stderr, "kernel_launch: hipMemsetAsync failed\n"); return; }
    Args a{};
    for (int i = 0; i < 15; ++i) a.in[i] = (const float*)d_in[i];
    a.out = (float*)d_out; a.ws = (unsigned char*)d_ws;
    void* kargs[] = {&a};
    hipError_t e = hipLaunchCooperativeKernel((const void*)fwd_megakernel, dim3(grid), dim3(NTHR), kargs, LDS_BYTES, stream);
    if (e != hipSuccess) fprintf(stderr, "cooperative launch failed: %s (grid %d)\n", hipGetErrorString(e), grid);
}
```
